# Optimizing an MI355X kernel written in HIP

```python
import math
import jax
import jax.numpy as jnp
from jax import lax
import numpy as np


D_MODEL = 1024
BATCH = 16
SEQ = 4096
DEPTH = 4

CTX_LEN = 256
GRID_W = 64
QBLK = 128
ROPE_BASE = 10000.0
NORM_EPS = 1e-6
NEG_INF = -1e30

SWA_HEADS = 8
SWA_KV_HEADS = 2
SWA_HEAD_DIM = 64
SWA_WINDOW = 128

MLA_HEADS = 8
MLA_Q_RANK = 256
MLA_KV_RANK = 128
MLA_NOPE_DIM = 64
MLA_ROPE_DIM = 32
MLA_V_DIM = 64

DIFF_HEADS = 8
DIFF_HEAD_DIM = 64
DIFF_EPS = 1e-5

N_GROUPS = 4
EXPERTS_PER_GROUP = 8
N_EXPERTS = N_GROUPS * EXPERTS_PER_GROUP
TOP_K = 2
EXPERT_FF = 512
MOE_BLK = 128

AB_IN_WIDTHS = (SWA_HEADS * SWA_HEAD_DIM, SWA_KV_HEADS * SWA_HEAD_DIM, SWA_KV_HEADS * SWA_HEAD_DIM, MLA_Q_RANK, MLA_KV_RANK, MLA_ROPE_DIM)
AB_IN_WIDTH = 512 + 128 + 128 + 256 + 128 + 32
AB_OUT_WIDTH = SWA_HEADS * SWA_HEAD_DIM + MLA_HEADS * MLA_V_DIM
DIFF_IN_WIDTHS = (DIFF_HEADS * 2 * DIFF_HEAD_DIM, DIFF_HEADS * 2 * DIFF_HEAD_DIM, DIFF_HEADS * 2 * DIFF_HEAD_DIM)
DIFF_IN_WIDTH = 3 * DIFF_HEADS * 2 * DIFF_HEAD_DIM
DIFF_OUT_WIDTH = DIFF_HEADS * 2 * DIFF_HEAD_DIM

kernel_name = 'hybrid_swa_mla_diff_hmoe_dit'


def _rmsnorm(x, g, eps=NORM_EPS):
    xf = x.astype(jnp.float32)
    y = xf * lax.rsqrt(jnp.mean(xf * xf, axis=-1, keepdims=True) + eps)
    return (y * g.astype(jnp.float32)).astype(x.dtype)


def _modulate(h, shift, scale):
    return h * (1 + scale) + shift


def _split(x, widths):
    idx = [int(i) for i in np.cumsum(widths)[:-1]]
    return jnp.split(x, idx, axis=-1)


def _axial_rope_tables(n_tokens, dim):
    rows = n_tokens // GRID_W
    row = jnp.repeat(jnp.arange(rows, dtype=jnp.float32), GRID_W)
    col = jnp.tile(jnp.arange(GRID_W, dtype=jnp.float32), rows)
    nf = dim // 4
    inv = ROPE_BASE ** (-jnp.arange(nf, dtype=jnp.float32) / nf)
    ang = jnp.concatenate([row[:, None] * inv, col[:, None] * inv], axis=-1)
    return jnp.cos(ang), jnp.sin(ang)


def _rope(x, tables):
    cos, sin = tables
    cos = cos[None, :, None, :]
    sin = sin[None, :, None, :]
    half = x.shape[-1] // 2
    x1 = x[..., :half].astype(jnp.float32)
    x2 = x[..., half:].astype(jnp.float32)
    return jnp.concatenate([x1 * cos - x2 * sin, x2 * cos + x1 * sin], axis=-1).astype(x.dtype)


def _dense_attention(q, k, v, scale):
    b, sq, h, d = q.shape
    dv = v.shape[-1]
    nb = sq // QBLK
    qb = jnp.moveaxis(q.reshape(b, nb, QBLK, h, d), 1, 0)

    def block(qi):
        s = jnp.einsum('bqhd,bkhd->bhqk', qi, k, preferred_element_type=jnp.float32) * scale
        p = jax.nn.softmax(s, axis=-1).astype(v.dtype)
        return jnp.einsum('bhqk,bkhd->bqhd', p, v)

    out = lax.map(block, qb)
    return jnp.moveaxis(out, 0, 1).reshape(b, sq, h, dv)


def _sink_softmax(s, sink_g):
    sk = jnp.broadcast_to(sink_g.astype(jnp.float32)[None, :, :, None, None], s.shape[:-1] + (1,))
    p = jax.nn.softmax(jnp.concatenate([s, sk], axis=-1), axis=-1)
    return p[..., :-1]


def _window_attention_with_sink(q, k, v, k_ctx, v_ctx, sink):
    b, s_len, hq, d = q.shape
    hkv = k.shape[2]
    g = hq // hkv
    dv = v.shape[-1]
    nb = s_len // QBLK
    kb_len = QBLK + 2 * SWA_WINDOW
    scale = d ** -0.5
    pad = ((0, 0), (SWA_WINDOW, SWA_WINDOW), (0, 0), (0, 0))
    kp = jnp.pad(k, pad)
    vp = jnp.pad(v, pad)
    qb = jnp.moveaxis(q.reshape(b, nb, QBLK, hkv, g, d), 1, 0)
    sink_g = sink.reshape(hkv, g)

    def block(args):
        i, qi = args
        start = i * QBLK
        kb = lax.dynamic_slice_in_dim(kp, start, kb_len, axis=1)
        vb = lax.dynamic_slice_in_dim(vp, start, kb_len, axis=1)
        qpos = start + jnp.arange(QBLK)
        kpos = start - SWA_WINDOW + jnp.arange(kb_len)
        mask = (jnp.abs(qpos[:, None] - kpos[None, :]) <= SWA_WINDOW) & ((kpos >= 0) & (kpos < s_len))[None, :]
        s_loc = jnp.einsum('bqhgd,bkhd->bhgqk', qi, kb, preferred_element_type=jnp.float32) * scale
        s_loc = jnp.where(mask, s_loc, NEG_INF)
        s_ctx = jnp.einsum('bqhgd,bkhd->bhgqk', qi, k_ctx, preferred_element_type=jnp.float32) * scale
        p = _sink_softmax(jnp.concatenate([s_loc, s_ctx], axis=-1), sink_g).astype(v.dtype)
        return (jnp.einsum('bhgqk,bkhd->bqhgd', p[..., :kb_len], vb)
                + jnp.einsum('bhgqk,bkhd->bqhgd', p[..., kb_len:], v_ctx))

    out = lax.map(block, (jnp.arange(nb), qb))
    return jnp.moveaxis(out, 0, 1).reshape(b, s_len, hq * dv)


def _context_sink_attention(q, k, v, sink):
    b, c_len, hq, d = q.shape
    hkv = k.shape[2]
    g = hq // hkv
    qg = q.reshape(b, c_len, hkv, g, d)
    s = jnp.einsum('bqhgd,bkhd->bhgqk', qg, k, preferred_element_type=jnp.float32) * (d ** -0.5)
    p = _sink_softmax(s, sink.reshape(hkv, g)).astype(v.dtype)
    return jnp.einsum('bhgqk,bkhd->bqhgd', p, v).reshape(b, c_len, hq * v.shape[-1])


def _swa_mla_mixer(h_lat, h_ctx, w_in, q_norm, w_uq, kv_norm, w_ukv, sink, w_out, rope_a, rope_b, ctx_out):
    def project(h):
        b, n, _ = h.shape
        aq, ak, av, cq, ckv, kr = _split(h @ w_in, AB_IN_WIDTHS)
        aq = aq.reshape(b, n, SWA_HEADS, SWA_HEAD_DIM)
        ak = ak.reshape(b, n, SWA_KV_HEADS, SWA_HEAD_DIM)
        av = av.reshape(b, n, SWA_KV_HEADS, SWA_HEAD_DIM)
        q = (_rmsnorm(cq, q_norm) @ w_uq).reshape(b, n, MLA_HEADS, MLA_NOPE_DIM + MLA_ROPE_DIM)
        kv = (_rmsnorm(ckv, kv_norm) @ w_ukv).reshape(b, n, MLA_HEADS, MLA_NOPE_DIM + MLA_V_DIM)
        return (aq, ak, av, q[..., :MLA_NOPE_DIM], q[..., MLA_NOPE_DIM:],
                kv[..., :MLA_NOPE_DIM], kr[:, :, None, :], kv[..., MLA_NOPE_DIM:])

    aq_l, ak_l, av_l, qn_l, qr_l, kn_l, kr_l, mv_l = project(h_lat)
    aq_c, ak_c, av_c, qn_c, qr_c, kn_c, kr_c, mv_c = project(h_ctx)
    aq_l = _rope(aq_l, rope_a)
    ak_l = _rope(ak_l, rope_a)
    qr_l = _rope(qr_l, rope_b)
    kr_l = _rope(kr_l, rope_b)

    def mla_qk(qn, qr, kn, kr):
        q = jnp.concatenate([qn, qr], axis=-1)
        k = jnp.concatenate([kn, jnp.broadcast_to(kr, kn.shape[:-1] + (MLA_ROPE_DIM,))], axis=-1)
        return q, k

    q_l, k_l = mla_qk(qn_l, qr_l, kn_l, kr_l)
    q_c, k_c = mla_qk(qn_c, qr_c, kn_c, kr_c)
    mla_scale = (MLA_NOPE_DIM + MLA_ROPE_DIM) ** -0.5
    b, s_len = h_lat.shape[0], h_lat.shape[1]
    o_a = _window_attention_with_sink(aq_l, ak_l, av_l, ak_c, av_c, sink)
    o_b = _dense_attention(q_l, jnp.concatenate([k_l, k_c], axis=1), jnp.concatenate([mv_l, mv_c], axis=1), mla_scale)
    out_lat = jnp.concatenate([o_a, o_b.reshape(b, s_len, -1)], axis=-1) @ w_out
    if not ctx_out:
        return out_lat, None
    c_len = h_ctx.shape[1]
    o_a_c = _context_sink_attention(aq_c, ak_c, av_c, sink)
    o_b_c = _dense_attention(q_c, k_c, mv_c, mla_scale).reshape(b, c_len, -1)
    out_ctx = jnp.concatenate([o_a_c, o_b_c], axis=-1) @ w_out
    return out_lat, out_ctx


def _diff_mixer(h_lat, h_ctx, w_in, lq1, lk1, lq2, lk2, subln, w_out, lambda_init, rope, ctx_out):
    def project(h):
        b, n, _ = h.shape
        q, k, v = _split(h @ w_in, DIFF_IN_WIDTHS)
        q = q.reshape(b, n, DIFF_HEADS, 2, DIFF_HEAD_DIM)
        k = k.reshape(b, n, DIFF_HEADS, 2, DIFF_HEAD_DIM)
        v = v.reshape(b, n, DIFF_HEADS, 2 * DIFF_HEAD_DIM)
        return q[..., 0, :], q[..., 1, :], k[..., 0, :], k[..., 1, :], v

    q1_l, q2_l, k1_l, k2_l, v_l = project(h_lat)
    q1_c, q2_c, k1_c, k2_c, v_c = project(h_ctx)
    q1_l = _rope(q1_l, rope)
    q2_l = _rope(q2_l, rope)
    k1_l = _rope(k1_l, rope)
    k2_l = _rope(k2_l, rope)
    lam = (jnp.exp(jnp.sum(lq1.astype(jnp.float32) * lk1.astype(jnp.float32)))
           - jnp.exp(jnp.sum(lq2.astype(jnp.float32) * lk2.astype(jnp.float32))) + lambda_init)
    scale = DIFF_HEAD_DIM ** -0.5

    def combine(a1, a2):
        o = a1 - lam.astype(a1.dtype) * a2
        o = _rmsnorm(o, subln, DIFF_EPS) * (1.0 - lambda_init)
        return o.reshape(o.shape[0], o.shape[1], -1) @ w_out

    k1_all = jnp.concatenate([k1_l, k1_c], axis=1)
    k2_all = jnp.concatenate([k2_l, k2_c], axis=1)
    v_all = jnp.concatenate([v_l, v_c], axis=1)
    out_lat = combine(_dense_attention(q1_l, k1_all, v_all, scale), _dense_attention(q2_l, k2_all, v_all, scale))
    if not ctx_out:
        return out_lat, None
    out_ctx = combine(_dense_attention(q1_c, k1_c, v_c, scale), _dense_attention(q2_c, k2_c, v_c, scale))
    return out_lat, out_ctx


def _hier_moe(h, w_group, b_group, w_expert, b_expert, w1, w3, w2):
    n_tok, d = h.shape
    g_logits = jnp.dot(h, w_group, preferred_element_type=jnp.float32) + b_group.astype(jnp.float32)
    g_prob = jax.nn.softmax(g_logits, axis=-1)
    grp = jnp.argmax(g_logits, axis=-1).astype(jnp.int32)
    p_grp = jnp.take_along_axis(g_prob, grp[:, None], axis=-1)
    e_logits = (jnp.dot(h, w_expert, preferred_element_type=jnp.float32) + b_expert.astype(jnp.float32)).reshape(n_tok, N_GROUPS, EXPERTS_PER_GROUP)
    e_logits = jnp.take_along_axis(e_logits, grp[:, None, None], axis=1)[:, 0]
    top_p, top_i = lax.top_k(jax.nn.softmax(e_logits, axis=-1), TOP_K)
    gate = p_grp * top_p / jnp.sum(top_p, axis=-1, keepdims=True)
    eid = grp[:, None] * EXPERTS_PER_GROUP + top_i.astype(jnp.int32)

    n_assign = n_tok * TOP_K
    flat_e = eid.reshape(n_assign)
    flat_tok = jnp.repeat(jnp.arange(n_tok, dtype=jnp.int32), TOP_K)
    flat_gate = gate.reshape(n_assign)
    order = jnp.argsort(flat_e)
    se = flat_e[order]
    stok = flat_tok[order]
    sgate = flat_gate[order]
    counts = jnp.zeros((N_EXPERTS,), jnp.int32).at[flat_e].add(1)
    padded = (counts + MOE_BLK - 1) // MOE_BLK * MOE_BLK
    pad_end = jnp.cumsum(padded)
    pad_start = pad_end - padded
    start = jnp.cumsum(counts) - counts
    dest = pad_start[se] + (jnp.arange(n_assign, dtype=jnp.int32) - start[se])
    n_blocks = (n_assign + N_EXPERTS * (MOE_BLK - 1) + MOE_BLK - 1) // MOE_BLK
    n_slots = n_blocks * MOE_BLK
    slot_tok = jnp.full((n_slots,), n_tok, jnp.int32).at[dest].set(stok)
    h_pad = jnp.concatenate([h, jnp.zeros((1, d), h.dtype)], axis=0)
    xb = h_pad[slot_tok].reshape(n_blocks, MOE_BLK, d)
    block_e = jnp.minimum(jnp.searchsorted(pad_end, jnp.arange(n_blocks, dtype=jnp.int32) * MOE_BLK, side='right'), N_EXPERTS - 1)

    def expert_block(args):
        xi, e = args
        return (jax.nn.silu(xi @ w1[e]) * (xi @ w3[e])) @ w2[e]

    yb = lax.map(expert_block, (xb, block_e)).reshape(n_slots, d)
    contrib = yb[dest] * sgate[:, None].astype(yb.dtype)
    return jnp.zeros((n_tok, d), h.dtype).at[stok].add(contrib)


def setup_inputs(seed: int = 0) -> dict:
    key = jax.random.key(seed)
    ks = jax.random.split(key, 30)
    d = D_MODEL
    n_even = (DEPTH + 1) // 2
    n_odd = DEPTH // 2

    def nrm(k, shape, scale):
        return jax.random.normal(k, shape, jnp.float32) * scale

    def gain(k, shape):
        return 1.0 + 0.1 * jax.random.normal(k, shape, jnp.float32)

    return {
        'x': nrm(ks[0], (BATCH, SEQ, d), 1.0),
        'c': nrm(ks[1], (BATCH, d), 1.0),
        'ctx': nrm(ks[2], (BATCH, CTX_LEN, d), 1.0),
        'c_ctx': nrm(ks[3], (d,), 1.0),
        'norm_mix': gain(ks[4], (DEPTH, d)),
        'norm_ffn': gain(ks[5], (DEPTH, d)),
        'ada_w': nrm(ks[6], (DEPTH, d, 6 * d), 0.5 * d ** -0.5),
        'ada_b': nrm(ks[7], (DEPTH, 6 * d), 0.02),
        'ab_w_in': nrm(ks[8], (n_even, d, AB_IN_WIDTH), d ** -0.5),
        'mla_q_norm': gain(ks[9], (n_even, MLA_Q_RANK)),
        'mla_w_uq': nrm(ks[10], (n_even, MLA_Q_RANK, MLA_HEADS * (MLA_NOPE_DIM + MLA_ROPE_DIM)), MLA_Q_RANK ** -0.5),
        'mla_kv_norm': gain(ks[11], (n_even, MLA_KV_RANK)),
        'mla_w_ukv': nrm(ks[12], (n_even, MLA_KV_RANK, MLA_HEADS * (MLA_NOPE_DIM + MLA_V_DIM)), MLA_KV_RANK ** -0.5),
        'swa_sink': nrm(ks[13], (n_even, SWA_HEADS), 1.0),
        'ab_w_out': nrm(ks[14], (n_even, AB_OUT_WIDTH, d), AB_OUT_WIDTH ** -0.5),
        'diff_w_in': nrm(ks[15], (n_odd, d, DIFF_IN_WIDTH), d ** -0.5),
        'diff_lambda_q1': nrm(ks[16], (n_odd, DIFF_HEAD_DIM), 0.1),
        'diff_lambda_k1': nrm(ks[17], (n_odd, DIFF_HEAD_DIM), 0.1),
        'diff_lambda_q2': nrm(ks[18], (n_odd, DIFF_HEAD_DIM), 0.1),
        'diff_lambda_k2': nrm(ks[19], (n_odd, DIFF_HEAD_DIM), 0.1),
        'diff_subln': gain(ks[20], (n_odd, 2 * DIFF_HEAD_DIM)),
        'diff_w_out': nrm(ks[21], (n_odd, DIFF_OUT_WIDTH, d), DIFF_OUT_WIDTH ** -0.5),
        'router_group_w': nrm(ks[22], (DEPTH, d, N_GROUPS), d ** -0.5),
        'router_group_b': nrm(ks[23], (DEPTH, N_GROUPS), 0.01),
        'router_expert_w': nrm(ks[24], (DEPTH, d, N_EXPERTS), d ** -0.5),
        'router_expert_b': nrm(ks[25], (DEPTH, N_EXPERTS), 0.01),
        'expert_w1': nrm(ks[26], (DEPTH, N_EXPERTS, d, EXPERT_FF), d ** -0.5),
        'expert_w3': nrm(ks[27], (DEPTH, N_EXPERTS, d, EXPERT_FF), d ** -0.5),
        'expert_w2': nrm(ks[28], (DEPTH, N_EXPERTS, EXPERT_FF, d), EXPERT_FF ** -0.5),
        'final_norm': gain(ks[29], (d,)),
    }


def reference(x, c, ctx, c_ctx, norm_mix, norm_ffn, ada_w, ada_b, ab_w_in, mla_q_norm, mla_w_uq, mla_kv_norm, mla_w_ukv, swa_sink, ab_w_out, diff_w_in, diff_lambda_q1, diff_lambda_k1, diff_lambda_q2, diff_lambda_k2, diff_subln, diff_w_out, router_group_w, router_group_b, router_expert_w, router_expert_b, expert_w1, expert_w3, expert_w2, final_norm):
    b, s_len, d = x.shape
    rope_64 = _axial_rope_tables(s_len, SWA_HEAD_DIM)
    rope_32 = _axial_rope_tables(s_len, MLA_ROPE_DIM)
    sc = jax.nn.silu(c)
    scc = jax.nn.silu(c_ctx)
    x_lat = x
    x_ctx = ctx
    n_lat = b * s_len
    for l in range(DEPTH):
        last = l == DEPTH - 1
        mod_l = [m[:, None, :] for m in jnp.split(sc @ ada_w[l] + ada_b[l], 6, axis=-1)]
        mod_c = jnp.split(scc @ ada_w[l] + ada_b[l], 6, axis=-1)
        h_lat = _modulate(_rmsnorm(x_lat, norm_mix[l]), mod_l[0], mod_l[1])
        h_ctx = _modulate(_rmsnorm(x_ctx, norm_mix[l]), mod_c[0], mod_c[1])
        j = l // 2
        if l % 2 == 0:
            o_lat, o_ctx = _swa_mla_mixer(h_lat, h_ctx, ab_w_in[j], mla_q_norm[j], mla_w_uq[j], mla_kv_norm[j], mla_w_ukv[j], swa_sink[j], ab_w_out[j], rope_64, rope_32, not last)
        else:
            lambda_init = 0.8 - 0.6 * math.exp(-0.3 * l)
            o_lat, o_ctx = _diff_mixer(h_lat, h_ctx, diff_w_in[j], diff_lambda_q1[j], diff_lambda_k1[j], diff_lambda_q2[j], diff_lambda_k2[j], diff_subln[j], diff_w_out[j], lambda_init, rope_64, not last)
        x_lat = x_lat + mod_l[2] * o_lat
        h_lat = _modulate(_rmsnorm(x_lat, norm_ffn[l]), mod_l[3], mod_l[4])
        if last:
            tokens = h_lat.reshape(n_lat, d)
        else:
            x_ctx = x_ctx + mod_c[2] * o_ctx
            h_ctx = _modulate(_rmsnorm(x_ctx, norm_ffn[l]), mod_c[3], mod_c[4])
            tokens = jnp.concatenate([h_lat.reshape(n_lat, d), h_ctx.reshape(-1, d)], axis=0)
        y = _hier_moe(tokens, router_group_w[l], router_group_b[l], router_expert_w[l], router_expert_b[l], expert_w1[l], expert_w3[l], expert_w2[l])
        x_lat = x_lat + mod_l[5] * y[:n_lat].reshape(b, s_len, d)
        if not last:
            x_ctx = x_ctx + mod_c[5] * y[n_lat:].reshape(x_ctx.shape)
    return _rmsnorm(x_lat, final_norm)
```

```cpp
#include <hip/hip_runtime.h>
#include <cstdio>
#include <cstdint>

#define LAS __attribute__((address_space(3)))
#define GAS __attribute__((address_space(1)))
typedef unsigned short bf16_t;
typedef short bf16x8 __attribute__((ext_vector_type(8)));
typedef short s16x4 __attribute__((ext_vector_type(4)));
typedef float f32x4 __attribute__((ext_vector_type(4)));
typedef float f32x16 __attribute__((ext_vector_type(16)));
typedef unsigned u32x4 __attribute__((ext_vector_type(4)));
typedef unsigned u32x2 __attribute__((ext_vector_type(2)));
typedef LAS unsigned char* lptr;

#ifndef REP_ATT
#define REP_ATT 1
#endif
#ifndef REP_PRO
#define REP_PRO 1
#endif
#ifndef REP_MOE
#define REP_MOE 1
#endif
#ifndef REP_WIN
#define REP_WIN 1
#endif
#ifndef REP_ROW
#define REP_ROW 1
#endif
constexpr int DM = 1024, NB = 16, SEQ = 4096, CTXL = 256, DEPTH = 4;
constexpr int NLAT = NB * SEQ, NCTX = NB * CTXL, MTOT = NLAT + NCTX;
constexpr int NEXP = 32, EFF = 512;
constexpr int MAXSLOTS = 147456;
constexpr int MAXTILES = MAXSLOTS / 256;
constexpr int ZROW = MTOT;
constexpr int NWAVES = 8, NTHREADS = 512;
constexpr float NORM_EPS = 1e-6f, DIFF_EPS = 1e-5f;
constexpr float LOG2E = 1.4426950408889634f;

constexpr size_t al256(size_t x) { return (x + 255) & ~(size_t)255; }
constexpr size_t WS_CTL = 0, CTL_BYTES = 1u << 20, CTL_ZERO = 131072;
constexpr size_t WS_MODP = WS_CTL + CTL_BYTES;
constexpr size_t MOD_ELEMS = (size_t)DEPTH * 17 * 6144;
constexpr size_t WS_MOD = WS_MODP + al256(4 * MOD_ELEMS * 4);
constexpr size_t WS_ROPE64 = WS_MOD + al256(MOD_ELEMS * 4);
constexpr size_t WS_ROPE32 = WS_ROPE64 + (size_t)2 * SEQ * 32 * 4;
constexpr size_t WS_WINE = WS_ROPE32 + (size_t)2 * SEQ * 16 * 4;
constexpr size_t WS_WUQ = WS_WINE + (size_t)2 * 1280 * 1024 * 2;
constexpr size_t WS_WUKV = WS_WUQ + (size_t)2 * 768 * 256 * 2;
constexpr size_t WS_WOUTE = WS_WUKV + (size_t)2 * 1024 * 256 * 2;
constexpr size_t WS_WINO = WS_WOUTE + (size_t)2 * 1024 * 1024 * 2;
constexpr size_t WS_WOUTO = WS_WINO + (size_t)2 * 3072 * 1024 * 2;
constexpr size_t WS_W13 = WS_WOUTO + (size_t)2 * 1024 * 1024 * 2;
constexpr size_t WS_W2T = WS_W13 + (size_t)DEPTH * NEXP * 1024 * 1024 * 2;
constexpr size_t WS_XCTX = WS_W2T + (size_t)DEPTH * NEXP * 1024 * 512 * 2;
constexpr size_t WS_H = WS_XCTX + (size_t)NCTX * DM * 4;
constexpr size_t WS_BIG = WS_H + al256((size_t)(MTOT + 1) * DM * 2);
constexpr size_t BIG_BYTES = (size_t)MAXSLOTS * (512 + 1024) * 2;
constexpr size_t BG_AQ = 0;
constexpr size_t BG_AKV = BG_AQ + (size_t)MTOT * 512 * 2;
constexpr size_t BG_CQ = BG_AKV + (size_t)MTOT * 256 * 2;
constexpr size_t BG_CKVR = BG_CQ + (size_t)MTOT * 256 * 2;
constexpr size_t BG_QM = BG_CKVR + (size_t)MTOT * 256 * 2;
constexpr size_t BG_KVM = BG_QM + (size_t)MTOT * 768 * 2;
static_assert(BG_KVM + (size_t)MTOT * 1024 * 2 <= BIG_BYTES, "even view fits");
static_assert((size_t)MTOT * 3072 * 2 <= BIG_BYTES, "odd view fits");
constexpr size_t BG_ACT = 0;
constexpr size_t BG_YB = (size_t)MAXSLOTS * 512 * 2;
constexpr size_t WS_RSQ = WS_BIG + BIG_BYTES;
constexpr size_t WS_TOKE = WS_RSQ + (size_t)MTOT * 8 * 4;
constexpr size_t WS_TOKG = WS_TOKE + (size_t)MTOT * 2 * 4;
constexpr size_t WS_TOKP = WS_TOKG + (size_t)MTOT * 2 * 4;
constexpr size_t WS_TOKD = WS_TOKP + (size_t)MTOT * 2 * 4;
constexpr size_t WS_SLOTT = WS_TOKD + (size_t)MTOT * 2 * 4;
constexpr size_t WS_SLOTG = WS_SLOTT + (size_t)MAXSLOTS * 4;
constexpr size_t WS_WGB = WS_SLOTG + (size_t)MAXSLOTS * 4;
constexpr size_t WS_RS16 = WS_WGB + (size_t)256 * 32 * 4;
constexpr size_t WS_END = WS_RS16 + (size_t)MTOT * 16 * 4;
constexpr int CW_BAR = 4096;
constexpr int CW_CNT = 16384;
static_assert((CW_BAR + 3456) * 4 <= 131072 && (CW_CNT + DEPTH * 32 * 16) * 4 <= 131072, "control words inside the per-call memset");

constexpr int LDS_MISC = 147456;
constexpr int LDS_BYTES = 155648;
constexpr int LDS_PB = LDS_BYTES - 1024;

__device__ __forceinline__ unsigned f2bf(float f) { unsigned u = __builtin_bit_cast(unsigned, f); return (u + 0x7fffu + ((u >> 16) & 1u)) >> 16; }
typedef float f32x2_t __attribute__((ext_vector_type(2))); typedef __bf16 bf16x2_t __attribute__((ext_vector_type(2)));
__device__ __forceinline__ unsigned pk2(float lo, float hi) { const f32x2_t v = {lo, hi}; const bf16x2_t b = __builtin_convertvector(v, bf16x2_t); return __builtin_bit_cast(unsigned, b); }
__device__ __forceinline__ float bf2f(unsigned short b) { return __builtin_bit_cast(float, ((unsigned)b) << 16); }
__device__ __forceinline__ float bflo(unsigned w) { return __builtin_bit_cast(float, w << 16); }
__device__ __forceinline__ float bfhi(unsigned w) { return __builtin_bit_cast(float, w & 0xffff0000u); }
template <int MASK> __device__ __forceinline__ float xshfl(float v) {
    if (MASK == 32) { const auto rr = __builtin_amdgcn_permlane32_swap(__builtin_bit_cast(unsigned, v), __builtin_bit_cast(unsigned, v), false, false);
        const unsigned a = rr[0], b = rr[1]; const unsigned own = __builtin_bit_cast(unsigned, v); return __builtin_bit_cast(float, a ^ b ^ own); }
    else return __builtin_bit_cast(float, __builtin_amdgcn_ds_swizzle(__builtin_bit_cast(int, v), (MASK << 10) | 0x1f));
}
__device__ __forceinline__ float wave_sum(float v) {
    v += xshfl<1>(v); v += xshfl<2>(v); v += xshfl<4>(v); v += xshfl<8>(v); v += xshfl<16>(v); v += xshfl<32>(v);
    return v;
}
__device__ __forceinline__ int opaque_tid(int wv) { int t; asm volatile("v_mbcnt_lo_u32_b32 %0, -1, 0\n\tv_mbcnt_hi_u32_b32 %0, -1, %0" : "=v"(t)); return t | (wv << 6); }
__device__ __forceinline__ int opaque_s(int x) { asm volatile("" : "+s"(x)); return x; }
__device__ __forceinline__ int crow(int r, int hi) { return (r & 3) + 8 * (r >> 2) + 4 * hi; }
__device__ __forceinline__ unsigned char* parg(lptr lds, int i) {
    int pbo = LDS_PB; asm volatile("" : "+v"(pbo));
    const LAS unsigned* p = (const LAS unsigned*)(lds + pbo) + 2 * i;
    const unsigned lo = __builtin_amdgcn_readfirstlane(p[0]), hi = __builtin_amdgcn_readfirstlane(p[1]);
    return (unsigned char*)(((unsigned long long)hi << 32) | lo);
}
__device__ __forceinline__ const float* pin(lptr lds, int i) { return (const float*)parg(lds, i); }

#define XB_TMO      128
#define XB_XCNT(j)  (256  + 64 * (j))
#define XB_XSUB(j)  (1280 + 64 * (j))
#define XB_XGEN(j)  (2304 + 64 * (j))
#define XB_TOP      3328
#define XB_TOPGEN   3392
#define XCD_BAR_WORDS 3456
#define XB_SPIN_CAP (1u << 22)
__device__ __forceinline__ unsigned xb_ld(unsigned* p)              { return __hip_atomic_load(p, __ATOMIC_RELAXED, __HIP_MEMORY_SCOPE_AGENT); }
__device__ __forceinline__ unsigned xb_add(unsigned* p, unsigned v) { return __hip_atomic_fetch_add(p, v, __ATOMIC_RELAXED, __HIP_MEMORY_SCOPE_AGENT); }
__device__ __forceinline__ unsigned xb_xcc_id() { return (unsigned)__builtin_amdgcn_s_getreg((3 << 11) | 20) & 0xFu; }
#define XB_SPIN(cond, bar) do { unsigned _sp = 0; while (cond) { __builtin_amdgcn_s_sleep(1); \
    if ((++_sp & 255u) == 0u) { if (xb_ld(&(bar)[XB_TMO])) break; if (_sp > XB_SPIN_CAP) { atomicAdd(&(bar)[XB_TMO], 1u); break; } } } } while (0)
struct XcdBarrier { unsigned* bar; unsigned x; volatile LAS unsigned* st; };
__device__ __forceinline__ XcdBarrier xcd_barrier_post(unsigned* bar, volatile LAS unsigned* st, int wv) {
    XcdBarrier b; b.bar = bar; b.x = xb_xcc_id(); b.st = st;
    if (opaque_tid(wv) == 0) (void)xb_add(&bar[XB_XCNT(b.x)], 1u);
    return b;
}
__device__ __forceinline__ void xcd_barrier_complete(unsigned* bar, unsigned x, unsigned& nloc, unsigned& nx) {
    const unsigned G = gridDim.x * gridDim.y * gridDim.z;
    unsigned sum, cnt, mine, sp = 0u;
    for (;;) {
        sum = 0u; cnt = 0u; mine = 0u;
#pragma unroll
        for (unsigned j = 0; j < 16; ++j) { const unsigned c = xb_ld(&bar[XB_XCNT(j)]); sum += c; cnt += (c > 0u) ? 1u : 0u; mine = (j == x) ? c : mine; }
        if (sum == G) break;
        __builtin_amdgcn_s_sleep(1);
        if ((++sp & 255u) == 0u) { if (xb_ld(&bar[XB_TMO])) break; if (sp > XB_SPIN_CAP) { atomicAdd(&bar[XB_TMO], 1u); break; } }
    }
    nloc = mine > 0u ? mine : 1u; nx = cnt > 0u ? cnt : 1u;
}
__device__ __forceinline__ void xcd_barrier(const XcdBarrier& b, int wv) {
    asm volatile("s_waitcnt vmcnt(0)" ::: "memory");
    __syncthreads();
    if (opaque_tid(wv) == 0) {
        unsigned* bar = b.bar;
        __builtin_amdgcn_s_waitcnt(0);
        unsigned nloc = b.st[0], nx = b.st[1];
        if (nloc == 0u) { xcd_barrier_complete(bar, b.x, nloc, nx); b.st[0] = nloc; b.st[1] = nx; }
        const unsigned old = xb_add(&bar[XB_XSUB(b.x)], 1u);
        const unsigned gen = old / nloc;
        if (old + 1u == (gen + 1u) * nloc) {
            __builtin_amdgcn_fence(__ATOMIC_RELEASE, "agent");
            asm volatile("s_waitcnt vmcnt(0)" ::: "memory");
            const unsigned og = xb_add(&bar[XB_TOP], 1u);
            const unsigned tg = og / nx;
            if (og + 1u == (tg + 1u) * nx) xb_add(&bar[XB_TOPGEN], 1u);
            else XB_SPIN(xb_ld(&bar[XB_TOPGEN]) == tg, bar);
            __builtin_amdgcn_fence(__ATOMIC_ACQUIRE, "agent");
            xb_add(&bar[XB_XGEN(b.x)], 1u);
            asm volatile("s_waitcnt vmcnt(0)" ::: "memory");
        } else {
            XB_SPIN(xb_ld(&bar[XB_XGEN(b.x)]) == gen, bar);
            __builtin_amdgcn_fence(__ATOMIC_ACQUIRE, "agent");
            asm volatile("s_waitcnt vmcnt(0)" ::: "memory");
        }
    }
    __syncthreads();
}

struct Ctx {
    lptr lds;
    int tid, lane, wave, vcu, G;
    const float* const* in;
    float* out; unsigned char* ws;
};
__device__ __forceinline__ float* xrow_ptr(float* out, unsigned char* ws, int row) {
    return row < NLAT ? out + (size_t)row * DM : (float*)(ws + WS_XCTX) + (size_t)(row - NLAT) * DM;
}
__device__ __forceinline__ int mod_r(int row) { return row < NLAT ? (row >> 12) : 16; }

namespace pg8 {
constexpr int BM = 256, BK = 64, HALF = 128, HTB = HALF * BK * 2, STAGE_BYTES = 8 * HTB;
__device__ __forceinline__ int lds_byte(int r, int c) { const int st = (r >> 4) * 2 + (c >> 5), rr = r & 15, cc = c & 31, ob = rr * 64 + cc * 2; return st * 1024 + (ob ^ (((ob >> 9) & 1) << 5)); }
__device__ __forceinline__ void stage_rc(int b, int& R, int& C) { const int st = b / 1024, sb = b % 1024, swz = sb ^ (((sb >> 9) & 1) << 5); R = (st >> 1) * 16 + swz / 64; C = (st & 1) * 32 + (swz % 64) / 2; }
__device__ __forceinline__ int perm32(int rho) { const int n = rho >> 4, i = rho & 15; return 8 * (i >> 2) + 4 * n + (i & 3); }
struct Unit { int pm, pn, aux; };
template <class GD, class Sched, class Epi>
__device__ __forceinline__ void gemm_phase(lptr lds, const GD& G, const Sched& S, const Epi& E, int wv) {
    const int tid = opaque_tid(wv), wid = __builtin_amdgcn_readfirstlane(tid >> 6), lane = tid & 63, wr = wid >> 2, wc = wid & 3, fr = lane & 15, fq = lane >> 4;
    const int K = G.K, nt = K / BK;
    unsigned voffB[2];
#pragma unroll
    for (int i = 0; i < 2; ++i) { int R, C; stage_rc(tid * 16 + i * 8192, R, C); const int Rb = Epi::PERM ? ((R & ~31) + perm32(R & 31)) : R; voffB[i] = (unsigned)(Rb * K + C) * 2u; }
#define PG8_AOFFS(u, o00, o01, o10, o11) do { int R0_, C0_, R1_, C1_; stage_rc(tid * 16, R0_, C0_); stage_rc(tid * 16 + 8192, R1_, C1_); \
        o00 = G.a_off(u, R0_) + C0_ * 2; o01 = G.a_off(u, R1_) + C1_ * 2; o10 = G.a_off(u, HALF + R0_) + C0_ * 2; o11 = G.a_off(u, HALF + R1_) + C1_ * 2; } while (0)
    const size_t kstep = (size_t)(BK * 2);
    const size_t hstep = (size_t)HALF * K * 2;
    const unsigned ldsw = (unsigned)wid * 1024u;
    const int aoff = lds_byte(wr * 64 + fr, fq * 8), boff = lds_byte(wc * 32 + fr, fq * 8);
    const char* const Ab = G.a_base();
#define PG8_SA(b, h) (((b) * 2 + (h)) * HTB)
#define PG8_SB(b, h) ((4 + (b) * 2 + (h)) * HTB)
#define PG8_STAGE_B(bufoff, gbase) do { _Pragma("unroll") for (int _i = 0; _i < 2; ++_i) \
        __builtin_amdgcn_global_load_lds((const unsigned*)((const char*)(gbase) + voffB[_i]), (LAS unsigned*)(lds + (bufoff) + ldsw + _i * 8192), 16, 0, 0); } while (0)
#define PG8_STAGE_A(bufoff, o0, o1, kb) do { const char* ub_ = Ab + (size_t)(kb);     \
        __builtin_amdgcn_global_load_lds((const unsigned*)(ub_ + (o0)), (LAS unsigned*)(lds + (bufoff) + ldsw), 16, 0, 0); \
        __builtin_amdgcn_global_load_lds((const unsigned*)(ub_ + (o1)), (LAS unsigned*)(lds + (bufoff) + ldsw + 8192), 16, 0, 0); } while (0)
#define PG8_LDA(dst, b, h) do { _Pragma("unroll") for (int m = 0; m < 4; ++m) _Pragma("unroll") for (int k = 0; k < 2; ++k) dst[m][k] = *(const LAS bf16x8*)(lds + PG8_SA(b, h) + aoff + m * 2048 + k * 1024); } while (0)
#define PG8_LDB(dst, b, h) do { _Pragma("unroll") for (int n = 0; n < 2; ++n) _Pragma("unroll") for (int k = 0; k < 2; ++k) dst[n][k] = *(const LAS bf16x8*)(lds + PG8_SB(b, h) + boff + n * 2048 + k * 1024); } while (0)
#define PG8_MMA(ai, bj, At, Bt) do { __builtin_amdgcn_s_setprio(1); _Pragma("unroll") for (int m = 0; m < 4; ++m) _Pragma("unroll") for (int n = 0; n < 2; ++n) _Pragma("unroll") for (int k = 0; k < 2; ++k) \
        acc[ai][bj][m][n] = __builtin_amdgcn_mfma_f32_16x16x32_bf16(Bt[n][k], At[m][k], acc[ai][bj][m][n], 0, 0, 0); __builtin_amdgcn_s_setprio(0); } while (0)
#define PG8_WAIT_V(n) asm volatile("s_waitcnt vmcnt(" #n ")" ::: "memory")
#define PG8_WAIT_L(n) asm volatile("s_waitcnt lgkmcnt(" #n ")" ::: "memory")
#define PG8_BAR __builtin_amdgcn_s_barrier()
#define PG8_SCHED __builtin_amdgcn_sched_barrier(0)
    Unit cur, nxt; int ui = 0;
    if (!S.next(0, cur)) return;
    f32x4 acc[2][2][4][2];
    float zf = 0.f; asm volatile("" : "+v"(zf));
#pragma unroll
    for (int a = 0; a < 2; ++a)
#pragma unroll
        for (int b = 0; b < 2; ++b)
#pragma unroll
            for (int m = 0; m < 4; ++m)
#pragma unroll
                for (int n = 0; n < 2; ++n) acc[a][b][m][n] = (f32x4){zf, zf, zf, zf};
    bf16x8 At[4][2], B0[2][2], B1[2][2];
    unsigned c00, c01, c10, c11; PG8_AOFFS(cur, c00, c01, c10, c11);
    const char* cB = G.b_base(cur);
    PG8_STAGE_B(PG8_SB(0, 0), cB); PG8_STAGE_A(PG8_SA(0, 0), c00, c01, 0); PG8_STAGE_B(PG8_SB(0, 1), cB + hstep); PG8_STAGE_A(PG8_SA(0, 1), c10, c11, 0);
    if (wr == 1) PG8_BAR;
    PG8_WAIT_V(4); PG8_BAR;
    PG8_STAGE_B(PG8_SB(1, 0), cB + kstep); PG8_STAGE_A(PG8_SA(1, 0), c00, c01, kstep); PG8_STAGE_B(PG8_SB(1, 1), cB + hstep + kstep);
    PG8_WAIT_V(6); PG8_BAR;
    for (;;) {
        const bool has_next = S.next(ui + 1, nxt);
        const char* nB = has_next ? G.b_base(nxt) : cB;
        for (int t = 0; t < nt; t += 2) {
            const bool last = (t == nt - 2);
            const size_t k1 = (size_t)(t + 1) * kstep;
            const size_t k2 = last ? 0 : (size_t)(t + 2) * kstep, k3 = k2 + kstep;
            unsigned a00 = c00, a01 = c01, a10 = c10, a11 = c11;
            if (last && has_next) PG8_AOFFS(nxt, a00, a01, a10, a11);
            const char* b2 = last ? nB : cB + (size_t)(t + 2) * kstep; const char* b3 = b2 + kstep;
            PG8_LDB(B0, 0, 0); PG8_SCHED; PG8_LDA(At, 0, 0); PG8_STAGE_A(PG8_SA(1, 1), c10, c11, k1);
            PG8_WAIT_L(8); PG8_BAR; PG8_WAIT_L(0); PG8_MMA(0, 0, At, B0); PG8_BAR; PG8_SCHED;
            PG8_LDB(B1, 0, 1); PG8_STAGE_B(PG8_SB(0, 0), b2);
            PG8_BAR; PG8_WAIT_L(0); PG8_MMA(0, 1, At, B1); PG8_BAR;
            PG8_LDA(At, 0, 1); PG8_STAGE_A(PG8_SA(0, 0), a00, a01, k2);
            PG8_BAR; PG8_WAIT_L(0); PG8_MMA(1, 0, At, B0); PG8_BAR; PG8_SCHED;
            PG8_STAGE_B(PG8_SB(0, 1), b2 + hstep);
            PG8_WAIT_V(6); PG8_BAR; PG8_MMA(1, 1, At, B1); PG8_BAR;
            PG8_LDB(B0, 1, 0); PG8_SCHED; PG8_LDA(At, 1, 0); PG8_STAGE_A(PG8_SA(0, 1), a10, a11, k2);
            PG8_WAIT_L(8); PG8_BAR; PG8_WAIT_L(0); PG8_MMA(0, 0, At, B0); PG8_BAR; PG8_SCHED;
            PG8_LDB(B1, 1, 1); PG8_STAGE_B(PG8_SB(1, 0), b3);
            PG8_BAR; PG8_WAIT_L(0); PG8_MMA(0, 1, At, B1); PG8_BAR;
            PG8_LDA(At, 1, 1); PG8_STAGE_A(PG8_SA(1, 0), a00, a01, k3);
            PG8_BAR; PG8_WAIT_L(0); PG8_MMA(1, 0, At, B0); PG8_BAR; PG8_SCHED;
            PG8_STAGE_B(PG8_SB(1, 1), b3 + hstep);
            PG8_WAIT_V(6); PG8_BAR; PG8_MMA(1, 1, At, B1); PG8_BAR;
        }
        { int fr_ = fr, fq_ = fq; asm volatile("" : "+v"(fr_), "+v"(fq_));
          E(acc, cur, wr, wc, fr_, fq_); }
        if (!has_next) break;
#pragma unroll
        for (int a = 0; a < 2; ++a)
#pragma unroll
            for (int b = 0; b < 2; ++b)
#pragma unroll
                for (int m = 0; m < 4; ++m)
#pragma unroll
                    for (int n = 0; n < 2; ++n) acc[a][b][m][n] = (f32x4){zf, zf, zf, zf};
        cur = nxt; cB = nB; PG8_AOFFS(cur, c00, c01, c10, c11); ++ui;
    }
    PG8_WAIT_V(0);
    if (wr == 0) PG8_BAR;
    PG8_BAR;
#undef PG8_AOFFS
#undef PG8_SA
#undef PG8_SB
#undef PG8_STAGE_A
#undef PG8_STAGE_B
#undef PG8_LDA
#undef PG8_LDB
#undef PG8_MMA
#undef PG8_WAIT_V
#undef PG8_WAIT_L
#undef PG8_BAR
#undef PG8_SCHED
}

struct GemmPlain {
    const char* A; const char* Bt; int K; int lda;
    __device__ __forceinline__ const char* a_base() const { return A; }
    __device__ __forceinline__ unsigned a_off(const Unit& u, int r) const { return (unsigned)(((size_t)(u.pm * 256 + r) * lda) * 2); }
    __device__ __forceinline__ const char* b_base(const Unit& u) const { return Bt + (size_t)u.pn * 256 * K * 2; }
};
struct StaticOrder {
    int nM, nN, nwg, G, c;
    __device__ __forceinline__ void init(int nM_, int nN_, int G_, int c_) { nM = nM_; nN = nN_; nwg = nM * nN; G = G_; c = c_; }
    __device__ __forceinline__ bool next(int i, Unit& u) const {
        const long L = (long)i * G + c; if (L >= nwg) return false;
        int wgid = (int)L; { const int q = nwg / 8, r = nwg % 8, xcd = wgid % 8, off = wgid / 8; wgid = (xcd < r ? xcd * (q + 1) : r * (q + 1) + (xcd - r) * q) + off; }
        const int nig = 8 * nN, gid = wgid / nig, fm = gid * 8, gsz = (nM - fm) < 8 ? (nM - fm) : 8;
        u.pm = fm + ((wgid % nig) % gsz); u.pn = (wgid % nig) / gsz; u.aux = 0; return true;
    }
};
}

__device__ __forceinline__ void rope4(f32x4& v0, f32x4& v1, const float* cs, const float* sn) {
    const f32x4 c = *(const f32x4*)cs, s = *(const f32x4*)sn;
    const float a0 = v0[0] * c[0] - v0[1] * s[0], b0 = v0[1] * c[0] + v0[0] * s[0];
    const float a1 = v0[2] * c[1] - v0[3] * s[1], b1 = v0[3] * c[1] + v0[2] * s[1];
    const float a2 = v1[0] * c[2] - v1[1] * s[2], b2 = v1[1] * c[2] + v1[0] * s[2];
    const float a3 = v1[2] * c[3] - v1[3] * s[3], b3 = v1[3] * c[3] + v1[2] * s[3];
    v0 = (f32x4){a0, b0, a1, b1}; v1 = (f32x4){a2, b2, a3, b3};
}
__device__ __forceinline__ void rope4v(f32x4& v0, f32x4& v1, const f32x4& c, const f32x4& s) {
    const float a0 = v0[0] * c[0] - v0[1] * s[0], b0 = v0[1] * c[0] + v0[0] * s[0];
    const float a1 = v0[2] * c[1] - v0[3] * s[1], b1 = v0[3] * c[1] + v0[2] * s[1];
    const float a2 = v1[0] * c[2] - v1[1] * s[2], b2 = v1[1] * c[2] + v1[0] * s[2];
    const float a3 = v1[2] * c[3] - v1[3] * s[3], b3 = v1[3] * c[3] + v1[2] * s[3];
    v0 = (f32x4){a0, b0, a1, b1}; v1 = (f32x4){a2, b2, a3, b3};
}
__device__ __forceinline__ u32x4 pack8(const f32x4& v0, const f32x4& v1) { u32x4 w; w.x = pk2(v0[0], v0[1]); w.y = pk2(v0[2], v0[3]); w.z = pk2(v1[0], v1[1]); w.w = pk2(v1[2], v1[3]); return w; }
__device__ __forceinline__ float sumsq8(const f32x4& v0, const f32x4& v1) { return (v0[0] * v0[0] + v0[1] * v0[1]) + (v0[2] * v0[2] + v0[3] * v0[3]) + (v1[0] * v1[0] + v1[1] * v1[1]) + (v1[2] * v1[2] + v1[3] * v1[3]); }

struct EpiWinEven {
    static constexpr bool PERM = true;
    unsigned char* big; float* rsq; const float* rope64; const float* rope32;
    __device__ __forceinline__ void operator()(const f32x4 (&acc)[2][2][4][2], const pg8::Unit& u, int wr, int wc, int fr, int fq) const {
        const int row0 = u.pm * 256 + wr * 64 + fr;
        const bool lat = (u.pm * 256) < NLAT;
        bf16_t* dst; int ldc;
        if (u.pn < 2) { dst = (bf16_t*)(big + BG_AQ) + u.pn * 256; ldc = 512; }
        else if (u.pn == 2) { dst = (bf16_t*)(big + BG_AKV); ldc = 256; }
        else if (u.pn == 3) { dst = (bf16_t*)(big + BG_CQ); ldc = 256; }
        else { dst = (bf16_t*)(big + BG_CKVR); ldc = 256; }
        const bool r64 = lat && (u.pn <= 2), r32 = lat && (u.pn == 4) && (wc == 0);
        const float* tb = r64 ? rope64 : rope32; const int w = r64 ? 32 : 16; const int i0 = r64 ? (((wc & 1) * 32 + 8 * fq) >> 1) : 4 * fq;
#pragma unroll
        for (int ai = 0; ai < 2; ++ai) {
            f32x4 cs[4], sn[4];
#pragma unroll
            for (int mh = 0; mh < 2; ++mh) {
            if (r64 || r32) {
#pragma unroll
                for (int m = 2 * mh; m < 2 * mh + 2; ++m) { const int sp = (row0 + ai * 128 + m * 16) & (SEQ - 1); cs[m] = *(const f32x4*)(tb + sp * w + i0); sn[m] = *(const f32x4*)(tb + SEQ * w + sp * w + i0); }
            }
#pragma unroll
            for (int m = 2 * mh; m < 2 * mh + 2; ++m) {
                const int row = row0 + ai * 128 + m * 16;
                float ssq = 0.f;
#pragma unroll
                for (int bj = 0; bj < 2; ++bj) {
                    const int cl = bj * 128 + wc * 32 + 8 * fq;
                    f32x4 v0 = acc[ai][bj][m][0], v1 = acc[ai][bj][m][1];
                    if (u.pn < 2 || (u.pn == 2 && bj == 0)) { if (r64) rope4v(v0, v1, cs[m], sn[m]); if (u.pn < 2) { v0 = v0 * (0.125f * LOG2E); v1 = v1 * (0.125f * LOG2E); } }
                    else if (u.pn == 3) { ssq += sumsq8(v0, v1); }
                    else if (u.pn == 4) { if (bj == 0) ssq += sumsq8(v0, v1); else if (r32) rope4v(v0, v1, cs[m], sn[m]); }
                    *(u32x4*)(dst + (size_t)row * ldc + cl) = pack8(v0, v1);
                }
                if (u.pn >= 3) { ssq += xshfl<16>(ssq); ssq += xshfl<32>(ssq); if (fq == 0) rsq[(size_t)row * 8 + (u.pn - 3) * 4 + wc] = ssq; }
            }
            }
        }
    }
};
struct EpiUq {
    static constexpr bool PERM = true;
    bf16_t* qm; const float* rsq; const float* rope32;
    __device__ __forceinline__ void operator()(const f32x4 (&acc)[2][2][4][2], const pg8::Unit& u, int wr, int wc, int fr, int fq) const {
        const int row0 = u.pm * 256 + wr * 64 + fr; const bool lat = (u.pm * 256) < NLAT;
        const int colb0 = u.pn * 256 + wc * 32 + 8 * fq, colb1 = colb0 + 128;
        const int d0 = colb0 % 96, d1 = colb1 % 96;
        const bool rp0 = lat && d0 >= 64, rp1 = lat && d1 >= 64;
        const int i00 = rp0 ? ((d0 - 64) >> 1) : 0, i01 = rp1 ? ((d1 - 64) >> 1) : 0;
#pragma unroll
        for (int ai = 0; ai < 2; ++ai) {
            f32x4 pq[4], c0[4], s0[4], c1[4], s1[4];
#pragma unroll
            for (int m = 0; m < 4; ++m) { const int row = row0 + ai * 128 + m * 16; const int sp = row & (SEQ - 1);
                pq[m] = *(const f32x4*)(rsq + (size_t)row * 8);
                c0[m] = *(const f32x4*)(rope32 + sp * 16 + i00); s0[m] = *(const f32x4*)(rope32 + SEQ * 16 + sp * 16 + i00);
                c1[m] = *(const f32x4*)(rope32 + sp * 16 + i01); s1[m] = *(const f32x4*)(rope32 + SEQ * 16 + sp * 16 + i01); }
#pragma unroll
            for (int m = 0; m < 4; ++m) {
                const int row = row0 + ai * 128 + m * 16;
                const float rs = __builtin_amdgcn_rsqf(((pq[m][0] + pq[m][1]) + (pq[m][2] + pq[m][3])) * (1.0f / 256.0f) + NORM_EPS) * (0.10206207261596575f * LOG2E);
                { f32x4 v0 = acc[ai][0][m][0] * rs, v1 = acc[ai][0][m][1] * rs; if (rp0) rope4v(v0, v1, c0[m], s0[m]); *(u32x4*)(qm + (size_t)row * 768 + colb0) = pack8(v0, v1); }
                { f32x4 v0 = acc[ai][1][m][0] * rs, v1 = acc[ai][1][m][1] * rs; if (rp1) rope4v(v0, v1, c1[m], s1[m]); *(u32x4*)(qm + (size_t)row * 768 + colb1) = pack8(v0, v1); }
            }
        }
    }
};
struct EpiUkv {
    static constexpr bool PERM = true;
    bf16_t* kvm; const float* rsq;
    __device__ __forceinline__ void operator()(const f32x4 (&acc)[2][2][4][2], const pg8::Unit& u, int wr, int wc, int fr, int fq) const {
        const int row0 = u.pm * 256 + wr * 64 + fr;
        f32x4 pq[2][4];
#pragma unroll
        for (int ai = 0; ai < 2; ++ai)
#pragma unroll
            for (int m = 0; m < 4; ++m) pq[ai][m] = *(const f32x4*)(rsq + (size_t)(row0 + ai * 128 + m * 16) * 8 + 4);
#pragma unroll
        for (int ai = 0; ai < 2; ++ai)
#pragma unroll
            for (int m = 0; m < 4; ++m) {
                const int row = row0 + ai * 128 + m * 16; const f32x4 p = pq[ai][m];
                const float rs = __builtin_amdgcn_rsqf(((p[0] + p[1]) + (p[2] + p[3])) * (1.0f / 128.0f) + NORM_EPS);
#pragma unroll
                for (int bj = 0; bj < 2; ++bj) {
                    const int col = u.pn * 256 + bj * 128 + wc * 32 + 8 * fq;
                    const f32x4 v0 = acc[ai][bj][m][0] * rs, v1 = acc[ai][bj][m][1] * rs;
                    *(u32x4*)(kvm + (size_t)row * 1024 + col) = pack8(v0, v1);
                }
            }
    }
};
struct EpiWinOdd {
    static constexpr bool PERM = true;
    bf16_t* qkv; const float* rope64;
    __device__ __forceinline__ void operator()(const f32x4 (&acc)[2][2][4][2], const pg8::Unit& u, int wr, int wc, int fr, int fq) const {
        const int row0 = u.pm * 256 + wr * 64 + fr; const bool dorope = ((u.pm * 256) < NLAT) && (u.pn < 8);
        const int i0 = ((wc & 1) * 32 + 8 * fq) >> 1;
#pragma unroll
        for (int ai = 0; ai < 2; ++ai) {
            f32x4 cs[4], sn[4];
            if (dorope) {
#pragma unroll
                for (int m = 0; m < 4; ++m) { const int sp = (row0 + ai * 128 + m * 16) & (SEQ - 1); cs[m] = *(const f32x4*)(rope64 + sp * 32 + i0); sn[m] = *(const f32x4*)(rope64 + SEQ * 32 + sp * 32 + i0); }
            }
#pragma unroll
            for (int m = 0; m < 4; ++m) {
                const int row = row0 + ai * 128 + m * 16;
#pragma unroll
                for (int bj = 0; bj < 2; ++bj) {
                    const int col = u.pn * 256 + bj * 128 + wc * 32 + 8 * fq;
                    f32x4 v0 = acc[ai][bj][m][0], v1 = acc[ai][bj][m][1];
                    if (dorope) rope4v(v0, v1, cs[m], sn[m]);
                    if (u.pn < 4) { v0 = v0 * (0.125f * LOG2E); v1 = v1 * (0.125f * LOG2E); }
                    *(u32x4*)(qkv + (size_t)row * 3072 + col) = pack8(v0, v1);
                }
            }
        }
    }
};
struct EpiResid {
    static constexpr bool PERM = false;
    const float* src_lat; const float* src_ctx; float* dst_lat; float* dst_ctx; const float* mod; int gate_off;
    float* rs16;
    __device__ __forceinline__ void operator()(const f32x4 (&acc)[2][2][4][2], const pg8::Unit& u, int wr, int wc, int fr, int fq) const {
        const int rowt = u.pm * 256; const bool lat = rowt < NLAT;
        const float* sp = lat ? src_lat + (size_t)rowt * DM : src_ctx + (size_t)(rowt - NLAT) * DM;
        float* dp = lat ? dst_lat + (size_t)rowt * DM : dst_ctx + (size_t)(rowt - NLAT) * DM;
        const float* g = mod + (size_t)(lat ? (rowt >> 12) : 16) * 6144 + gate_off;
        const int r0 = wr * 64 + fr, col0 = u.pn * 256 + wc * 32 + 4 * fq;
        f32x4 gv[2][2];
#pragma unroll
        for (int bj = 0; bj < 2; ++bj)
#pragma unroll
            for (int n = 0; n < 2; ++n) gv[bj][n] = *(const f32x4*)(g + col0 + bj * 128 + n * 16);
#pragma unroll
        for (int ai = 0; ai < 2; ++ai) {
            f32x4 xv[4][2][2];
#pragma unroll
            for (int m = 0; m < 4; ++m) { const size_t ro = (size_t)(r0 + ai * 128 + m * 16) * DM + col0;
#pragma unroll
                for (int bj = 0; bj < 2; ++bj)
#pragma unroll
                    for (int n = 0; n < 2; ++n) xv[m][bj][n] = *(const f32x4*)(sp + ro + bj * 128 + n * 16); }
#pragma unroll
            for (int m = 0; m < 4; ++m) { const size_t ro = (size_t)(r0 + ai * 128 + m * 16) * DM + col0; float ss = 0.f;
#pragma unroll
                for (int bj = 0; bj < 2; ++bj)
#pragma unroll
                    for (int n = 0; n < 2; ++n) { const f32x4 y = xv[m][bj][n] + gv[bj][n] * acc[ai][bj][m][n]; *(f32x4*)(dp + ro + bj * 128 + n * 16) = y; ss += (y[0] * y[0] + y[1] * y[1]) + (y[2] * y[2] + y[3] * y[3]); }
                ss += xshfl<16>(ss); ss += xshfl<32>(ss);
                if (fq == 0) rs16[(size_t)(rowt + r0 + ai * 128 + m * 16) * 16 + u.pn * 4 + wc] = ss; }
        }
    }
};
struct EpiSwiglu {
    static constexpr bool PERM = true;
    bf16_t* act;
    __device__ __forceinline__ void operator()(const f32x4 (&acc)[2][2][4][2], const pg8::Unit& u, int wr, int wc, int fr, int fq) const {
        const int row0 = u.pm * 256 + wr * 64 + fr;
#pragma unroll
        for (int ai = 0; ai < 2; ++ai)
#pragma unroll
            for (int m = 0; m < 4; ++m) {
                const int row = row0 + ai * 128 + m * 16;
#pragma unroll
                for (int bj = 0; bj < 2; ++bj) {
                    const int col = u.pn * 256 + bj * 128 + wc * 32 + 8 * fq;
                    const f32x4 v0 = acc[ai][bj][m][0], v1 = acc[ai][bj][m][1];
                    float o[4];
                    { const float a = v0[0], b = v0[1]; o[0] = a * __builtin_amdgcn_rcpf(1.f + __builtin_amdgcn_exp2f(-LOG2E * a)) * b; }
                    { const float a = v0[2], b = v0[3]; o[1] = a * __builtin_amdgcn_rcpf(1.f + __builtin_amdgcn_exp2f(-LOG2E * a)) * b; }
                    { const float a = v1[0], b = v1[1]; o[2] = a * __builtin_amdgcn_rcpf(1.f + __builtin_amdgcn_exp2f(-LOG2E * a)) * b; }
                    { const float a = v1[2], b = v1[3]; o[3] = a * __builtin_amdgcn_rcpf(1.f + __builtin_amdgcn_exp2f(-LOG2E * a)) * b; }
                    u32x2 w; w.x = pk2(o[0], o[1]); w.y = pk2(o[2], o[3]);
                    *(u32x2*)(act + (size_t)row * EFF + (col >> 1)) = w;
                }
            }
    }
};
struct EpiMoe2 {
    static constexpr bool PERM = true;
    bf16_t* yb; const float* slot_gate;
    __device__ __forceinline__ void operator()(const f32x4 (&acc)[2][2][4][2], const pg8::Unit& u, int wr, int wc, int fr, int fq) const {
        const int row0 = u.pm * 256 + wr * 64 + fr;
        float gt[2][4];
#pragma unroll
        for (int ai = 0; ai < 2; ++ai)
#pragma unroll
            for (int m = 0; m < 4; ++m) gt[ai][m] = slot_gate[row0 + ai * 128 + m * 16];
#pragma unroll
        for (int ai = 0; ai < 2; ++ai)
#pragma unroll
            for (int m = 0; m < 4; ++m) {
                const int row = row0 + ai * 128 + m * 16; const float g = gt[ai][m];
#pragma unroll
                for (int bj = 0; bj < 2; ++bj) {
                    const int col = u.pn * 256 + bj * 128 + wc * 32 + 8 * fq;
                    const f32x4 v0 = acc[ai][bj][m][0] * g, v1 = acc[ai][bj][m][1] * g;
                    *(u32x4*)(yb + (size_t)row * DM + col) = pack8(v0, v1);
                }
            }
    }
};
struct MoeSched {
    const LAS int* tile_exp; int ntiles; int G, c;
    __device__ __forceinline__ bool next(int i, pg8::Unit& u) const {
        const int L = i * G + c; if (L >= ntiles * 4) return false;
        u.pm = L >> 2; u.pn = L & 3; u.aux = i; return true;
    }
};
struct GemmMoe1 {
    const char* H; const char* W13l; const LAS int* idx; const LAS int* tile_exp; int K;
    __device__ __forceinline__ const char* a_base() const { return H; }
    __device__ __forceinline__ unsigned a_off(const pg8::Unit& u, int r) const { return (unsigned)idx[u.aux * 256 + r] * (unsigned)(DM * 2); }
    __device__ __forceinline__ const char* b_base(const pg8::Unit& u) const { return W13l + ((size_t)tile_exp[u.pm] * 1024 + (size_t)u.pn * 256) * 1024 * 2; }
};
struct GemmMoe2 {
    const char* ACT; const char* W2l; const LAS int* tile_exp; int K;
    __device__ __forceinline__ const char* a_base() const { return ACT; }
    __device__ __forceinline__ unsigned a_off(const pg8::Unit& u, int r) const { return (unsigned)(u.pm * 256 + r) * (unsigned)(EFF * 2); }
    __device__ __forceinline__ const char* b_base(const pg8::Unit& u) const { return W2l + ((size_t)tile_exp[u.pm] * 1024 + (size_t)u.pn * 256) * 512 * 2; }
};

namespace att {
enum { MLA = 0, SWA = 1, DIFF = 2 };
template <int MODE> struct Cfg;
template <> struct Cfg<MLA>  { static constexpr int DQK = 96, DV = 64,  NKCH = 12, QB = 256; };
template <> struct Cfg<SWA>  { static constexpr int DQK = 64, DV = 64,  NKCH = 8,  QB = 256; };
template <> struct Cfg<DIFF> { static constexpr int DQK = 64, DV = 128, NKCH = 16, QB = 128; };
struct Unit {
    int qrow0;
    int lat_row0;
    int nlat;
    int ctx_row0;
    int head;
    int qpos0;
    int kpos0;
};
struct Tensors {
    const bf16_t* q; const bf16_t* k; const bf16_t* k2; const bf16_t* v; bf16_t* o;
    const float* sink; float lam; const float* subln; float post;
    float c2;
};
__device__ __forceinline__ s16x4 vtr(const LAS unsigned char* p) {
    typedef short v4i16_t __attribute__((ext_vector_type(4)));
    return __builtin_bit_cast(s16x4, __builtin_amdgcn_ds_read_tr16_b64_v4i16((LAS v4i16_t*)p));
}
template <int MODE>
__device__ __forceinline__ void issue_tile(lptr lds, int buf, int row0, const Tensors& T, int head, int wid, int lane) {
    typedef Cfg<MODE> C;
    constexpr int KB = C::NKCH * 1024, VB = C::DV * 128;
    for (int p = wid; p < C::NKCH; p += 8) {
        const bf16_t* src;
        const size_t row = (size_t)(row0 + lane);
        if (MODE == MLA) src = (p < 8) ? T.k + row * 1024 + head * 128 + p * 8 : T.k2 + row * 256 + 128 + (p - 8) * 8;
        else if (MODE == SWA) src = T.k + row * 256 + (head >> 2) * 64 + p * 8;
        else src = T.k + row * 3072 + 1024 + head * 128 + p * 8;
        __builtin_amdgcn_global_load_lds((const unsigned*)src, (LAS unsigned*)(lds + buf * KB + p * 1024), 16, 0, 0);
    }
    for (int p = wid; p < C::DV / 8; p += 8) {
        const size_t row = (size_t)(row0 + 16 * (p & 3) + (lane >> 2)); const int col = (p >> 2) * 32 + (lane & 3) * 8;
        const bf16_t* src;
        if (MODE == MLA) src = T.v + row * 1024 + head * 128 + 64 + col;
        else if (MODE == SWA) src = T.v + row * 256 + 128 + (head >> 2) * 64 + col;
        else src = T.v + row * 3072 + 2048 + head * 128 + col;
        __builtin_amdgcn_global_load_lds((const unsigned*)src, (LAS unsigned*)(lds + 2 * KB + buf * VB + p * 1024), 16, 0, 0);
    }
}
template <int MODE, bool GUARDED>
__device__ __forceinline__ bool attn_unit(lptr lds, const Unit& U, const Tensors& T, int wv) {
    typedef Cfg<MODE> C;
    constexpr int KB = C::NKCH * 1024, VB = C::DV * 128, NKS = C::DQK / 16, ND = C::DV / 32;
    const int tid = opaque_tid(wv), lane = tid & 63, r32 = lane & 31, hi = lane >> 5; const int wid = __builtin_amdgcn_readfirstlane(tid >> 6);
    const int br = (MODE == DIFF) ? (wid >> 2) : 0;
    const int wq = (MODE == DIFF) ? (wid & 3) : wid;
    const int NT = U.nlat + 4;
    issue_tile<MODE>(lds, 0, U.nlat > 0 ? U.lat_row0 : U.ctx_row0, T, U.head, wid, lane);
    bf16x8 qf[NKS];
    {
        const size_t qrow = (size_t)(U.qrow0 + wq * 32 + r32);
        const bf16_t* qp;
        if (MODE == MLA) qp = T.q + qrow * 768 + U.head * 96 + hi * 8;
        else if (MODE == SWA) qp = T.q + qrow * 512 + U.head * 64 + hi * 8;
        else qp = T.q + qrow * 3072 + U.head * 128 + br * 64 + hi * 8;
#pragma unroll
        for (int ks = 0; ks < NKS; ++ks) qf[ks] = *(const bf16x8*)(qp + ks * 16);
    }
    f32x16 o[ND];
#pragma unroll
    for (int d = 0; d < ND; ++d) o[d] = f32x16{};
    float m = GUARDED ? -INFINITY : 0.f, l = 0.f;
    const float c2 = T.c2;
    const int qpos = U.qpos0 + wq * 32 + r32, qa = U.qpos0 + wq * 32;
    const int koff = (MODE == DIFF ? br * 8192 : 0) + hi * 1024 + r32 * 16;
    const int voff = ((lane >> 4) & 1) * 32 + (lane & 3) * 8 + (4 * hi + ((lane & 15) >> 2)) * 64;
    asm volatile("s_waitcnt vmcnt(0)" ::: "memory");
    __syncthreads();
    for (int j = 0; j < NT; ++j) {
        const int buf = j & 1;
        if (j + 1 < NT) { const int jn = j + 1; issue_tile<MODE>(lds, buf ^ 1, jn < U.nlat ? U.lat_row0 + 64 * jn : U.ctx_row0 + 64 * (jn - U.nlat), T, U.head, wid, lane); }
        bool active = true; const bool latt = j < U.nlat; const int kt = U.kpos0 + 64 * j;
        if (MODE == SWA && latt) active = (kt <= qa + 31 + 128) && (kt + 63 >= qa - 128);
        if (active) {
            const lptr kb = lds + buf * KB + koff;
            f32x16 s0 = f32x16{}, s1 = f32x16{};
#pragma unroll
            for (int ks = 0; ks < NKS; ++ks) {
                const bf16x8 k0 = *(const LAS bf16x8*)(kb + ks * 2048), k1 = *(const LAS bf16x8*)(kb + ks * 2048 + 512);
                s0 = __builtin_amdgcn_mfma_f32_32x32x16_bf16(k0, qf[ks], s0, 0, 0, 0);
                s1 = __builtin_amdgcn_mfma_f32_32x32x16_bf16(k1, qf[ks], s1, 0, 0, 0);
            }
            if (MODE == SWA && latt) {
#pragma unroll
                for (int r = 0; r < 16; ++r) { const int kp = kt + crow(r, hi); int d0 = qpos - kp; d0 = d0 < 0 ? -d0 : d0; int d1 = qpos - kp - 32; d1 = d1 < 0 ? -d1 : d1;
                    if (d0 > 128) s0[r] = -INFINITY; if (d1 > 128) s1[r] = -INFINITY; }
            }
            float ps = 0.f;
            if (GUARDED) {
                float mt = fmaxf(s0[0], s1[0]);
#pragma unroll
                for (int r = 1; r < 16; ++r) mt = fmaxf(mt, fmaxf(s0[r], s1[r]));
                mt = fmaxf(mt, xshfl<32>(mt)) * c2;
                const float mn = fmaxf(m, mt);
                const float mu = (mn == -INFINITY) ? 0.f : mn;
                const float alpha = __builtin_amdgcn_exp2f(m - mu);
                m = mn;
#pragma unroll
                for (int r = 0; r < 16; ++r) { s0[r] = __builtin_amdgcn_exp2f(s0[r] * c2 - mu); s1[r] = __builtin_amdgcn_exp2f(s1[r] * c2 - mu); ps += s0[r] + s1[r]; }
                l = l * alpha + ps;
#pragma unroll
                for (int d = 0; d < ND; ++d)
#pragma unroll
                    for (int r = 0; r < 16; ++r) o[d][r] *= alpha;
            } else {
#pragma unroll
                for (int r = 0; r < 16; ++r) { s0[r] = __builtin_amdgcn_exp2f(s0[r]); s1[r] = __builtin_amdgcn_exp2f(s1[r]); ps += s0[r] + s1[r]; }
                l += ps;
            }
            bf16x8 pw[4];
            { u32x4 w;
              w.x = pk2(s0[0], s0[1]); w.y = pk2(s0[2], s0[3]); w.z = pk2(s0[4], s0[5]); w.w = pk2(s0[6], s0[7]); pw[0] = __builtin_bit_cast(bf16x8, w);
              w.x = pk2(s0[8], s0[9]); w.y = pk2(s0[10], s0[11]); w.z = pk2(s0[12], s0[13]); w.w = pk2(s0[14], s0[15]); pw[1] = __builtin_bit_cast(bf16x8, w);
              w.x = pk2(s1[0], s1[1]); w.y = pk2(s1[2], s1[3]); w.z = pk2(s1[4], s1[5]); w.w = pk2(s1[6], s1[7]); pw[2] = __builtin_bit_cast(bf16x8, w);
              w.x = pk2(s1[8], s1[9]); w.y = pk2(s1[10], s1[11]); w.z = pk2(s1[12], s1[13]); w.w = pk2(s1[14], s1[15]); pw[3] = __builtin_bit_cast(bf16x8, w); }
            const lptr vb = lds + 2 * KB + buf * VB + voff;
#pragma unroll
            for (int d = 0; d < ND; ++d)
#pragma unroll
                for (int kk = 0; kk < 4; ++kk) {
                    const s16x4 lo = vtr(vb + d * 4096 + kk * 1024), hh = vtr(vb + d * 4096 + kk * 1024 + 512);
                    const bf16x8 vf = (bf16x8){lo[0], lo[1], lo[2], lo[3], hh[0], hh[1], hh[2], hh[3]};
                    o[d] = __builtin_amdgcn_mfma_f32_32x32x16_bf16(vf, pw[kk], o[d], 0, 0, 0);
                }
        }
        asm volatile("s_waitcnt vmcnt(0)" ::: "memory");
        __syncthreads();
    }
    l += xshfl<32>(l);
    if (MODE == SWA) l += __builtin_amdgcn_exp2f(T.sink[U.head] * LOG2E - m);
    if (!GUARDED) {
        float oa = 0.f;
#pragma unroll
        for (int d = 0; d < ND; ++d)
#pragma unroll
            for (int r = 0; r < 16; ++r) oa += __builtin_fabsf(o[d][r]);
        const bool badl = !(l > 0x1p-100f && l < 0x1p100f) || !(oa < 0x1p120f);
        LAS unsigned* flg = (LAS unsigned*)(lds + LDS_MISC + 4608);
        const bool wbad = __builtin_amdgcn_ballot_w64(badl) != 0ull;
        if (lane == 0) flg[wid] = wbad ? 1u : 0u;
        __syncthreads();
        unsigned anyb = 0u;
#pragma unroll
        for (int w = 0; w < 8; ++w) anyb |= flg[w];
        __syncthreads();
        if (__builtin_amdgcn_readfirstlane(anyb) != 0u) return true;
    }
    const float inv = 1.0f / l;
#pragma unroll
    for (int d = 0; d < ND; ++d)
#pragma unroll
        for (int r = 0; r < 16; ++r) o[d][r] *= inv;
    const size_t orow = (size_t)(U.qrow0 + wq * 32 + r32);
    if (MODE == DIFF) {
        LAS float* xch = (LAS float*)lds + (size_t)(wid & 3) * 4096 + lane;
        if (br == 1) {
#pragma unroll
            for (int d = 0; d < ND; ++d)
#pragma unroll
                for (int r = 0; r < 16; ++r) xch[(d * 16 + r) * 64] = o[d][r];
        }
        __syncthreads();
        if (br == 0) {
            float ss = 0.f;
#pragma unroll
            for (int d = 0; d < ND; ++d)
#pragma unroll
                for (int r = 0; r < 16; ++r) { const float v = o[d][r] - T.lam * xch[(d * 16 + r) * 64]; o[d][r] = v; ss += v * v; }
            ss += xshfl<32>(ss);
            const float rs = __builtin_amdgcn_rsqf(ss * (1.0f / 128.0f) + DIFF_EPS) * T.post;
            bf16_t* op = T.o + orow * 1024 + U.head * 128;
#pragma unroll
            for (int d = 0; d < ND; ++d)
#pragma unroll
                for (int g = 0; g < 4; ++g) {
                    const int dv0 = 32 * d + 8 * g + 4 * hi; const f32x4 gn = *(const f32x4*)(T.subln + dv0);
                    u32x2 w; w.x = pk2(o[d][4 * g] * rs * gn[0], o[d][4 * g + 1] * rs * gn[1]); w.y = pk2(o[d][4 * g + 2] * rs * gn[2], o[d][4 * g + 3] * rs * gn[3]);
                    *(u32x2*)(op + dv0) = w;
                }
        }
        __syncthreads();
    } else {
        bf16_t* op = T.o + orow * 1024 + (MODE == MLA ? 512 + U.head * 64 : U.head * 64);
#pragma unroll
        for (int d = 0; d < ND; ++d)
#pragma unroll
            for (int g = 0; g < 4; ++g) {
                const int dv0 = 32 * d + 8 * g + 4 * hi;
                u32x2 w; w.x = pk2(o[d][4 * g], o[d][4 * g + 1]); w.y = pk2(o[d][4 * g + 2], o[d][4 * g + 3]);
                *(u32x2*)(op + dv0) = w;
            }
    }
    return false;
}
__device__ __forceinline__ void glds16(const void* gsrc, unsigned lds_dst) { unsigned keep;
    asm volatile("s_mov_b32 %0, m0\n\ts_mov_b32 m0, %2\n\ts_nop 0\n\tglobal_load_lds_dwordx4 %1, off\n\ts_mov_b32 m0, %0" : "=&s"(keep) : "v"(gsrc), "s"(lds_dst) : "memory"); }
template <int MODE>
__device__ __forceinline__ void issue_k(lptr lds, int kbyte, int row0, const Tensors& T, int head, int wid, int lane) {
    typedef Cfg<MODE> C;
#pragma unroll
    for (int q = 0; q < (C::NKCH + 7) / 8; ++q) {
        int p = wid + 8 * q; if (p >= C::NKCH) p -= 8;
        const bf16_t* src; const size_t row = (size_t)(row0 + lane);
        if (MODE == MLA) src = (p < 8) ? T.k + row * 1024 + head * 128 + p * 8 : T.k2 + row * 256 + 128 + (p - 8) * 8;
        else if (MODE == SWA) src = T.k + row * 256 + (head >> 2) * 64 + p * 8;
        else {
            const int r = 4 * p + (lane >> 4), sl = lane & 15;
            src = T.k + (size_t)(row0 + r) * 3072 + 1024 + head * 128 + ((sl ^ (r & 15)) * 8);
        }
        glds16(src, (unsigned)__builtin_amdgcn_readfirstlane((int)(unsigned)(size_t)(lds + kbyte + p * 1024)));
    }
}
template <int MODE>
__device__ __forceinline__ void issue_v(lptr lds, int vbyte, int row0, const Tensors& T, int head, int wid, int lane) {
    typedef Cfg<MODE> C;
#pragma unroll
    for (int q = 0; q < C::DV / 64; ++q) {
        const int p = wid + 8 * q;
        const size_t row = (size_t)(row0 + 16 * (p & 3) + (lane >> 2)); const int col = (p >> 2) * 32 + (lane & 3) * 8;
        const bf16_t* src;
        if (MODE == MLA) src = T.v + row * 1024 + head * 128 + 64 + col;
        else if (MODE == SWA) src = T.v + row * 256 + 128 + (head >> 2) * 64 + col;
        else {
            const int r = 4 * p + (lane >> 4), sl = lane & 15;
            src = T.v + (size_t)(row0 + r) * 3072 + 2048 + head * 128 + ((((sl >> 2) ^ (r & 3)) * 4 + (sl & 3)) * 8);
        }
        glds16(src, (unsigned)__builtin_amdgcn_readfirstlane((int)(unsigned)(size_t)(lds + vbyte + p * 1024)));
    }
}
template <int MODE>
__device__ __forceinline__ void attn_unit_p(lptr lds, const Unit& U, const Tensors& T, int wv) {
    typedef Cfg<MODE> C;
    constexpr int KB = C::NKCH * 1024, VB = C::DV * 128, NKS = C::DQK / 16, ND = C::DV / 32;
    constexpr float THR = 8.0f;
    const int tid = opaque_tid(wv), lane = tid & 63, r32 = lane & 31, hi = lane >> 5; const int wid = __builtin_amdgcn_readfirstlane(tid >> 6);
    const int br = (MODE == DIFF) ? (wid >> 2) : 0;
    const int wq = (MODE == DIFF) ? (wid & 3) : wid;
    const int NT = U.nlat + 4;
#define TROW(j) ((j) < U.nlat ? U.lat_row0 + 64 * (j) : U.ctx_row0 + 64 * ((j) - U.nlat))
    issue_k<MODE>(lds, 0, TROW(0), T, U.head, wid, lane);
    issue_v<MODE>(lds, 2 * KB, TROW(0), T, U.head, wid, lane);
    issue_k<MODE>(lds, KB, TROW(1), T, U.head, wid, lane);
    bf16x8 qf[NKS];
    {
        const size_t qrow = (size_t)(U.qrow0 + wq * 32 + r32);
        const bf16_t* qp;
        if (MODE == MLA) qp = T.q + qrow * 768 + U.head * 96 + hi * 8;
        else if (MODE == SWA) qp = T.q + qrow * 512 + U.head * 64 + hi * 8;
        else qp = T.q + qrow * 3072 + U.head * 128 + br * 64 + hi * 8;
#pragma unroll
        for (int ks = 0; ks < NKS; ++ks) qf[ks] = *(const bf16x8*)(qp + ks * 16);
    }
    f32x16 o[ND];
#pragma unroll
    for (int d = 0; d < ND; ++d) o[d] = f32x16{};
    float mref = -INFINITY, l = 0.f;
    const float c2 = T.c2;
    const int koff = (MODE == DIFF ? br * 8192 : 0) + hi * 1024 + r32 * 16;
    const int voff = ((lane >> 4) & 1) * 32 + (lane & 3) * 8 + (4 * hi + ((lane & 15) >> 2)) * 64;
#define QKT(D0, D1, KBUF) do { const lptr kb_ = lds + (KBUF) * KB + koff; D0 = f32x16{}; D1 = f32x16{}; \
        _Pragma("unroll") for (int ks = 0; ks < NKS; ++ks) { const bf16x8 k0_ = *(const LAS bf16x8*)(kb_ + ks * 2048), k1_ = *(const LAS bf16x8*)(kb_ + ks * 2048 + 512); \
            D0 = __builtin_amdgcn_mfma_f32_32x32x16_bf16(k0_, qf[ks], D0, 0, 0, 0); D1 = __builtin_amdgcn_mfma_f32_32x32x16_bf16(k1_, qf[ks], D1, 0, 0, 0); } } while (0)
#define SOFTMAX_PV(VBUF) do { \
        float mt_ = fmaxf(s0[0], s1[0]); \
        _Pragma("unroll") for (int r = 1; r < 16; ++r) mt_ = fmaxf(mt_, fmaxf(s0[r], s1[r])); \
        mt_ = fmaxf(mt_, xshfl<32>(mt_)) * c2; \
        if (__builtin_amdgcn_ballot_w64(mt_ > mref + THR) != 0ull) { \
            const float mn_ = fmaxf(mref, mt_); const float mu_ = (mn_ == -INFINITY) ? 0.f : mn_; const float alpha_ = __builtin_amdgcn_exp2f(mref - mu_); \
            mref = mn_; l *= alpha_; \
            _Pragma("unroll") for (int d = 0; d < ND; ++d) _Pragma("unroll") for (int r = 0; r < 16; ++r) o[d][r] *= alpha_; } \
        const float mu2_ = (mref == -INFINITY) ? 0.f : mref; float ps_ = 0.f; \
        _Pragma("unroll") for (int r = 0; r < 16; ++r) { s0[r] = __builtin_amdgcn_exp2f(s0[r] * c2 - mu2_); s1[r] = __builtin_amdgcn_exp2f(s1[r] * c2 - mu2_); ps_ += s0[r] + s1[r]; } \
        l += ps_; \
        bf16x8 pw_[4]; { u32x4 w_; \
          w_.x = pk2(s0[0], s0[1]); w_.y = pk2(s0[2], s0[3]); w_.z = pk2(s0[4], s0[5]); w_.w = pk2(s0[6], s0[7]); pw_[0] = __builtin_bit_cast(bf16x8, w_); \
          w_.x = pk2(s0[8], s0[9]); w_.y = pk2(s0[10], s0[11]); w_.z = pk2(s0[12], s0[13]); w_.w = pk2(s0[14], s0[15]); pw_[1] = __builtin_bit_cast(bf16x8, w_); \
          w_.x = pk2(s1[0], s1[1]); w_.y = pk2(s1[2], s1[3]); w_.z = pk2(s1[4], s1[5]); w_.w = pk2(s1[6], s1[7]); pw_[2] = __builtin_bit_cast(bf16x8, w_); \
          w_.x = pk2(s1[8], s1[9]); w_.y = pk2(s1[10], s1[11]); w_.z = pk2(s1[12], s1[13]); w_.w = pk2(s1[14], s1[15]); pw_[3] = __builtin_bit_cast(bf16x8, w_); } \
        const lptr vb_ = lds + 2 * KB + (VBUF) * VB + voff; \
        _Pragma("unroll") for (int d = 0; d < ND; ++d) _Pragma("unroll") for (int kk = 0; kk < 4; ++kk) { \
            const s16x4 lo_ = vtr(vb_ + d * 4096 + kk * 1024), hh_ = vtr(vb_ + d * 4096 + kk * 1024 + 512); \
            const bf16x8 vf_ = (bf16x8){lo_[0], lo_[1], lo_[2], lo_[3], hh_[0], hh_[1], hh_[2], hh_[3]}; \
            o[d] = __builtin_amdgcn_mfma_f32_32x32x16_bf16(vf_, pw_[kk], o[d], 0, 0, 0); } } while (0)
    asm volatile("s_waitcnt vmcnt(0)" ::: "memory");
    __syncthreads();
    f32x16 s0, s1;
    QKT(s0, s1, 0);
    __syncthreads();
    for (int j = 0; j + 1 < NT; ++j) {
        if (j + 2 < NT) issue_k<MODE>(lds, (j & 1) * KB, TROW(j + 2), T, U.head, wid, lane);
        issue_v<MODE>(lds, 2 * KB + ((j + 1) & 1) * VB, TROW(j + 1), T, U.head, wid, lane);
        f32x16 n0, n1;
        QKT(n0, n1, (j + 1) & 1);
        SOFTMAX_PV(j & 1);
        s0 = n0; s1 = n1;
        asm volatile("s_waitcnt vmcnt(0)" ::: "memory");
        __syncthreads();
    }
    SOFTMAX_PV((NT - 1) & 1);
    __syncthreads();
#undef TROW
#undef QKT
#undef SOFTMAX_PV
    l += xshfl<32>(l);
    const float inv = 1.0f / l;
#pragma unroll
    for (int d = 0; d < ND; ++d)
#pragma unroll
        for (int r = 0; r < 16; ++r) o[d][r] *= inv;
    const size_t orow = (size_t)(U.qrow0 + wq * 32 + r32);
    if (MODE == DIFF) {
        LAS float* xch = (LAS float*)lds + (size_t)(wid & 3) * 4096 + lane;
        if (br == 1) {
#pragma unroll
            for (int d = 0; d < ND; ++d)
#pragma unroll
                for (int r = 0; r < 16; ++r) xch[(d * 16 + r) * 64] = o[d][r];
        }
        __syncthreads();
        if (br == 0) {
            float ss = 0.f;
#pragma unroll
            for (int d = 0; d < ND; ++d)
#pragma unroll
                for (int r = 0; r < 16; ++r) { const float v = o[d][r] - T.lam * xch[(d * 16 + r) * 64]; o[d][r] = v; ss += v * v; }
            ss += xshfl<32>(ss);
            const float rs = __builtin_amdgcn_rsqf(ss * (1.0f / 128.0f) + DIFF_EPS) * T.post;
            bf16_t* op = T.o + orow * 1024 + U.head * 128;
#pragma unroll
            for (int d = 0; d < ND; ++d)
#pragma unroll
                for (int g = 0; g < 4; ++g) {
                    const int dv0 = 32 * d + 8 * g + 4 * hi; const f32x4 gn = *(const f32x4*)(T.subln + dv0);
                    u32x2 w; w.x = pk2(o[d][4 * g] * rs * gn[0], o[d][4 * g + 1] * rs * gn[1]); w.y = pk2(o[d][4 * g + 2] * rs * gn[2], o[d][4 * g + 3] * rs * gn[3]);
                    *(u32x2*)(op + dv0) = w;
                }
        }
        __syncthreads();
    } else {
        bf16_t* op = T.o + orow * 1024 + (MODE == MLA ? 512 + U.head * 64 : U.head * 64);
#pragma unroll
        for (int d = 0; d < ND; ++d)
#pragma unroll
            for (int g = 0; g < 4; ++g) {
                const int dv0 = 32 * d + 8 * g + 4 * hi;
                u32x2 w; w.x = pk2(o[d][4 * g], o[d][4 * g + 1]); w.y = pk2(o[d][4 * g + 2], o[d][4 * g + 3]);
                *(u32x2*)(op + dv0) = w;
            }
    }
}

template <int MODE, bool GUARDED>
__device__ __forceinline__ bool attn_unit_q(lptr lds, const Unit& U, const Tensors& T, int wv) {
    typedef Cfg<MODE> C;
    constexpr int KB = C::NKCH * 1024, VB = C::DV * 128, NKS = C::DQK / 16, ND = C::DV / 32;
    constexpr int NQK = 2 * NKS, NPV = 4 * ND;
    constexpr int EA = GUARDED ? 0 : ((MODE == MLA) ? 18 : 8);
    const int tid = opaque_tid(wv), lane = tid & 63, r32 = lane & 31, hi = lane >> 5; const int wid = __builtin_amdgcn_readfirstlane(tid >> 6);
    const int br = (MODE == DIFF) ? (wid >> 2) : 0;
    const int wq = (MODE == DIFF) ? (wid & 3) : wid;
    const int NT = U.nlat + 4;
#define TROW(j) ((j) < U.nlat ? U.lat_row0 + 64 * (j) : U.ctx_row0 + 64 * ((j) - U.nlat))
#define SBAR() __builtin_amdgcn_sched_barrier(0)
    issue_k<MODE>(lds, 0, TROW(0), T, U.head, wid, lane);
    issue_k<MODE>(lds, KB, TROW(1), T, U.head, wid, lane);
    issue_k<MODE>(lds, 2 * KB, TROW(2), T, U.head, wid, lane);
    issue_v<MODE>(lds, 3 * KB, TROW(0), T, U.head, wid, lane);
    bf16x8 qf[NKS];
    {
        const size_t qrow = (size_t)(U.qrow0 + wq * 32 + r32);
        const bf16_t* qp;
        if (MODE == MLA) qp = T.q + qrow * 768 + U.head * 96 + hi * 8;
        else qp = T.q + qrow * 3072 + U.head * 128 + br * 64 + hi * 8;
#pragma unroll
        for (int ks = 0; ks < NKS; ++ks) qf[ks] = *(const bf16x8*)(qp + ks * 16);
    }
    f32x16 o[ND];
#pragma unroll
    for (int d = 0; d < ND; ++d) o[d] = f32x16{};
    float mref = 0.f, mtrue = -INFINITY, l = 0.f; bool general = false;
    constexpr float GUARD = 64.0f;
    const int x15 = r32 & 15, q4 = (lane & 15) >> 2;
    const int koff = (MODE == DIFF) ? (r32 * 256 + ((br ^ (x15 >> 3)) * 128) + ((hi ^ (x15 & 1)) * 16)) : (hi * 1024 + r32 * 16);
    const int kx = (x15 >> 1) & 3;
    const int voff = (MODE == DIFF) ? ((4 * hi + q4) * 256 + ((lane >> 4) & 1) * 32 + (lane & 3) * 8) : (((lane >> 4) & 1) * 32 + (lane & 3) * 8 + (4 * hi + q4) * 64);
    f32x16 sA0, sA1, sB0, sB1;
    u32x4 pA[4], pB[4];
    float alpha = 1.f, negmu = 0.f; bool need = false; float psa = 0.f, psb = 0.f;
#define KFRAG(KBUF, i) ((MODE == DIFF) ? *(const LAS bf16x8*)(lds + (KBUF) + koff + ((((i) >> 1) ^ kx) * 32) + ((i) & 1) * 8192) : *(const LAS bf16x8*)(lds + (KBUF) + koff + ((i) >> 1) * 2048 + ((i) & 1) * 512))
#define EXPS(E0, E1, sc0, sc1, pkn) do { _Pragma("unroll") for (int e = (E0); e < (E1); ++e) { float p_; if (e < 16) { p_ = __builtin_amdgcn_exp2f(sc0[e & 15]); sc0[e & 15] = p_; } else { p_ = __builtin_amdgcn_exp2f(sc1[e & 15]); sc1[e & 15] = p_; } \
            if (e & 1) { psb += p_; const float q_ = (e < 16) ? sc0[(e - 1) & 15] : sc1[(e - 1) & 15]; unsigned w_ = pk2(q_, p_); asm volatile("" : "+v"(w_), "+v"(psa), "+v"(psb));   pkn[e >> 3][(e >> 1) & 3] = w_; } else psa += p_; } } while (0)
#define BLOCK_A(KBUF, DOMAX, n0, n1, sc0, sc1, pkn, DOEXPA) do { \
        bf16x8 kf_[3]; kf_[0] = KFRAG(KBUF, 0); kf_[1] = KFRAG(KBUF, 1); SBAR(); \
        _Pragma("unroll") for (int i = 0; i < NQK; ++i) { \
            if (i + 2 < NQK) kf_[(i + 2) % 3] = KFRAG(KBUF, i + 2); \
            if ((i & 1) == 0) n0 = __builtin_amdgcn_mfma_f32_32x32x16_bf16(kf_[i % 3], qf[i >> 1], (i < 2) ? f32x16{} : n0, 0, 0, 0); \
            else              n1 = __builtin_amdgcn_mfma_f32_32x32x16_bf16(kf_[i % 3], qf[i >> 1], (i < 2) ? f32x16{} : n1, 0, 0, 0); \
            if (GUARDED && DOMAX) { _Pragma("unroll") for (int e = (i * 32) / NQK; e < ((i + 1) * 32) / NQK; ++e) { const float x_ = (e < 16) ? sc0[e & 15] : sc1[e & 15]; if (e & 1) mb = fmaxf(mb, x_); else ma = fmaxf(ma, x_); } } \
            if (DOEXPA && EA > 0) EXPS((i * EA) / NQK, ((i + 1) * EA) / NQK, sc0, sc1, pkn); \
            SBAR(); } \
        if (DOEXPA && EA > 0) { l += psa + psb; psa = 0.f; psb = 0.f; } } while (0)
#define DECIDE() do { if (!GUARDED) break; float mt_ = fmaxf(ma, mb); mt_ = fmaxf(mt_, xshfl<32>(mt_)); mtrue = fmaxf(mtrue, mt_); \
        need = __builtin_amdgcn_ballot_w64((mt_ - mref > GUARD) || (mtrue - mref < -GUARD)) != 0ull; alpha = 1.f; \
        if (need) { const float mn_ = (mtrue == -INFINITY) ? mref : mtrue; alpha = __builtin_amdgcn_exp2f(fminf(mref - mn_, 126.0f)); mref = mn_; l *= alpha; general = true; } \
        negmu = -mref; } while (0)
#define VFRAG(DST, VBUF, i) do { const lptr vp_ = (MODE == DIFF) ? (lds + (VBUF) + voff + ((((i) >> 2) ^ q4) * 64) + ((i) & 3) * 4096) : (lds + (VBUF) + voff + ((i) >> 2) * 4096 + ((i) & 3) * 1024);     const s16x4 lo_ = vtr(vp_), hh_ = vtr(vp_ + ((MODE == DIFF) ? 2048 : 512)); \
        DST = (bf16x8){lo_[0], lo_[1], lo_[2], lo_[3], hh_[0], hh_[1], hh_[2], hh_[3]}; } while (0)
#define BLOCK_B(VBUF, DOPV, DOEXP, sc0, sc1, pk, pkn, ELO) do { \
        if (GUARDED && DOEXP && general) { _Pragma("unroll") for (int e = 0; e < 16; ++e) { sc0[e] += negmu; sc1[e] += negmu; } }     \
        if (DOPV) { bf16x8 vf_[3]; VFRAG(vf_[0], VBUF, 0); VFRAG(vf_[1], VBUF, 1); SBAR(); \
            _Pragma("unroll") for (int i = 0; i < NPV; ++i) { \
                if (i + 2 < NPV) VFRAG(vf_[(i + 2) % 3], VBUF, i + 2); \
                o[i >> 2] = __builtin_amdgcn_mfma_f32_32x32x16_bf16(vf_[i % 3], __builtin_bit_cast(bf16x8, pk[i & 3]), o[i >> 2], 0, 0, 0); \
                if (DOEXP) EXPS((ELO) + (i * (32 - (ELO))) / NPV, (ELO) + ((i + 1) * (32 - (ELO))) / NPV, sc0, sc1, pkn); \
                SBAR(); } } \
        else if (DOEXP) EXPS((ELO), 32, sc0, sc1, pkn); \
        if (DOEXP) { l += psa + psb; psa = 0.f; psb = 0.f; } } while (0)
#define RESCALE_O() do { if (GUARDED && need) { _Pragma("unroll") for (int d = 0; d < ND; ++d) _Pragma("unroll") for (int r = 0; r < 16; ++r) o[d][r] *= alpha; } } while (0)
    constexpr int NDMA = (C::NKCH + 7) / 8 + C::DV / 64;
#define WAIT_BAR_KEEP() do { if (NDMA == 4) asm volatile("s_waitcnt vmcnt(4) lgkmcnt(0)\n\ts_barrier" ::: "memory"); else asm volatile("s_waitcnt vmcnt(3) lgkmcnt(0)\n\ts_barrier" ::: "memory"); } while (0)
#define WAIT_BAR_ALL() asm volatile("s_waitcnt vmcnt(0) lgkmcnt(0)\n\ts_barrier" ::: "memory")
    if (wid >= 4) __builtin_amdgcn_s_setprio(1);
    WAIT_BAR_ALL();
    { float ma = -INFINITY, mb = -INFINITY; (void)ma; (void)mb; BLOCK_A(0, false, sA0, sA1, sA0, sA1, pA, false); }
    WAIT_BAR_ALL();
    int kn = KB;
#define VSLOT(t) (3 * KB + (((t) & 3) * VB))
#define KNEXT() do { kn = (kn == 2 * KB) ? 0 : kn + KB; } while (0)
#define ISSUE(j_) do { const int kfree = (kn == 0) ? 2 * KB : kn - KB; if ((j_) + 3 < NT) issue_k<MODE>(lds, kfree, TROW((j_) + 3), T, U.head, wid, lane); \
        issue_v<MODE>(lds, VSLOT((j_) + 1), TROW((j_) + 1), T, U.head, wid, lane); } while (0)
#define ENDW(j_) do { if ((j_) + 3 < NT) WAIT_BAR_KEEP(); else WAIT_BAR_ALL(); } while (0)
    if (wid < 4) {
        {
            float ma = -INFINITY, mb = -INFINITY;
            BLOCK_A(kn, true, sB0, sB1, sA0, sA1, pA, true);
            issue_k<MODE>(lds, 0, TROW(3), T, U.head, wid, lane); issue_v<MODE>(lds, VSLOT(1), TROW(1), T, U.head, wid, lane);
            DECIDE();
            BLOCK_B(0, false, true, sA0, sA1, pB, pA, EA);
            WAIT_BAR_KEEP(); KNEXT();
        }
#define STEP1(j_, N0, N1, SC0, SC1, PK, PKN) do { float ma = -INFINITY, mb = -INFINITY; \
            BLOCK_A(kn, true, N0, N1, SC0, SC1, PKN, true); ISSUE(j_); DECIDE(); BLOCK_B(VSLOT((j_) - 1), true, true, SC0, SC1, PK, PKN, EA); RESCALE_O(); ENDW(j_); KNEXT(); } while (0)
        for (int j = 1; j + 1 < NT; j += 2) { STEP1(j, sA0, sA1, sB0, sB1, pA, pB); STEP1(j + 1, sB0, sB1, sA0, sA1, pB, pA); }
#undef STEP1
        {
            float ma = -INFINITY, mb = -INFINITY;
            if (GUARDED) {
#pragma unroll
                for (int e = 0; e < 16; ++e) { ma = fmaxf(ma, sB0[e]); mb = fmaxf(mb, sB1[e]); } }
            DECIDE();
            BLOCK_B(VSLOT(NT - 2), true, true, sB0, sB1, pA, pB, 0);
            RESCALE_O();
            BLOCK_B(VSLOT(NT - 1), true, false, sB0, sB1, pB, pA, 0);
        }
    } else {
        float mcar;
        {
            float ma = -INFINITY, mb = -INFINITY;
            issue_k<MODE>(lds, 0, TROW(3), T, U.head, wid, lane); issue_v<MODE>(lds, VSLOT(1), TROW(1), T, U.head, wid, lane);
            BLOCK_A(kn, true, sB0, sB1, sA0, sA1, pA, true);
            mcar = fmaxf(ma, mb);
            WAIT_BAR_KEEP(); KNEXT();
        }
#define STEP2(j_, SC0, SC1, PK, PKN, SM0, SM1, DOPV) do { float ma = mcar, mb = mcar; \
            ISSUE(j_); DECIDE(); BLOCK_B(VSLOT((j_) - 2), DOPV, true, SC0, SC1, PK, PKN, EA); RESCALE_O(); \
            ma = -INFINITY; mb = -INFINITY; BLOCK_A(kn, true, SC0, SC1, SM0, SM1, PK, true); mcar = fmaxf(ma, mb); ENDW(j_); KNEXT(); } while (0)
        STEP2(1, sA0, sA1, pB, pA, sB0, sB1, false);
        STEP2(2, sB0, sB1, pA, pB, sA0, sA1, true);
        for (int j = 3; j + 1 < NT; j += 2) { STEP2(j, sA0, sA1, pB, pA, sB0, sB1, true); STEP2(j + 1, sB0, sB1, pA, pB, sA0, sA1, true); }
#undef STEP2
        {
            float ma = mcar, mb = mcar;
            DECIDE();
            BLOCK_B(VSLOT(NT - 3), true, true, sA0, sA1, pB, pA, EA);
            RESCALE_O();
            ma = -INFINITY; mb = -INFINITY;
            if (GUARDED) {
#pragma unroll
                for (int e = 0; e < 16; ++e) { ma = fmaxf(ma, sB0[e]); mb = fmaxf(mb, sB1[e]); } }
            DECIDE();
            BLOCK_B(VSLOT(NT - 2), true, true, sB0, sB1, pA, pB, 0);
            RESCALE_O();
            BLOCK_B(VSLOT(NT - 1), true, false, sB0, sB1, pB, pA, 0);
        }
    }
#undef VSLOT
#undef KNEXT
#undef ISSUE
#undef ENDW
    __builtin_amdgcn_s_setprio(0);
    WAIT_BAR_ALL();
#undef WAIT_BAR_KEEP
#undef WAIT_BAR_ALL
#undef TROW
#undef SBAR
#undef KFRAG
#undef BLOCK_A
#undef DECIDE
#undef VFRAG
#undef EXPS
#undef BLOCK_B
#undef RESCALE_O
    l += xshfl<32>(l);
    if (!GUARDED) {
        float oa = 0.f;
#pragma unroll
        for (int d = 0; d < ND; ++d)
#pragma unroll
            for (int r = 0; r < 16; ++r) oa += __builtin_fabsf(o[d][r]);
        const bool badl = !(l > 0x1p-100f && l < 0x1p100f) || !(oa < 0x1p120f);
        LAS unsigned* flg = (LAS unsigned*)(lds + LDS_MISC + 4608);
        const bool wbad = __builtin_amdgcn_ballot_w64(badl) != 0ull;
        if (lane == 0) flg[wid] = wbad ? 1u : 0u;
        __syncthreads();
        unsigned anyb = 0u;
#pragma unroll
        for (int w = 0; w < 8; ++w) anyb |= flg[w];
        __syncthreads();
        if (__builtin_amdgcn_readfirstlane(anyb) != 0u) return true;
    }
    const float inv = 1.0f / l;
#pragma unroll
    for (int d = 0; d < ND; ++d)
#pragma unroll
        for (int r = 0; r < 16; ++r) o[d][r] *= inv;
    const size_t orow = (size_t)(U.qrow0 + wq * 32 + r32);
    if (MODE == DIFF) {
        LAS float* xch = (LAS float*)lds + (size_t)(wid & 3) * 4096 + lane;
        if (br == 1) {
#pragma unroll
            for (int d = 0; d < ND; ++d)
#pragma unroll
                for (int r = 0; r < 16; ++r) xch[(d * 16 + r) * 64] = o[d][r];
        }
        __syncthreads();
        if (br == 0) {
            float ss = 0.f;
#pragma unroll
            for (int d = 0; d < ND; ++d)
#pragma unroll
                for (int r = 0; r < 16; ++r) { const float v = o[d][r] - T.lam * xch[(d * 16 + r) * 64]; o[d][r] = v; ss += v * v; }
            ss += xshfl<32>(ss);
            const float rs = __builtin_amdgcn_rsqf(ss * (1.0f / 128.0f) + DIFF_EPS) * T.post;
            bf16_t* op = T.o + orow * 1024 + U.head * 128;
#pragma unroll
            for (int d = 0; d < ND; ++d)
#pragma unroll
                for (int g = 0; g < 4; g += 2) {
                    u32x2 wa, wb;
                    { const int dv0 = 32 * d + 8 * g + 4 * hi; const f32x4 gn = *(const f32x4*)(T.subln + dv0);
                      wa.x = pk2(o[d][4 * g] * rs * gn[0], o[d][4 * g + 1] * rs * gn[1]); wa.y = pk2(o[d][4 * g + 2] * rs * gn[2], o[d][4 * g + 3] * rs * gn[3]); }
                    { const int dv1 = 32 * d + 8 * (g + 1) + 4 * hi; const f32x4 gn = *(const f32x4*)(T.subln + dv1);
                      wb.x = pk2(o[d][4 * g + 4] * rs * gn[0], o[d][4 * g + 5] * rs * gn[1]); wb.y = pk2(o[d][4 * g + 6] * rs * gn[2], o[d][4 * g + 7] * rs * gn[3]); }
                    const auto rx = __builtin_amdgcn_permlane32_swap(wa.x, wb.x, false, false); const auto ry = __builtin_amdgcn_permlane32_swap(wa.y, wb.y, false, false);
                    *(u32x4*)(op + 32 * d + 8 * g + 8 * hi) = (u32x4){rx[0], ry[0], rx[1], ry[1]};
                }
        }
        __syncthreads();
    } else {
        bf16_t* op = T.o + orow * 1024 + 512 + U.head * 64;
#pragma unroll
        for (int d = 0; d < ND; ++d)
#pragma unroll
            for (int g = 0; g < 4; g += 2) {
                u32x2 wa, wb; wa.x = pk2(o[d][4 * g], o[d][4 * g + 1]); wa.y = pk2(o[d][4 * g + 2], o[d][4 * g + 3]); wb.x = pk2(o[d][4 * g + 4], o[d][4 * g + 5]); wb.y = pk2(o[d][4 * g + 6], o[d][4 * g + 7]);
                const auto rx = __builtin_amdgcn_permlane32_swap(wa.x, wb.x, false, false); const auto ry = __builtin_amdgcn_permlane32_swap(wa.y, wb.y, false, false);
                *(u32x4*)(op + 32 * d + 8 * g + 8 * hi) = (u32x4){rx[0], ry[0], rx[1], ry[1]};
            }
    }
    return false;
}
}

#define LDS_WAIT() asm volatile("s_waitcnt lgkmcnt(0)" ::: "memory")
template <class F> __device__ __forceinline__ void tr_generic_item(const F& f, int Kpad, bf16_t* WT, LAS float* scr, int kb, int nb, int lane) {
    const int k0 = 64 * kb, n0 = 32 * nb;
    float fv[32];
#pragma unroll
    for (int i = 0; i < 32; ++i) fv[i] = f(k0 + 2 * i + (lane >> 5), n0 + (lane & 31));
#pragma unroll
    for (int i = 0; i < 32; ++i) { const int kk = 2 * i + (lane >> 5); scr[kk * 33 + (lane & 31)] = fv[i]; }
    LDS_WAIT();
    const int c = lane & 7;
#pragma unroll
    for (int j = 0; j < 4; ++j) { const int n = (lane >> 3) + 8 * j; const LAS float* s = scr + (8 * c) * 33 + n;
        u32x4 o; o.x = pk2(s[0 * 33], s[1 * 33]); o.y = pk2(s[2 * 33], s[3 * 33]); o.z = pk2(s[4 * 33], s[5 * 33]); o.w = pk2(s[6 * 33], s[7 * 33]);
        *(u32x4*)(WT + (size_t)(n0 + n) * Kpad + k0 + 8 * c) = o; }
    LDS_WAIT();
}
struct FWinEven { const float* W;
    __device__ __forceinline__ float operator()(int k, int n) const {
        int oc;
        if (n < 640) { const int blk = n >> 6, d = n & 63; oc = blk * 64 + (d & 1) * 32 + (d >> 1); }
        else if (n < 1152) oc = n;
        else if (n < 1184) { const int d = n - 1152; oc = 1152 + (d & 1) * 16 + (d >> 1); }
        else return 0.f;
        return W[(size_t)k * 1184 + oc];
    } };
struct FWuq { const float* W; const float* g;
    __device__ __forceinline__ float operator()(int k, int n) const {
        const int h = n / 96, d = n - h * 96; int oc;
        if (d < 64) oc = h * 96 + d; else { const int dd = d - 64; oc = h * 96 + 64 + (dd & 1) * 16 + (dd >> 1); }
        return W[(size_t)k * 768 + oc] * g[k];
    } };
struct FWukv { const float* W; const float* g;
    __device__ __forceinline__ float operator()(int k, int n) const { return k < 128 ? W[(size_t)k * 1024 + n] * g[k] : 0.f; } };
struct FPlain { const float* W; int N;
    __device__ __forceinline__ float operator()(int k, int n) const { return W[(size_t)k * N + n]; } };
struct FWinOdd { const float* W;
    __device__ __forceinline__ float operator()(int k, int n) const {
        int oc = n; if (n < 2048) { const int blk = n >> 6, d = n & 63; oc = blk * 64 + (d & 1) * 32 + (d >> 1); }
        return W[(size_t)k * 3072 + oc];
    } };
__device__ __forceinline__ void tr_expert_item(int item, LAS float* scr, int lane, const float* w1, const float* w3, const float* w2, bf16_t* W13, bf16_t* W2T) {
    const int q = lane & 15, kr = lane >> 4;
    bf16_t* dst; int Kd, k0, n0;
    if (item < 32768) {
        const int le = item >> 8, kb = (item >> 4) & 15, nb = item & 15; k0 = kb * 64; n0 = nb * 64; Kd = 1024;
        const float* src = ((q < 8) ? w1 : w3) + (size_t)le * 1024 * 512 + (n0 >> 1) + 4 * (q & 7);
        f32x4 v[16];
#pragma unroll
        for (int i = 0; i < 16; ++i) v[i] = *(const f32x4*)(src + (size_t)(k0 + 4 * i + kr) * 512);
#pragma unroll
        for (int i = 0; i < 16; ++i) { const int kk = 4 * i + kr; LAS float* p = scr + kk * 65 + 8 * (q & 7) + (q >> 3); p[0] = v[i][0]; p[2] = v[i][1]; p[4] = v[i][2]; p[6] = v[i][3]; }
        dst = W13 + (size_t)le * 1024 * 1024;
    } else {
        const int it = item - 32768, le = it >> 7, kb = (it >> 4) & 7, nb = it & 15; k0 = kb * 64; n0 = nb * 64; Kd = 512;
        const float* src = w2 + (size_t)le * 512 * 1024 + n0 + 4 * q;
        f32x4 v[16];
#pragma unroll
        for (int i = 0; i < 16; ++i) v[i] = *(const f32x4*)(src + (size_t)(k0 + 4 * i + kr) * 1024);
#pragma unroll
        for (int i = 0; i < 16; ++i) { const int kk = 4 * i + kr; LAS float* p = scr + kk * 65 + 4 * q; p[0] = v[i][0]; p[1] = v[i][1]; p[2] = v[i][2]; p[3] = v[i][3]; }
        dst = W2T + (size_t)le * 1024 * 512;
    }
    LDS_WAIT();
    const int c = lane & 7;
#pragma unroll
    for (int j = 0; j < 8; ++j) { const int n = (lane >> 3) + 8 * j; const LAS float* s = scr + (8 * c) * 65 + n;
        u32x4 o; o.x = pk2(s[0 * 65], s[1 * 65]); o.y = pk2(s[2 * 65], s[3 * 65]); o.z = pk2(s[4 * 65], s[5 * 65]); o.w = pk2(s[6 * 65], s[7 * 65]);
        *(u32x4*)(dst + (size_t)(n0 + n) * Kd + k0 + 8 * c) = o; }
    LDS_WAIT();
}

__device__ __forceinline__ void prologue_a(lptr lds, int vcu, int G, int wv) {
    const int tid = opaque_tid(wv), lane = tid & 63, wave = __builtin_amdgcn_readfirstlane(tid >> 6);
    unsigned char* ws = parg(lds, 31);
    const int gw = vcu * NWAVES + wave, NGW = G * NWAVES;
    LAS float* scr = (LAS float*)(lds + wave * 16640);
    for (int it = gw; it < 49152; it += NGW) tr_expert_item(it, scr, lane, pin(lds, 26), pin(lds, 27), pin(lds, 28), (bf16_t*)(ws + WS_W13), (bf16_t*)(ws + WS_W2T));
    for (int it = gw; it < 6848; it += NGW) {
        const int j = it / 3424; int r = it - j * 3424;
        if (r < 640) { FWinEven f{pin(lds, 8) + (size_t)j * 1024 * 1184}; tr_generic_item(f, 1024, (bf16_t*)(ws + WS_WINE) + (size_t)j * 1280 * 1024, scr, r / 40, r % 40, lane); continue; } r -= 640;
        if (r < 96) { FWuq f{pin(lds, 10) + (size_t)j * 256 * 768, pin(lds, 9) + j * 256}; tr_generic_item(f, 256, (bf16_t*)(ws + WS_WUQ) + (size_t)j * 768 * 256, scr, r / 24, r % 24, lane); continue; } r -= 96;
        if (r < 128) { FWukv f{pin(lds, 12) + (size_t)j * 128 * 1024, pin(lds, 11) + j * 128}; tr_generic_item(f, 256, (bf16_t*)(ws + WS_WUKV) + (size_t)j * 1024 * 256, scr, r / 32, r % 32, lane); continue; } r -= 128;
        if (r < 512) { FPlain f{pin(lds, 14) + (size_t)j * 1024 * 1024, 1024}; tr_generic_item(f, 1024, (bf16_t*)(ws + WS_WOUTE) + (size_t)j * 1024 * 1024, scr, r / 32, r % 32, lane); continue; } r -= 512;
        if (r < 1536) { FWinOdd f{pin(lds, 15) + (size_t)j * 1024 * 3072}; tr_generic_item(f, 1024, (bf16_t*)(ws + WS_WINO) + (size_t)j * 3072 * 1024, scr, r / 96, r % 96, lane); continue; } r -= 1536;
        { FPlain f{pin(lds, 21) + (size_t)j * 1024 * 1024, 1024}; tr_generic_item(f, 1024, (bf16_t*)(ws + WS_WOUTO) + (size_t)j * 1024 * 1024, scr, r / 32, r % 32, lane); }
    }
    {
        const int gt = gw * 64 + lane, NGT = NGW * 64;
        float* r64 = (float*)(ws + WS_ROPE64); float* r32 = (float*)(ws + WS_ROPE32);
        for (int i = gt; i < SEQ * 32; i += NGT) { const int s = i >> 5, p = i & 31; const int pos = (p < 16) ? (s >> 6) : (s & 63); const int jj = p & 15;
            const float inv = powf(10000.0f, -(float)jj / 16.0f); const float ang = (float)pos * inv; r64[i] = cosf(ang); r64[SEQ * 32 + i] = sinf(ang); }
        for (int i = gt; i < SEQ * 16; i += NGT) { const int s = i >> 4, p = i & 15; const int pos = (p < 8) ? (s >> 6) : (s & 63); const int jj = p & 7;
            const float inv = powf(10000.0f, -(float)jj / 8.0f); const float ang = (float)pos * inv; r32[i] = cosf(ang); r32[SEQ * 16 + i] = sinf(ang); }
        if (gt < 512) ((unsigned*)(ws + WS_H + (size_t)ZROW * DM * 2))[gt] = 0u;
    }
    {
        float* modp = (float*)(ws + WS_MODP);
        const float* adaw = pin(lds, 6); const float* cvec = pin(lds, 1); const float* cctx = pin(lds, 3);
        __syncthreads();
        LAS float* sil = (LAS float*)lds;
        for (int i = tid; i < 17 * 1024; i += NTHREADS) { const int r = i >> 10, k = i & 1023; const float cv = (r < 16) ? cvec[r * 1024 + k] : cctx[k]; sil[k * 17 + r] = cv / (1.f + __expf(-cv)); }
        __syncthreads();
        for (int it = gw; it < 1536; it += NGW) {
            const int kq = it / 384, rem = it - kq * 384, l = rem / 96, nb = rem - l * 96; const int n = nb * 64 + lane;
            const float* w = adaw + ((size_t)l * 1024 + kq * 256) * 6144 + n;
            float acc[17];
#pragma unroll
            for (int r = 0; r < 17; ++r) acc[r] = 0.f;
#pragma unroll 8
            for (int k = 0; k < 256; ++k) {
                const float wv = w[(size_t)k * 6144];
                const LAS float* sp = sil + (kq * 256 + k) * 17;
#pragma unroll
                for (int r = 0; r < 17; ++r) acc[r] += sp[r] * wv;
            }
#pragma unroll
            for (int r = 0; r < 17; ++r) modp[(((size_t)kq * DEPTH + l) * 17 + r) * 6144 + n] = acc[r];
        }
    }
}
__device__ __forceinline__ void prologue_b(lptr lds, int vcu, int G, int wv) {
    const int tid = opaque_tid(wv), lane = tid & 63, wave = __builtin_amdgcn_readfirstlane(tid >> 6);
    const int gt = (vcu * NWAVES + wave) * 64 + lane, NGT = G * NWAVES * 64;
    unsigned char* ws = parg(lds, 31); const float* adab = pin(lds, 7);
    const float* modp = (const float*)(ws + WS_MODP); float* mod = (float*)(ws + WS_MOD);
    for (int i = gt; i < (int)MOD_ELEMS; i += NGT) { const int l = i / (17 * 6144), n = i % 6144;
        mod[i] = ((modp[i] + modp[MOD_ELEMS + i]) + (modp[2 * MOD_ELEMS + i] + modp[3 * MOD_ELEMS + i])) + adab[l * 6144 + n]; }
}

__device__ __forceinline__ void phase_norm_mix(lptr lds, int l, int vcu, int G, int wv, bool dry = false) {
    const int tid = opaque_tid(wv), lane = tid & 63, wave = __builtin_amdgcn_readfirstlane(tid >> 6);
    unsigned char* ws = parg(lds, 31); float* outp = (float*)parg(lds, 30); const float* xin = pin(lds, 0); const float* cin = pin(lds, 2);
    const int gw = vcu * NWAVES + wave, NGW = G * NWAVES;
    const float* mod = (const float*)(ws + WS_MOD);
    const int* tokd = (const int*)(ws + WS_TOKD); const bf16_t* yb = (const bf16_t*)(ws + WS_BIG + BG_YB);
    bf16_t* H = dry ? (bf16_t*)(ws + WS_END) : (bf16_t*)(ws + WS_H);
    const int nrows = (l == DEPTH) ? NLAT : MTOT;
    const float* gain = (l == DEPTH) ? pin(lds, 29) : pin(lds, 4) + l * DM;
    for (int row0 = gw; row0 < nrows; row0 += 2 * NGW) {
        float* xp[2]; f32x4 v[2][4]; int rr[2]; int dd[2][2];
        const bool docomb = (l > 0);
#pragma unroll
        for (int q = 0; q < 2; ++q) {
            const int row = row0 + q * NGW;
            rr[q] = mod_r(row); xp[q] = xrow_ptr(outp, ws, row);
            const float* xs = (l == 0) ? (row < NLAT ? xin + (size_t)row * DM : cin + (size_t)(row - NLAT) * DM) : xp[q];
            if (docomb) { dd[q][0] = tokd[row * 2]; dd[q][1] = tokd[row * 2 + 1]; }
#pragma unroll
            for (int j = 0; j < 4; ++j) v[q][j] = *(const f32x4*)(xs + 256 * j + 4 * lane);
        }
        if (docomb) {
            u32x2 ya[2][4], yb2[2][4];
#pragma unroll
            for (int q = 0; q < 2; ++q)
#pragma unroll
                for (int j = 0; j < 4; ++j) { ya[q][j] = *(const u32x2*)(yb + (size_t)dd[q][0] * DM + 256 * j + 4 * lane); yb2[q][j] = *(const u32x2*)(yb + (size_t)dd[q][1] * DM + 256 * j + 4 * lane); }
#pragma unroll
            for (int q = 0; q < 2; ++q) {
                const float* g5 = mod + ((size_t)(l - 1) * 17 + rr[q]) * 6144 + 5 * 1024;
#pragma unroll
                for (int j = 0; j < 4; ++j) {
                    const u32x2 a = ya[q][j], b = yb2[q][j];
                    const f32x4 gg = *(const f32x4*)(g5 + 256 * j + 4 * lane);
                    v[q][j][0] += gg[0] * (bflo(a.x) + bflo(b.x)); v[q][j][1] += gg[1] * (bfhi(a.x) + bfhi(b.x));
                    v[q][j][2] += gg[2] * (bflo(a.y) + bflo(b.y)); v[q][j][3] += gg[3] * (bfhi(a.y) + bfhi(b.y));
                }
                if (l < DEPTH && !dry) {
#pragma unroll
                    for (int j = 0; j < 4; ++j) *(f32x4*)(xp[q] + 256 * j + 4 * lane) = v[q][j];
                }
            }
        }
#pragma unroll
        for (int q = 0; q < 2; ++q) {
            const int row = row0 + q * NGW;
            float ss = 0.f;
#pragma unroll
            for (int j = 0; j < 4; ++j) ss += (v[q][j][0] * v[q][j][0] + v[q][j][1] * v[q][j][1]) + (v[q][j][2] * v[q][j][2] + v[q][j][3] * v[q][j][3]);
            const float rs = __builtin_amdgcn_rsqf(wave_sum(ss) * (1.0f / DM) + NORM_EPS);
            if (l == DEPTH) {
                if (!dry)
#pragma unroll
                for (int j = 0; j < 4; ++j) { const f32x4 g = *(const f32x4*)(gain + 256 * j + 4 * lane); *(f32x4*)(xp[q] + 256 * j + 4 * lane) = v[q][j] * rs * g; }
            } else {
                const float* sh = mod + ((size_t)l * 17 + rr[q]) * 6144; const float* sc = sh + 1024;
#pragma unroll
                for (int j = 0; j < 4; ++j) { const int c = 256 * j + 4 * lane; const f32x4 g = *(const f32x4*)(gain + c), s0 = *(const f32x4*)(sh + c), s1 = *(const f32x4*)(sc + c);
                    const f32x4 h = v[q][j] * rs * g * (s1 + 1.0f) + s0;
                    u32x2 w; w.x = pk2(h[0], h[1]); w.y = pk2(h[2], h[3]); *(u32x2*)(H + (size_t)row * DM + c) = w; }
            }
        }
    }
}

constexpr int RW_STRIDE = 1028;
__device__ __forceinline__ void phase_norm_ffn_router(int l, lptr lds, int vcu, int G, int wv, bool dry = false) {
    const int tid = opaque_tid(wv), lane = tid & 63, wave = __builtin_amdgcn_readfirstlane(tid >> 6);
    unsigned char* ws = parg(lds, 31); float* outp = (float*)parg(lds, 30);
    const float* gain = pin(lds, 5) + l * DM;
    const float* bgp = pin(lds, 23) + l * 4; const float* bep = pin(lds, 25) + l * 32;
    LAS float* wl = (LAS float*)lds;
    { const float* wg = pin(lds, 22) + (size_t)l * 1024 * 4; const float* we = pin(lds, 24) + (size_t)l * 1024 * 32;
      for (int i = tid; i < 1024 * 4; i += NTHREADS) wl[(i & 3) * RW_STRIDE + (i >> 2)] = wg[i];
      for (int i = tid; i < 1024 * 32; i += NTHREADS) wl[(4 + (i & 31)) * RW_STRIDE + (i >> 5)] = we[i]; }
    LAS unsigned* hist = (LAS unsigned*)(lds + LDS_MISC + 4608);
    if (tid < 32) hist[tid] = 0u;
    __syncthreads();
    const int gw = vcu * NWAVES + wave, NGW = G * NWAVES;
    const float* mod = (const float*)(ws + WS_MOD);
    bf16_t* H = dry ? (bf16_t*)(ws + WS_END) : (bf16_t*)(ws + WS_H);
    int* toke = (int*)(ws + WS_TOKE); float* tokg = (float*)(ws + WS_TOKG); int* tokp = (int*)(ws + WS_TOKP);
    unsigned* cnt = (unsigned*)(ws + WS_CTL) + CW_CNT + l * 32 * 16;
    const int nrows = (l == DEPTH - 1) ? NLAT : MTOT;
    for (int row = gw; row < nrows; row += NGW) {
        const int r = mod_r(row);
        const float* xp = xrow_ptr(outp, ws, row);
        f32x4 v[4];
#pragma unroll
        for (int j = 0; j < 4; ++j) v[j] = *(const f32x4*)(xp + 256 * j + 4 * lane);
        float ss = 0.f;
#pragma unroll
        for (int j = 0; j < 4; ++j) ss += (v[j][0] * v[j][0] + v[j][1] * v[j][1]) + (v[j][2] * v[j][2] + v[j][3] * v[j][3]);
        const float rs = __builtin_amdgcn_rsqf(wave_sum(ss) * (1.0f / DM) + NORM_EPS);
        const float* sh = mod + ((size_t)l * 17 + r) * 6144 + 3 * 1024; const float* sc = sh + 1024;
#pragma unroll
        for (int j = 0; j < 4; ++j) { const int c = 256 * j + 4 * lane; const f32x4 g = *(const f32x4*)(gain + c), s0 = *(const f32x4*)(sh + c), s1 = *(const f32x4*)(sc + c);
            v[j] = v[j] * rs * g * (s1 + 1.0f) + s0;
            u32x2 w; w.x = pk2(v[j][0], v[j][1]); w.y = pk2(v[j][2], v[j][3]); *(u32x2*)(H + (size_t)row * DM + c) = w; }
        float a[36];
        int wo = 4 * lane; asm volatile("" : "+v"(wo));
        const LAS float* wlr = wl + wo;
#pragma unroll
        for (int c = 0; c < 36; ++c) {
            float s = 0.f;
#pragma unroll
            for (int j = 0; j < 4; ++j) { const f32x4 w = *(const LAS f32x4*)(wlr + c * RW_STRIDE + 256 * j); s += (v[j][0] * w[0] + v[j][1] * w[1]) + (v[j][2] * w[2] + v[j][3] * w[3]); }
            a[c] = s;
        }
#pragma unroll
        for (int c = 0; c < 4; ++c) a[c] = wave_sum(a[c]) + bgp[c];
#define HALVE(N, MASK) _Pragma("unroll") for (int i = 0; i < (N) / 2; ++i) { const bool up = (lane & (MASK)) != 0; const float send = up ? a[4 + i] : a[4 + i + (N) / 2]; \
            const float keep = up ? a[4 + i + (N) / 2] : a[4 + i]; a[4 + i] = keep + xshfl<(MASK)>(send); }
        HALVE(32, 32) HALVE(16, 16) HALVE(8, 8) HALVE(4, 4) HALVE(2, 2)
#undef HALVE
        float ev = a[4] + xshfl<1>(a[4]);
        ev += bep[lane >> 1];
        int grp = 0; float gm = a[0];
#pragma unroll
        for (int c = 1; c < 4; ++c) if (a[c] > gm) { gm = a[c]; grp = c; }
        float gs = 0.f;
#pragma unroll
        for (int c = 0; c < 4; ++c) gs += __expf(a[c] - gm);
        const float pgrp = 1.0f / gs;
        float el[8];
        const int grpu = __builtin_amdgcn_readfirstlane(grp);
#pragma unroll
        for (int i = 0; i < 8; ++i) el[i] = __builtin_bit_cast(float, __builtin_amdgcn_readlane(__builtin_bit_cast(int, ev), (grpu * 8 + i) * 2));
        int i1 = 0; float m1 = el[0];
#pragma unroll
        for (int i = 1; i < 8; ++i) if (el[i] > m1) { m1 = el[i]; i1 = i; }
        int i2 = -1; float m2 = -INFINITY;
#pragma unroll
        for (int i = 0; i < 8; ++i) if (i != i1 && el[i] > m2) { m2 = el[i]; i2 = i; }
        const float e2 = __expf(m2 - m1);
        const float g1 = pgrp / (1.0f + e2), g2 = pgrp * e2 / (1.0f + e2);
        if (lane == 0 && (!dry || g1 < -1.0f)) {
            const int ea = grp * 8 + i1, eb = grp * 8 + i2;
            const unsigned pa = __hip_atomic_fetch_add(hist + ea, 1u, __ATOMIC_RELAXED, __HIP_MEMORY_SCOPE_WORKGROUP), pb = __hip_atomic_fetch_add(hist + eb, 1u, __ATOMIC_RELAXED, __HIP_MEMORY_SCOPE_WORKGROUP);
            toke[row * 2] = ea; toke[row * 2 + 1] = eb; tokg[row * 2] = g1; tokg[row * 2 + 1] = g2; tokp[row * 2] = (int)pa; tokp[row * 2 + 1] = (int)pb;
        }
    }
    __syncthreads();
    if (tid < 32 && !dry) ((int*)(ws + WS_WGB))[vcu * 32 + tid] = (int)atomicAdd(cnt + tid * 16, hist[tid]);
}

constexpr int RW2_STRIDE = 2080, RW2_TAB = 48 * RW2_STRIDE, RW2_SCR = RW2_TAB + 16384;
__device__ __forceinline__ void phase_router_mfma(int l, lptr lds, int vcu, int G, int wv) {
    const int tid = opaque_tid(wv), lane = tid & 63, wave = __builtin_amdgcn_readfirstlane(tid >> 6);
    unsigned char* ws = parg(lds, 31); float* outp = (float*)parg(lds, 30);
    const float* gain = pin(lds, 5) + l * DM;
    const float* bgp = pin(lds, 23) + l * 4; const float* bep = pin(lds, 25) + l * 32;
    const float* mod = (const float*)(ws + WS_MOD);
    const int nrows = (l == DEPTH - 1) ? NLAT : MTOT;
    const int RPW = nrows / G;
    const int row_lo = vcu * RPW; const int r_lo = mod_r(row_lo), r_hi = mod_r(row_lo + RPW - 1);
    {
        const float* wg = pin(lds, 22) + (size_t)l * 1024 * 4; const float* we = pin(lds, 24) + (size_t)l * 1024 * 32;
        for (int i = tid; i < 1024 * 32; i += NTHREADS) *(LAS bf16_t*)(lds + (i & 31) * RW2_STRIDE + (i >> 5) * 2) = (bf16_t)f2bf(we[i]);
        for (int i = tid; i < 1024 * 4; i += NTHREADS) *(LAS bf16_t*)(lds + (32 + (i & 3)) * RW2_STRIDE + (i >> 2) * 2) = (bf16_t)f2bf(wg[i]);
        for (int i = tid; i < 12 * 512; i += NTHREADS) *(LAS unsigned*)(lds + (36 + i / 512) * RW2_STRIDE + (i % 512) * 4) = 0u;
        LAS float* tab = (LAS float*)(lds + RW2_TAB);
        for (int i = tid; i < 2048; i += NTHREADS) { const int t = i >> 10, c = i & 1023; const int r = t ? r_hi : r_lo;
            const float* sh = mod + ((size_t)l * 17 + r) * 6144 + 3 * 1024;
            tab[t * 2048 + c] = gain[c] * (1.0f + sh[1024 + c]); tab[t * 2048 + 1024 + c] = sh[c]; }
        if (tid < 32) ((LAS unsigned*)(lds + LDS_MISC + 4608))[tid] = 0u;
    }
    __syncthreads();
    LAS unsigned* hist = (LAS unsigned*)(lds + LDS_MISC + 4608);
    bf16_t* H = (bf16_t*)(ws + WS_H);
    const float* rs16 = (const float*)(ws + WS_RS16);
    int* toke = (int*)(ws + WS_TOKE); float* tokg = (float*)(ws + WS_TOKG); int* tokp = (int*)(ws + WS_TOKP);
    const int rl = lane & 15, kq = lane >> 4;
    LAS float* scr = (LAS float*)(lds + RW2_SCR + wave * 3136);
    for (int b = wave; b < RPW / 16; b += NWAVES) {
        const int row0 = row_lo + 16 * b, row = row0 + rl;
        const int t = (mod_r(row0) == r_lo) ? 0 : 1;
        const LAS float* tA = (const LAS float*)(lds + RW2_TAB) + t * 2048 + 8 * kq; const LAS float* tB = tA + 1024;
        float rs;
        { const f32x4 p0 = *(const f32x4*)(rs16 + (size_t)row * 16), p1 = *(const f32x4*)(rs16 + (size_t)row * 16 + 4), p2 = *(const f32x4*)(rs16 + (size_t)row * 16 + 8), p3 = *(const f32x4*)(rs16 + (size_t)row * 16 + 12);
          const f32x4 q = (p0 + p1) + (p2 + p3); rs = __builtin_amdgcn_rsqf(((q[0] + q[1]) + (q[2] + q[3])) * (1.0f / DM) + NORM_EPS); }
        const float* xp = xrow_ptr(outp, ws, row) + 8 * kq;
        bf16_t* hp = H + (size_t)row * DM + 8 * kq;
        const LAS unsigned char* wp = lds + rl * RW2_STRIDE + 16 * kq;
        f32x4 acc0 = {0.f, 0.f, 0.f, 0.f}, acc1 = acc0, acc2 = acc0;
#pragma unroll 8
        for (int s = 0; s < 32; ++s) {
            const f32x4 x0 = *(const f32x4*)(xp + 32 * s), x1 = *(const f32x4*)(xp + 32 * s + 4);
            const f32x4 a0 = *(const LAS f32x4*)(tA + 32 * s), a1 = *(const LAS f32x4*)(tA + 32 * s + 4), b0 = *(const LAS f32x4*)(tB + 32 * s), b1 = *(const LAS f32x4*)(tB + 32 * s + 4);
            const f32x4 h0 = x0 * rs * a0 + b0, h1 = x1 * rs * a1 + b1;
            const u32x4 hw = pack8(h0, h1);
            *(u32x4*)(hp + 32 * s) = hw;
            const bf16x8 af = __builtin_bit_cast(bf16x8, hw);
            const bf16x8 w0 = *(const LAS bf16x8*)(wp + 64 * s), w1 = *(const LAS bf16x8*)(wp + 16 * RW2_STRIDE + 64 * s), w2 = *(const LAS bf16x8*)(wp + 32 * RW2_STRIDE + 64 * s);
            acc0 = __builtin_amdgcn_mfma_f32_16x16x32_bf16(af, w0, acc0, 0, 0, 0);
            acc1 = __builtin_amdgcn_mfma_f32_16x16x32_bf16(af, w1, acc1, 0, 0, 0);
            acc2 = __builtin_amdgcn_mfma_f32_16x16x32_bf16(af, w2, acc2, 0, 0, 0);
        }
#pragma unroll
        for (int j = 0; j < 4; ++j) { scr[(4 * kq + j) * 49 + rl] = acc0[j]; scr[(4 * kq + j) * 49 + 16 + rl] = acc1[j]; scr[(4 * kq + j) * 49 + 32 + rl] = acc2[j]; }
        LDS_WAIT();
        if (lane < 16) {
            const LAS float* lg = scr + lane * 49;
            float g[4];
#pragma unroll
            for (int c = 0; c < 4; ++c) g[c] = lg[32 + c] + bgp[c];
            int grp = 0; float gm = g[0];
#pragma unroll
            for (int c = 1; c < 4; ++c) if (g[c] > gm) { gm = g[c]; grp = c; }
            float gs = 0.f;
#pragma unroll
            for (int c = 0; c < 4; ++c) gs += __expf(g[c] - gm);
            const float pgrp = 1.0f / gs;
            float el[8];
#pragma unroll
            for (int i = 0; i < 8; ++i) el[i] = lg[grp * 8 + i] + bep[grp * 8 + i];
            int i1 = 0; float m1 = el[0];
#pragma unroll
            for (int i = 1; i < 8; ++i) if (el[i] > m1) { m1 = el[i]; i1 = i; }
            int i2 = -1; float m2 = -INFINITY;
#pragma unroll
            for (int i = 0; i < 8; ++i) if (i != i1 && el[i] > m2) { m2 = el[i]; i2 = i; }
            const float e2 = __expf(m2 - m1);
            const float g1 = pgrp / (1.0f + e2), g2 = pgrp * e2 / (1.0f + e2);
            const int ea = grp * 8 + i1, eb = grp * 8 + i2;
            const unsigned pa = __hip_atomic_fetch_add(hist + ea, 1u, __ATOMIC_RELAXED, __HIP_MEMORY_SCOPE_WORKGROUP), pb = __hip_atomic_fetch_add(hist + eb, 1u, __ATOMIC_RELAXED, __HIP_MEMORY_SCOPE_WORKGROUP);
            const int rr = row0 + lane;
            toke[rr * 2] = ea; toke[rr * 2 + 1] = eb; tokg[rr * 2] = g1; tokg[rr * 2 + 1] = g2; tokp[rr * 2] = (int)pa; tokp[rr * 2 + 1] = (int)pb;
        }
        LDS_WAIT();
    }
    __syncthreads();
    unsigned* cnt = (unsigned*)(ws + WS_CTL) + CW_CNT + l * 32 * 16;
    if (tid < 32) ((int*)(ws + WS_WGB))[vcu * 32 + tid] = (int)atomicAdd(cnt + tid * 16, hist[tid]);
}

__device__ __forceinline__ void phase_moe_scan(int l, lptr lds, int vcu, int G, int wv) {
    const int tid = opaque_tid(wv);
    unsigned char* ws = parg(lds, 31);
    LAS int* tile_exp = (LAS int*)(lds + LDS_MISC); LAS int* ntl = (LAS int*)(lds + LDS_MISC + 4096); LAS int* pad_start = (LAS int*)(lds + LDS_MISC + 4224); LAS int* cntl = (LAS int*)(lds + LDS_MISC + 4352);
    const unsigned* cnt = (const unsigned*)(ws + WS_CTL) + CW_CNT + l * 32 * 16;
    if (tid < 32) cntl[tid] = (int)__hip_atomic_load(cnt + tid * 16, __ATOMIC_RELAXED, __HIP_MEMORY_SCOPE_AGENT);
    __syncthreads();
    if (tid == 0) { int t = 0; for (int e = 0; e < 32; ++e) { pad_start[e] = t * 256; const int nt = (cntl[e] + 255) >> 8; for (int i = 0; i < nt; ++i) tile_exp[t + i] = e; t += nt; } ntl[0] = t; }
    __syncthreads();
    const int gt = vcu * NTHREADS + tid, NGT = G * NTHREADS;
    const int ntok = (l == DEPTH - 1) ? NLAT : MTOT;
    const int* toke = (const int*)(ws + WS_TOKE); const float* tokg = (const float*)(ws + WS_TOKG); const int* tokp = (const int*)(ws + WS_TOKP);
    int* tokd = (int*)(ws + WS_TOKD); int* slott = (int*)(ws + WS_SLOTT); float* slotg = (float*)(ws + WS_SLOTG);
    const int* wgb = (const int*)(ws + WS_WGB);
    for (int a = gt; a < 2 * ntok; a += NGT) { const int e = toke[a]; const int wgv = (a >> 1) / (ntok / G);
        const int dest = pad_start[e] + wgb[wgv * 32 + e] + tokp[a]; slott[dest] = a >> 1; slotg[dest] = tokg[a]; tokd[a] = dest; }
    for (int i = gt; i < 32 * 256; i += NGT) { const int e = i >> 8, off = i & 255; const int s = pad_start[e] + cntl[e] + off; const int end = pad_start[e] + (((cntl[e] + 255) >> 8) << 8);
        if (s < end) { slott[s] = ZROW; slotg[s] = 0.f; } }
}

struct Params { const float* in[30]; float* out; unsigned char* ws; };

__device__ __forceinline__ void moe_gemms(lptr lds, int l, int tid, int G, int bx) {
}

template <int L> __device__ __forceinline__ void layer_body(lptr lds, int wv) {
    constexpr int jj = L / 2, par = L % 2, l = L; constexpr bool last = (L == DEPTH - 1);
#define GRID_BAR() do { XcdBarrier b_; b_.bar = (unsigned*)(parg(lds, 31) + WS_CTL) + CW_BAR; b_.x = xb_xcc_id(); b_.st = (volatile LAS unsigned*)(lds + LDS_BYTES - 64); xcd_barrier(b_, wv); } while (0)
#define G   (opaque_s((int)gridDim.x))
#define bx  (opaque_s((int)blockIdx.x))
#define vcu (opaque_s((int)((blockIdx.x % 8) * (gridDim.x / 8) + blockIdx.x / 8)))
    const int tid = opaque_tid(wv);
            if (REP_ROW > 1 && l > 0) { phase_norm_mix(lds, l, vcu, G, wv, true); GRID_BAR(); }
            phase_norm_mix(lds, l, vcu, G, wv);
            GRID_BAR();
            if constexpr (par == 0) {
                for (int rep_ = 0; rep_ < REP_WIN; ++rep_)
                {
                    unsigned char* ws = parg(lds, 31);
                    pg8::GemmPlain g{(const char*)(ws + WS_H), (const char*)(ws + WS_WINE) + (size_t)jj * 1280 * 1024 * 2, 1024, 1024};
                    pg8::StaticOrder S; S.init(MTOT / 256, 5, G, bx);
                    EpiWinEven E{ws + WS_BIG, (float*)(ws + WS_RSQ), (const float*)(ws + WS_ROPE64), (const float*)(ws + WS_ROPE32)};
                    pg8::gemm_phase(lds, g, S, E, wv);
                }
                GRID_BAR();
                {
                    unsigned char* ws = parg(lds, 31);
                    pg8::GemmPlain g{(const char*)(ws + WS_BIG + BG_CQ), (const char*)(ws + WS_WUQ) + (size_t)jj * 768 * 256 * 2, 256, 256};
                    pg8::StaticOrder S; S.init(MTOT / 256, 3, G, bx);
                    EpiUq E{(bf16_t*)(ws + WS_BIG + BG_QM), (const float*)(ws + WS_RSQ), (const float*)(ws + WS_ROPE32)};
                    pg8::gemm_phase(lds, g, S, E, wv);
                }
                {
                    unsigned char* ws = parg(lds, 31);
                    pg8::GemmPlain g2{(const char*)(ws + WS_BIG + BG_CKVR), (const char*)(ws + WS_WUKV) + (size_t)jj * 1024 * 256 * 2, 256, 256};
                    pg8::StaticOrder S2; S2.init(MTOT / 256, 4, G, G - 1 - bx);
                    EpiUkv E2{(bf16_t*)(ws + WS_BIG + BG_KVM), (const float*)(ws + WS_RSQ)};
                    pg8::gemm_phase(lds, g2, S2, E2, wv);
                }
                GRID_BAR();
                for (int rep_ = 0; rep_ < REP_ATT; ++rep_) {
                {
                    unsigned char* big = parg(lds, 31) + WS_BIG; bf16_t* Hb = (bf16_t*)(parg(lds, 31) + WS_H);
                    att::Tensors Tm{(const bf16_t*)(big + BG_QM), (const bf16_t*)(big + BG_KVM), (const bf16_t*)(big + BG_CKVR), (const bf16_t*)(big + BG_KVM), Hb, nullptr, 0.f, nullptr, 0.f, 0.10206207261596575f * LOG2E};
                    LAS unsigned* redo = (LAS unsigned*)(lds + LDS_MISC + 4608 + 64);
#pragma unroll 1
                    for (int pass = 0; pass < 2; ++pass) {
#pragma unroll 1
                    for (int i = 0; i < 9; ++i) {
                        att::Unit U;
                        if (i < 8) { const int u = vcu + 256 * i, bh = u >> 4, qb = u & 15, b = bh >> 3, h = bh & 7; U = att::Unit{b * SEQ + qb * 256, b * SEQ, 64, NLAT + b * CTXL, h, 0, 0}; }
                        else { if (vcu >= 128) break; const int b = vcu >> 3, h = vcu & 7; U = att::Unit{NLAT + b * CTXL, 0, 0, NLAT + b * CTXL, h, 0, 0}; }
                        if (pass == 0) { const bool bad = att::attn_unit_q<att::MLA, false>(lds, U, Tm, wv); if (opaque_tid(wv) == 0) redo[i] = bad ? 1u : 0u; }
                        else { __syncthreads(); if (__builtin_amdgcn_readfirstlane(redo[i]) != 0u) (void)att::attn_unit_q<att::MLA, true>(lds, U, Tm, wv); }
                    }
                    }
                }
                {
                    unsigned char* big = parg(lds, 31) + WS_BIG; bf16_t* Hb = (bf16_t*)(parg(lds, 31) + WS_H);
                    att::Tensors Ts{(const bf16_t*)(big + BG_AQ), (const bf16_t*)(big + BG_AKV), nullptr, (const bf16_t*)(big + BG_AKV), Hb, pin(lds, 13) + jj * 8, 0.f, nullptr, 0.f, 1.0f};
                    LAS unsigned* redo = (LAS unsigned*)(lds + LDS_MISC + 4608 + 64);
#pragma unroll 1
                    for (int pass = 0; pass < 2; ++pass) {
#pragma unroll 1
                    for (int i = 0; i < 9; ++i) {
                        att::Unit U;
                        if (i < 8) { const int u = vcu + 256 * i, bh = u >> 4, qb = u & 15, b = bh >> 3, h = bh & 7;
                            const int q0 = qb * 256, t0 = (q0 == 0) ? 0 : (q0 / 64 - 2), t1 = (q0 / 64 + 5 > 63) ? 63 : (q0 / 64 + 5);
                            U = att::Unit{b * SEQ + q0, b * SEQ + 64 * t0, t1 - t0 + 1, NLAT + b * CTXL, h, q0, 64 * t0}; }
                        else { if (vcu < 128) break; const int u = vcu - 128, b = u >> 3, h = u & 7; U = att::Unit{NLAT + b * CTXL, 0, 0, NLAT + b * CTXL, h, 0, 0}; }
                        if (pass == 0) { const bool bad = att::attn_unit<att::SWA, false>(lds, U, Ts, wv); if (opaque_tid(wv) == 0) redo[i] = bad ? 1u : 0u; }
                        else { __syncthreads(); if (__builtin_amdgcn_readfirstlane(redo[i]) != 0u) (void)att::attn_unit<att::SWA, true>(lds, U, Ts, wv); }
                    }
                    }
                }
                }
                GRID_BAR();
                {
                    unsigned char* ws = parg(lds, 31); float* outp = (float*)parg(lds, 30); float* xctx = (float*)(ws + WS_XCTX);
                    pg8::GemmPlain g{(const char*)(ws + WS_H), (const char*)(ws + WS_WOUTE) + (size_t)jj * 1024 * 1024 * 2, 1024, 1024};
                    pg8::StaticOrder S; S.init(MTOT / 256, 4, G, bx);
                    EpiResid E{l == 0 ? pin(lds, 0) : outp, l == 0 ? pin(lds, 2) : xctx, outp, xctx, (const float*)(ws + WS_MOD) + (size_t)l * 17 * 6144, 2 * 1024, (float*)(ws + WS_RS16)};
                    pg8::gemm_phase(lds, g, S, E, wv);
                }
            } else {
                for (int rep_ = 0; rep_ < REP_WIN; ++rep_)
                {
                    unsigned char* ws = parg(lds, 31);
                    pg8::GemmPlain g{(const char*)(ws + WS_H), (const char*)(ws + WS_WINO) + (size_t)jj * 3072 * 1024 * 2, 1024, 1024};
                    pg8::StaticOrder S; S.init(MTOT / 256, 12, G, bx);
                    EpiWinOdd E{(bf16_t*)(ws + WS_BIG), (const float*)(ws + WS_ROPE64)};
                    pg8::gemm_phase(lds, g, S, E, wv);
                }
                GRID_BAR();
                for (int rep_ = 0; rep_ < REP_ATT; ++rep_)
                {
                    unsigned char* big = parg(lds, 31) + WS_BIG; bf16_t* Hb = (bf16_t*)(parg(lds, 31) + WS_H);
                    float d1 = 0.f, d2 = 0.f;
                    { const float* lq1 = pin(lds, 16) + jj * 64; const float* lk1 = pin(lds, 17) + jj * 64; const float* lq2 = pin(lds, 18) + jj * 64; const float* lk2 = pin(lds, 19) + jj * 64;
                      for (int i = 0; i < 64; ++i) { d1 += lq1[i] * lk1[i]; d2 += lq2[i] * lk2[i]; } }
                    const float lam_init = 0.8f - 0.6f * expf(-0.3f * (float)l);
                    const float lam = expf(d1) - expf(d2) + lam_init;
                    att::Tensors Td{(const bf16_t*)big, (const bf16_t*)big, nullptr, (const bf16_t*)big, Hb, nullptr, lam, pin(lds, 20) + jj * 128, 1.0f - lam_init, 0.125f * LOG2E};
                    LAS unsigned* redo = (LAS unsigned*)(lds + LDS_MISC + 4608 + 64);
#pragma unroll 1
                    for (int pass = 0; pass < 2; ++pass) {
#pragma unroll 1
                    for (int i = 0; i < 17; ++i) {
                        att::Unit U;
                        if (i < 16) { const int u = vcu + 256 * i, bh = u >> 5, qb = u & 31, b = bh >> 3, h = bh & 7; U = att::Unit{b * SEQ + qb * 128, b * SEQ, 64, NLAT + b * CTXL, h, 0, 0}; }
                        else { if (last) break; const int bh = vcu >> 1, half = vcu & 1, b = bh >> 3, h = bh & 7; U = att::Unit{NLAT + b * CTXL + half * 128, 0, 0, NLAT + b * CTXL, h, 0, 0}; }
                        if (pass == 0) { const bool bad = att::attn_unit_q<att::DIFF, false>(lds, U, Td, wv); if (opaque_tid(wv) == 0) redo[i] = bad ? 1u : 0u; }
                        else { __syncthreads(); if (__builtin_amdgcn_readfirstlane(redo[i]) != 0u) (void)att::attn_unit_q<att::DIFF, true>(lds, U, Td, wv); }
                    }
                    }
                }
                GRID_BAR();
                {
                    unsigned char* ws = parg(lds, 31); float* outp = (float*)parg(lds, 30); float* xctx = (float*)(ws + WS_XCTX);
                    pg8::GemmPlain g{(const char*)(ws + WS_H), (const char*)(ws + WS_WOUTO) + (size_t)jj * 1024 * 1024 * 2, 1024, 1024};
                    pg8::StaticOrder S; S.init((last ? NLAT : MTOT) / 256, 4, G, bx);
                    EpiResid E{outp, xctx, outp, xctx, (const float*)(ws + WS_MOD) + (size_t)l * 17 * 6144, 2 * 1024, (float*)(ws + WS_RS16)};
                    pg8::gemm_phase(lds, g, S, E, wv);
                }
            }
            GRID_BAR();
            phase_router_mfma(l, lds, vcu, G, wv);
            GRID_BAR();
            phase_moe_scan(l, lds, vcu, G, wv);
            GRID_BAR();
            for (int rep_ = 0; rep_ < REP_MOE; ++rep_)
            {
                unsigned char* ws = parg(lds, 31);
                LAS int* tile_exp = (LAS int*)(lds + LDS_MISC); LAS int* idx = (LAS int*)(lds + 131072); const int nt = *(LAS int*)(lds + LDS_MISC + 4096); const int* slott = (const int*)(ws + WS_SLOTT);
                const int cu_ = vcu;
                { const int t_ = opaque_tid(wv); for (int i = 0; i * G + cu_ < nt * 4; ++i) { const int pm = (i * G + cu_) >> 2; if (t_ < 256) idx[i * 256 + t_] = slott[pm * 256 + t_]; } }
                __syncthreads();
                GemmMoe1 g{(const char*)(ws + WS_H), (const char*)(ws + WS_W13) + (size_t)l * NEXP * 1024 * 1024 * 2, idx, tile_exp, 1024};
                MoeSched S{tile_exp, nt, G, cu_};
                EpiSwiglu E{(bf16_t*)(ws + WS_BIG + BG_ACT)};
                pg8::gemm_phase(lds, g, S, E, wv);
            }
            GRID_BAR();
            for (int rep_ = 0; rep_ < REP_MOE; ++rep_)
            {
                unsigned char* ws = parg(lds, 31);
                LAS int* tile_exp = (LAS int*)(lds + LDS_MISC); const int nt = *(LAS int*)(lds + LDS_MISC + 4096);
                GemmMoe2 g{(const char*)(ws + WS_BIG + BG_ACT), (const char*)(ws + WS_W2T) + (size_t)l * NEXP * 1024 * 512 * 2, tile_exp, 512};
                MoeSched S{tile_exp, nt, G, vcu};
                EpiMoe2 E{(bf16_t*)(ws + WS_BIG + BG_YB), (const float*)(ws + WS_SLOTG)};
                pg8::gemm_phase(lds, g, S, E, wv);
            }
            GRID_BAR();
}
#undef GRID_BAR
#undef G
#undef bx
#undef vcu
__global__ void __launch_bounds__(NTHREADS, 2) fwd_kernel(Params P) {
    extern __shared__ __attribute__((aligned(16))) unsigned char lds_raw[];
    const lptr lds = (lptr)lds_raw;
    const int tid = threadIdx.x;
    const int wv = __builtin_amdgcn_readfirstlane(tid >> 6);
#define G   (opaque_s((int)gridDim.x))
#define bx  (opaque_s((int)blockIdx.x))
#define vcu (opaque_s((int)((blockIdx.x % 8) * (gridDim.x / 8) + blockIdx.x / 8)))
    volatile LAS unsigned* bst = (volatile LAS unsigned*)(lds + LDS_BYTES - 64);
    if (tid < 16) bst[tid] = 0u;
    if (tid < 32) {
        const unsigned long long* ka = (const unsigned long long*)__builtin_amdgcn_kernarg_segment_ptr();
        ((LAS unsigned long long*)(lds + LDS_PB))[tid] = ka[tid];
    }
    __syncthreads();
    (void)xcd_barrier_post((unsigned*)(parg(lds, 31) + WS_CTL) + CW_BAR, bst, wv);
#define GRID_BAR() do { XcdBarrier b_; b_.bar = (unsigned*)(parg(lds, 31) + WS_CTL) + CW_BAR; b_.x = xb_xcc_id(); b_.st = (volatile LAS unsigned*)(lds + LDS_BYTES - 64); xcd_barrier(b_, wv); } while (0)

    for (int rep_ = 0; rep_ < REP_PRO; ++rep_) prologue_a(lds, vcu, G, wv);
    GRID_BAR();
    prologue_b(lds, vcu, G, wv);
    GRID_BAR();

    layer_body<0>(lds, wv);
    layer_body<1>(lds, wv);
    layer_body<2>(lds, wv);
    layer_body<3>(lds, wv);
    phase_norm_mix(lds, DEPTH, vcu, G, wv);
#undef G
#undef bx
#undef vcu
}

extern "C" void kernel_launch(void* const* d_in, const int* in_sizes, int n_in, void* d_out, int out_size, void* d_ws, size_t ws_size, hipStream_t stream) {
    static int grid = 0;
    if (grid == 0) {
        if (n_in != 30 || out_size != NLAT * DM || ws_size < WS_END + (REP_ROW > 1 ? (size_t)MTOT * DM * 2 : 0)) { fprintf(stderr, "kernel_launch: unexpected shapes (n_in %d out %d ws %zu need %zu)\n", n_in, out_size, ws_size, (size_t)WS_END); grid = -1; return; }
        int dev = 0, cus = 0, per_cu = 0;
        if (hipGetDevice(&dev) != hipSuccess || hipDeviceGetAttribute(&cus, hipDeviceAttributeMultiprocessorCount, dev) != hipSuccess) { grid = -1; return; }
        if (hipFuncSetAttribute((const void*)fwd_kernel, hipFuncAttributeMaxDynamicSharedMemorySize, LDS_BYTES) != hipSuccess) { fprintf(stderr, "kernel_launch: hipFuncSetAttribute failed\n"); grid = -1; return; }
        if (hipOccupancyMaxActiveBlocksPerMultiprocessor(&per_cu, (const void*)fwd_kernel, NTHREADS, LDS_BYTES) != hipSuccess || per_cu < 1) { fprintf(stderr, "kernel_launch: occupancy query says %d\n", per_cu); }
        (void)hipGetLastError();
        grid = cus;
        if (grid % 8 != 0 || grid < 8) { fprintf(stderr, "kernel_launch: unexpected CU count %d\n", cus); grid = -1; return; }
    }
    if (grid < 0) return;
    (void)hipMemsetAsync((char*)d_ws + WS_CTL, 0, CTL_ZERO, stream);
    Params p{};
    for (int i = 0; i < 30; ++i) p.in[i] = (const float*)d_in[i];
    p.out = (float*)d_out; p.ws = (unsigned char*)d_ws;
    hipLaunchKernelGGL(fwd_kernel, dim3(grid), dim3(NTHREADS), LDS_BYTES, stream, p);
}
```

```cpp
#include <hip/hip_runtime.h>
#include <cstdio>
#include <cstdint>

#define LAS __attribute__((address_space(3)))
#define GAS __attribute__((address_space(1)))
typedef unsigned short bf16_t;
typedef short bf16x8 __attribute__((ext_vector_type(8)));
typedef short s16x4 __attribute__((ext_vector_type(4)));
typedef float f32x4 __attribute__((ext_vector_type(4)));
typedef float f32x16 __attribute__((ext_vector_type(16)));
typedef unsigned u32x4 __attribute__((ext_vector_type(4)));
typedef unsigned u32x2 __attribute__((ext_vector_type(2)));
typedef LAS unsigned char* lptr;

#ifndef REP_ATT
#define REP_ATT 1
#endif
#ifndef REP_PRO
#define REP_PRO 1
#endif
#ifndef REP_MOE
#define REP_MOE 1
#endif
#ifndef REP_WIN
#define REP_WIN 1
#endif
#ifndef REP_ROW
#define REP_ROW 1
#endif
constexpr int DM = 1024, NB = 16, SEQ = 4096, CTXL = 256, DEPTH = 4;
constexpr int NLAT = NB * SEQ, NCTX = NB * CTXL, MTOT = NLAT + NCTX;
constexpr int NEXP = 32, EFF = 512;
constexpr int MAXSLOTS = 147456;
constexpr int MAXTILES = MAXSLOTS / 256;
constexpr int ZROW = MTOT;
constexpr int NWAVES = 8, NTHREADS = 512;
constexpr float NORM_EPS = 1e-6f, DIFF_EPS = 1e-5f;
constexpr float LOG2E = 1.4426950408889634f;

constexpr size_t al256(size_t x) { return (x + 255) & ~(size_t)255; }
constexpr size_t WS_CTL = 0, CTL_BYTES = 1u << 20, CTL_ZERO = 131072;
constexpr size_t WS_MODP = WS_CTL + CTL_BYTES;
constexpr size_t MOD_ELEMS = (size_t)DEPTH * 17 * 6144;
constexpr size_t WS_MOD = WS_MODP + al256(4 * MOD_ELEMS * 4);
constexpr size_t WS_ROPE64 = WS_MOD + al256(MOD_ELEMS * 4);
constexpr size_t WS_ROPE32 = WS_ROPE64 + (size_t)2 * SEQ * 32 * 4;
constexpr size_t WS_WINE = WS_ROPE32 + (size_t)2 * SEQ * 16 * 4;
constexpr size_t WS_WUQ = WS_WINE + (size_t)2 * 1280 * 1024 * 2;
constexpr size_t WS_WUKV = WS_WUQ + (size_t)2 * 768 * 256 * 2;
constexpr size_t WS_WOUTE = WS_WUKV + (size_t)2 * 1024 * 256 * 2;
constexpr size_t WS_WINO = WS_WOUTE + (size_t)2 * 1024 * 1024 * 2;
constexpr size_t WS_WOUTO = WS_WINO + (size_t)2 * 3072 * 1024 * 2;
constexpr size_t WS_W13 = WS_WOUTO + (size_t)2 * 1024 * 1024 * 2;
constexpr size_t WS_W2T = WS_W13 + (size_t)DEPTH * NEXP * 1024 * 1024 * 2;
constexpr size_t WS_XCTX = WS_W2T + (size_t)DEPTH * NEXP * 1024 * 512 * 2;
constexpr size_t WS_H = WS_XCTX + (size_t)NCTX * DM * 4;
constexpr size_t WS_BIG = WS_H + al256((size_t)(MTOT + 1) * DM * 2);
constexpr size_t BIG_BYTES = (size_t)MAXSLOTS * (512 + 1024) * 2;
constexpr size_t BG_AQ = 0;
constexpr size_t BG_AKV = BG_AQ + (size_t)MTOT * 512 * 2;
constexpr size_t BG_CQ = BG_AKV + (size_t)MTOT * 256 * 2;
constexpr size_t BG_CKVR = BG_CQ + (size_t)MTOT * 256 * 2;
constexpr size_t BG_QM = BG_CKVR + (size_t)MTOT * 256 * 2;
constexpr size_t BG_KVM = BG_QM + (size_t)MTOT * 768 * 2;
static_assert(BG_KVM + (size_t)MTOT * 1024 * 2 <= BIG_BYTES, "even view fits");
static_assert((size_t)MTOT * 3072 * 2 <= BIG_BYTES, "odd view fits");
constexpr size_t BG_ACT = 0;
constexpr size_t BG_YB = (size_t)MAXSLOTS * 512 * 2;
constexpr size_t WS_RSQ = WS_BIG + BIG_BYTES;
constexpr size_t WS_TOKE = WS_RSQ + (size_t)MTOT * 8 * 4;
constexpr size_t WS_TOKG = WS_TOKE + (size_t)MTOT * 2 * 4;
constexpr size_t WS_TOKP = WS_TOKG + (size_t)MTOT * 2 * 4;
constexpr size_t WS_TOKD = WS_TOKP + (size_t)MTOT * 2 * 4;
constexpr size_t WS_SLOTT = WS_TOKD + (size_t)MTOT * 2 * 4;
constexpr size_t WS_SLOTG = WS_SLOTT + (size_t)MAXSLOTS * 4;
constexpr size_t WS_WGB = WS_SLOTG + (size_t)MAXSLOTS * 4;
constexpr size_t WS_RS16 = WS_WGB + (size_t)256 * 32 * 4;
constexpr size_t WS_END = WS_RS16 + (size_t)MTOT * 16 * 4;
constexpr int CW_BAR = 4096;
constexpr int CW_CNT = 16384;
static_assert((CW_BAR + 3456) * 4 <= 131072 && (CW_CNT + DEPTH * 32 * 16) * 4 <= 131072, "control words inside the per-call memset");

constexpr int LDS_MISC = 147456;
constexpr int LDS_BYTES = 155648;
constexpr int LDS_PB = LDS_BYTES - 1024;

__device__ __forceinline__ unsigned f2bf(float f) { unsigned u = __builtin_bit_cast(unsigned, f); return (u + 0x7fffu + ((u >> 16) & 1u)) >> 16; }
typedef float f32x2_t __attribute__((ext_vector_type(2))); typedef __bf16 bf16x2_t __attribute__((ext_vector_type(2)));
__device__ __forceinline__ unsigned pk2(float lo, float hi) { const f32x2_t v = {lo, hi}; const bf16x2_t b = __builtin_convertvector(v, bf16x2_t); return __builtin_bit_cast(unsigned, b); }
__device__ __forceinline__ float bf2f(unsigned short b) { return __builtin_bit_cast(float, ((unsigned)b) << 16); }
__device__ __forceinline__ float bflo(unsigned w) { return __builtin_bit_cast(float, w << 16); }
__device__ __forceinline__ float bfhi(unsigned w) { return __builtin_bit_cast(float, w & 0xffff0000u); }
template <int MASK> __device__ __forceinline__ float xshfl(float v) {
    if (MASK == 32) { const auto rr = __builtin_amdgcn_permlane32_swap(__builtin_bit_cast(unsigned, v), __builtin_bit_cast(unsigned, v), false, false);
        const unsigned a = rr[0], b = rr[1]; const unsigned own = __builtin_bit_cast(unsigned, v); return __builtin_bit_cast(float, a ^ b ^ own); }
    else return __builtin_bit_cast(float, __builtin_amdgcn_ds_swizzle(__builtin_bit_cast(int, v), (MASK << 10) | 0x1f));
}
__device__ __forceinline__ float wave_sum(float v) {
    v += xshfl<1>(v); v += xshfl<2>(v); v += xshfl<4>(v); v += xshfl<8>(v); v += xshfl<16>(v); v += xshfl<32>(v);
    return v;
}
__device__ __forceinline__ int opaque_tid(int wv) { int t; asm volatile("v_mbcnt_lo_u32_b32 %0, -1, 0\n\tv_mbcnt_hi_u32_b32 %0, -1, %0" : "=v"(t)); return t | (wv << 6); }
__device__ __forceinline__ int opaque_s(int x) { asm volatile("" : "+s"(x)); return x; }
__device__ __forceinline__ int crow(int r, int hi) { return (r & 3) + 8 * (r >> 2) + 4 * hi; }
__device__ __forceinline__ unsigned char* parg(lptr lds, int i) {
    int pbo = LDS_PB; asm volatile("" : "+v"(pbo));
    const LAS unsigned* p = (const LAS unsigned*)(lds + pbo) + 2 * i;
    const unsigned lo = __builtin_amdgcn_readfirstlane(p[0]), hi = __builtin_amdgcn_readfirstlane(p[1]);
    return (unsigned char*)(((unsigned long long)hi << 32) | lo);
}
__device__ __forceinline__ const float* pin(lptr lds, int i) { return (const float*)parg(lds, i); }

#define XB_TMO      128
#define XB_XCNT(j)  (256  + 64 * (j))
#define XB_XSUB(j)  (1280 + 64 * (j))
#define XB_XGEN(j)  (2304 + 64 * (j))
#define XB_TOP      3328
#define XB_TOPGEN   3392
#define XCD_BAR_WORDS 3456
#define XB_SPIN_CAP (1u << 22)
__device__ __forceinline__ unsigned xb_ld(unsigned* p)              { return __hip_atomic_load(p, __ATOMIC_RELAXED, __HIP_MEMORY_SCOPE_AGENT); }
__device__ __forceinline__ unsigned xb_add(unsigned* p, unsigned v) { return __hip_atomic_fetch_add(p, v, __ATOMIC_RELAXED, __HIP_MEMORY_SCOPE_AGENT); }
__device__ __forceinline__ unsigned xb_xcc_id() { return (unsigned)__builtin_amdgcn_s_getreg((3 << 11) | 20) & 0xFu; }
#define XB_SPIN(cond, bar) do { unsigned _sp = 0; while (cond) { __builtin_amdgcn_s_sleep(1); \
    if ((++_sp & 255u) == 0u) { if (xb_ld(&(bar)[XB_TMO])) break; if (_sp > XB_SPIN_CAP) { atomicAdd(&(bar)[XB_TMO], 1u); break; } } } } while (0)
struct XcdBarrier { unsigned* bar; unsigned x; volatile LAS unsigned* st; };
__device__ __forceinline__ XcdBarrier xcd_barrier_post(unsigned* bar, volatile LAS unsigned* st, int wv) {
    XcdBarrier b; b.bar = bar; b.x = xb_xcc_id(); b.st = st;
    if (opaque_tid(wv) == 0) (void)xb_add(&bar[XB_XCNT(b.x)], 1u);
    return b;
}
__device__ __forceinline__ void xcd_barrier_complete(unsigned* bar, unsigned x, unsigned& nloc, unsigned& nx) {
    const unsigned G = gridDim.x * gridDim.y * gridDim.z;
    unsigned sum, cnt, mine, sp = 0u;
    for (;;) {
        sum = 0u; cnt = 0u; mine = 0u;
#pragma unroll
        for (unsigned j = 0; j < 16; ++j) { const unsigned c = xb_ld(&bar[XB_XCNT(j)]); sum += c; cnt += (c > 0u) ? 1u : 0u; mine = (j == x) ? c : mine; }
        if (sum == G) break;
        __builtin_amdgcn_s_sleep(1);
        if ((++sp & 255u) == 0u) { if (xb_ld(&bar[XB_TMO])) break; if (sp > XB_SPIN_CAP) { atomicAdd(&bar[XB_TMO], 1u); break; } }
    }
    nloc = mine > 0u ? mine : 1u; nx = cnt > 0u ? cnt : 1u;
}
__device__ __forceinline__ void xcd_barrier(const XcdBarrier& b, int wv) {
    asm volatile("s_waitcnt vmcnt(0)" ::: "memory");
    __syncthreads();
    if (opaque_tid(wv) == 0) {
        unsigned* bar = b.bar;
        __builtin_amdgcn_s_waitcnt(0);
        unsigned nloc = b.st[0], nx = b.st[1];
        if (nloc == 0u) { xcd_barrier_complete(bar, b.x, nloc, nx); b.st[0] = nloc; b.st[1] = nx; }
        const unsigned old = xb_add(&bar[XB_XSUB(b.x)], 1u);
        const unsigned gen = old / nloc;
        if (old + 1u == (gen + 1u) * nloc) {
            __builtin_amdgcn_fence(__ATOMIC_RELEASE, "agent");
            asm volatile("s_waitcnt vmcnt(0)" ::: "memory");
            const unsigned og = xb_add(&bar[XB_TOP], 1u);
            const unsigned tg = og / nx;
            if (og + 1u == (tg + 1u) * nx) xb_add(&bar[XB_TOPGEN], 1u);
            else XB_SPIN(xb_ld(&bar[XB_TOPGEN]) == tg, bar);
            __builtin_amdgcn_fence(__ATOMIC_ACQUIRE, "agent");
            xb_add(&bar[XB_XGEN(b.x)], 1u);
            asm volatile("s_waitcnt vmcnt(0)" ::: "memory");
        } else {
            XB_SPIN(xb_ld(&bar[XB_XGEN(b.x)]) == gen, bar);
            __builtin_amdgcn_fence(__ATOMIC_ACQUIRE, "agent");
            asm volatile("s_waitcnt vmcnt(0)" ::: "memory");
        }
    }
    __syncthreads();
}

struct Ctx {
    lptr lds;
    int tid, lane, wave, vcu, G;
    const float* const* in;
    float* out; unsigned char* ws;
};
__device__ __forceinline__ float* xrow_ptr(float* out, unsigned char* ws, int row) {
    return row < NLAT ? out + (size_t)row * DM : (float*)(ws + WS_XCTX) + (size_t)(row - NLAT) * DM;
}
__device__ __forceinline__ int mod_r(int row) { return row < NLAT ? (row >> 12) : 16; }

namespace pg8 {
constexpr int BM = 256, BK = 64, HALF = 128, HTB = HALF * BK * 2, STAGE_BYTES = 8 * HTB;
__device__ __forceinline__ int lds_byte(int r, int c) { const int st = (r >> 4) * 2 + (c >> 5), rr = r & 15, cc = c & 31, ob = rr * 64 + cc * 2; return st * 1024 + (ob ^ (((ob >> 9) & 1) << 5)); }
__device__ __forceinline__ void stage_rc(int b, int& R, int& C) { const int st = b / 1024, sb = b % 1024, swz = sb ^ (((sb >> 9) & 1) << 5); R = (st >> 1) * 16 + swz / 64; C = (st & 1) * 32 + (swz % 64) / 2; }
__device__ __forceinline__ int perm32(int rho) { const int n = rho >> 4, i = rho & 15; return 8 * (i >> 2) + 4 * n + (i & 3); }
struct Unit { int pm, pn, aux; };
template <class GD, class Sched, class Epi>
__device__ __forceinline__ void gemm_phase(lptr lds, const GD& G, const Sched& S, const Epi& E, int wv) {
    const int tid = opaque_tid(wv), wid = __builtin_amdgcn_readfirstlane(tid >> 6), lane = tid & 63, wr = wid >> 2, wc = wid & 3, fr = lane & 15, fq = lane >> 4;
    const int K = G.K, nt = K / BK;
    unsigned voffB[2];
#pragma unroll
    for (int i = 0; i < 2; ++i) { int R, C; stage_rc(tid * 16 + i * 8192, R, C); const int Rb = Epi::PERM ? ((R & ~31) + perm32(R & 31)) : R; voffB[i] = (unsigned)(Rb * K + C) * 2u; }
#define PG8_AOFFS(u, o00, o01, o10, o11) do { int R0_, C0_, R1_, C1_; stage_rc(tid * 16, R0_, C0_); stage_rc(tid * 16 + 8192, R1_, C1_); \
        o00 = G.a_off(u, R0_) + C0_ * 2; o01 = G.a_off(u, R1_) + C1_ * 2; o10 = G.a_off(u, HALF + R0_) + C0_ * 2; o11 = G.a_off(u, HALF + R1_) + C1_ * 2; } while (0)
    const size_t kstep = (size_t)(BK * 2);
    const size_t hstep = (size_t)HALF * K * 2;
    const unsigned ldsw = (unsigned)wid * 1024u;
    const int aoff = lds_byte(wr * 64 + fr, fq * 8), boff = lds_byte(wc * 32 + fr, fq * 8);
    const char* const Ab = G.a_base();
#define PG8_SA(b, h) (((b) * 2 + (h)) * HTB)
#define PG8_SB(b, h) ((4 + (b) * 2 + (h)) * HTB)
#define PG8_STAGE_B(bufoff, gbase) do { _Pragma("unroll") for (int _i = 0; _i < 2; ++_i) \
        __builtin_amdgcn_global_load_lds((const unsigned*)((const char*)(gbase) + voffB[_i]), (LAS unsigned*)(lds + (bufoff) + ldsw + _i * 8192), 16, 0, 0); } while (0)
#define PG8_STAGE_A(bufoff, o0, o1, kb) do { const char* ub_ = Ab + (size_t)(kb);     \
        __builtin_amdgcn_global_load_lds((const unsigned*)(ub_ + (o0)), (LAS unsigned*)(lds + (bufoff) + ldsw), 16, 0, 0); \
        __builtin_amdgcn_global_load_lds((const unsigned*)(ub_ + (o1)), (LAS unsigned*)(lds + (bufoff) + ldsw + 8192), 16, 0, 0); } while (0)
#define PG8_LDA(dst, b, h) do { _Pragma("unroll") for (int m = 0; m < 4; ++m) _Pragma("unroll") for (int k = 0; k < 2; ++k) dst[m][k] = *(const LAS bf16x8*)(lds + PG8_SA(b, h) + aoff + m * 2048 + k * 1024); } while (0)
#define PG8_LDB(dst, b, h) do { _Pragma("unroll") for (int n = 0; n < 2; ++n) _Pragma("unroll") for (int k = 0; k < 2; ++k) dst[n][k] = *(const LAS bf16x8*)(lds + PG8_SB(b, h) + boff + n * 2048 + k * 1024); } while (0)
#define PG8_MMA(ai, bj, At, Bt) do { __builtin_amdgcn_s_setprio(1); _Pragma("unroll") for (int m = 0; m < 4; ++m) _Pragma("unroll") for (int n = 0; n < 2; ++n) _Pragma("unroll") for (int k = 0; k < 2; ++k) \
        acc[ai][bj][m][n] = __builtin_amdgcn_mfma_f32_16x16x32_bf16(Bt[n][k], At[m][k], acc[ai][bj][m][n], 0, 0, 0); __builtin_amdgcn_s_setprio(0); } while (0)
#define PG8_WAIT_V(n) asm volatile("s_waitcnt vmcnt(" #n ")" ::: "memory")
#define PG8_WAIT_L(n) asm volatile("s_waitcnt lgkmcnt(" #n ")" ::: "memory")
#define PG8_BAR __builtin_amdgcn_s_barrier()
#define PG8_SCHED __builtin_amdgcn_sched_barrier(0)
    Unit cur, nxt; int ui = 0;
    if (!S.next(0, cur)) return;
    f32x4 acc[2][2][4][2];
    float zf = 0.f; asm volatile("" : "+v"(zf));
#pragma unroll
    for (int a = 0; a < 2; ++a)
#pragma unroll
        for (int b = 0; b < 2; ++b)
#pragma unroll
            for (int m = 0; m < 4; ++m)
#pragma unroll
                for (int n = 0; n < 2; ++n) acc[a][b][m][n] = (f32x4){zf, zf, zf, zf};
    bf16x8 At[4][2], B0[2][2], B1[2][2];
    unsigned c00, c01, c10, c11; PG8_AOFFS(cur, c00, c01, c10, c11);
    const char* cB = G.b_base(cur);
    PG8_STAGE_B(PG8_SB(0, 0), cB); PG8_STAGE_A(PG8_SA(0, 0), c00, c01, 0); PG8_STAGE_B(PG8_SB(0, 1), cB + hstep); PG8_STAGE_A(PG8_SA(0, 1), c10, c11, 0);
    if (wr == 1) PG8_BAR;
    PG8_WAIT_V(4); PG8_BAR;
    PG8_STAGE_B(PG8_SB(1, 0), cB + kstep); PG8_STAGE_A(PG8_SA(1, 0), c00, c01, kstep); PG8_STAGE_B(PG8_SB(1, 1), cB + hstep + kstep);
    PG8_WAIT_V(6); PG8_BAR;
    for (;;) {
        const bool has_next = S.next(ui + 1, nxt);
        const char* nB = has_next ? G.b_base(nxt) : cB;
        for (int t = 0; t < nt; t += 2) {
            const bool last = (t == nt - 2);
            const size_t k1 = (size_t)(t + 1) * kstep;
            const size_t k2 = last ? 0 : (size_t)(t + 2) * kstep, k3 = k2 + kstep;
            unsigned a00 = c00, a01 = c01, a10 = c10, a11 = c11;
            if (last && has_next) PG8_AOFFS(nxt, a00, a01, a10, a11);
            const char* b2 = last ? nB : cB + (size_t)(t + 2) * kstep; const char* b3 = b2 + kstep;
            PG8_LDB(B0, 0, 0); PG8_SCHED; PG8_LDA(At, 0, 0); PG8_STAGE_A(PG8_SA(1, 1), c10, c11, k1);
            PG8_WAIT_L(8); PG8_BAR; PG8_WAIT_L(0); PG8_MMA(0, 0, At, B0); PG8_BAR; PG8_SCHED;
            PG8_LDB(B1, 0, 1); PG8_STAGE_B(PG8_SB(0, 0), b2);
            PG8_BAR; PG8_WAIT_L(0); PG8_MMA(0, 1, At, B1); PG8_BAR;
            PG8_LDA(At, 0, 1); PG8_STAGE_A(PG8_SA(0, 0), a00, a01, k2);
            PG8_BAR; PG8_WAIT_L(0); PG8_MMA(1, 0, At, B0); PG8_BAR; PG8_SCHED;
            PG8_STAGE_B(PG8_SB(0, 1), b2 + hstep);
            PG8_WAIT_V(6); PG8_BAR; PG8_MMA(1, 1, At, B1); PG8_BAR;
            PG8_LDB(B0, 1, 0); PG8_SCHED; PG8_LDA(At, 1, 0); PG8_STAGE_A(PG8_SA(0, 1), a10, a11, k2);
            PG8_WAIT_L(8); PG8_BAR; PG8_WAIT_L(0); PG8_MMA(0, 0, At, B0); PG8_BAR; PG8_SCHED;
            PG8_LDB(B1, 1, 1); PG8_STAGE_B(PG8_SB(1, 0), b3);
            PG8_BAR; PG8_WAIT_L(0); PG8_MMA(0, 1, At, B1); PG8_BAR;
            PG8_LDA(At, 1, 1); PG8_STAGE_A(PG8_SA(1, 0), a00, a01, k3);
            PG8_BAR; PG8_WAIT_L(0); PG8_MMA(1, 0, At, B0); PG8_BAR; PG8_SCHED;
            PG8_STAGE_B(PG8_SB(1, 1), b3 + hstep);
            PG8_WAIT_V(6); PG8_BAR; PG8_MMA(1, 1, At, B1); PG8_BAR;
        }
        { int fr_ = fr, fq_ = fq; asm volatile("" : "+v"(fr_), "+v"(fq_));
          E(acc, cur, wr, wc, fr_, fq_); }
        if (!has_next) break;
#pragma unroll
        for (int a = 0; a < 2; ++a)
#pragma unroll
            for (int b = 0; b < 2; ++b)
#pragma unroll
                for (int m = 0; m < 4; ++m)
#pragma unroll
                    for (int n = 0; n < 2; ++n) acc[a][b][m][n] = (f32x4){zf, zf, zf, zf};
        cur = nxt; cB = nB; PG8_AOFFS(cur, c00, c01, c10, c11); ++ui;
    }
    PG8_WAIT_V(0);
    if (wr == 0) PG8_BAR;
    PG8_BAR;
#undef PG8_AOFFS
#undef PG8_SA
#undef PG8_SB
#undef PG8_STAGE_A
#undef PG8_STAGE_B
#undef PG8_LDA
#undef PG8_LDB
#undef PG8_MMA
#undef PG8_WAIT_V
#undef PG8_WAIT_L
#undef PG8_BAR
#undef PG8_SCHED
}

struct GemmPlain {
    const char* A; const char* Bt; int K; int lda;
    __device__ __forceinline__ const char* a_base() const { return A; }
    __device__ __forceinline__ unsigned a_off(const Unit& u, int r) const { return (unsigned)(((size_t)(u.pm * 256 + r) * lda) * 2); }
    __device__ __forceinline__ const char* b_base(const Unit& u) const { return Bt + (size_t)u.pn * 256 * K * 2; }
};
struct StaticOrder {
    int nM, nN, nwg, G, c;
    __device__ __forceinline__ void init(int nM_, int nN_, int G_, int c_) { nM = nM_; nN = nN_; nwg = nM * nN; G = G_; c = c_; }
    __device__ __forceinline__ bool next(int i, Unit& u) const {
        const long L = (long)i * G + c; if (L >= nwg) return false;
        int wgid = (int)L; { const int q = nwg / 8, r = nwg % 8, xcd = wgid % 8, off = wgid / 8; wgid = (xcd < r ? xcd * (q + 1) : r * (q + 1) + (xcd - r) * q) + off; }
        const int nig = 8 * nN, gid = wgid / nig, fm = gid * 8, gsz = (nM - fm) < 8 ? (nM - fm) : 8;
        u.pm = fm + ((wgid % nig) % gsz); u.pn = (wgid % nig) / gsz; u.aux = 0; return true;
    }
};
}

__device__ __forceinline__ void rope4(f32x4& v0, f32x4& v1, const float* cs, const float* sn) {
    const f32x4 c = *(const f32x4*)cs, s = *(const f32x4*)sn;
    const float a0 = v0[0] * c[0] - v0[1] * s[0], b0 = v0[1] * c[0] + v0[0] * s[0];
    const float a1 = v0[2] * c[1] - v0[3] * s[1], b1 = v0[3] * c[1] + v0[2] * s[1];
    const float a2 = v1[0] * c[2] - v1[1] * s[2], b2 = v1[1] * c[2] + v1[0] * s[2];
    const float a3 = v1[2] * c[3] - v1[3] * s[3], b3 = v1[3] * c[3] + v1[2] * s[3];
    v0 = (f32x4){a0, b0, a1, b1}; v1 = (f32x4){a2, b2, a3, b3};
}
__device__ __forceinline__ void rope_cs(float pos, const f32x4& rv, f32x4& c, f32x4& s) {
#pragma unroll
    for (int e = 0; e < 4; ++e) { const float r = __builtin_amdgcn_fractf(pos * rv[e]); c[e] = __builtin_amdgcn_cosf(r); s[e] = __builtin_amdgcn_sinf(r); }
}
__device__ __forceinline__ f32x4 rope_rv(int j0, float inv_nf) {
    f32x4 rv;
#pragma unroll
    for (int e = 0; e < 4; ++e) rv[e] = __builtin_amdgcn_exp2f(-(float)(j0 + e) * inv_nf * 13.287712379549449f) * 0.15915494309189535f;
    return rv;
}
__device__ __forceinline__ void rope4v(f32x4& v0, f32x4& v1, const f32x4& c, const f32x4& s) {
    const float a0 = v0[0] * c[0] - v0[1] * s[0], b0 = v0[1] * c[0] + v0[0] * s[0];
    const float a1 = v0[2] * c[1] - v0[3] * s[1], b1 = v0[3] * c[1] + v0[2] * s[1];
    const float a2 = v1[0] * c[2] - v1[1] * s[2], b2 = v1[1] * c[2] + v1[0] * s[2];
    const float a3 = v1[2] * c[3] - v1[3] * s[3], b3 = v1[3] * c[3] + v1[2] * s[3];
    v0 = (f32x4){a0, b0, a1, b1}; v1 = (f32x4){a2, b2, a3, b3};
}
__device__ __forceinline__ u32x4 pack8(const f32x4& v0, const f32x4& v1) { u32x4 w; w.x = pk2(v0[0], v0[1]); w.y = pk2(v0[2], v0[3]); w.z = pk2(v1[0], v1[1]); w.w = pk2(v1[2], v1[3]); return w; }
__device__ __forceinline__ float sumsq8(const f32x4& v0, const f32x4& v1) { return (v0[0] * v0[0] + v0[1] * v0[1]) + (v0[2] * v0[2] + v0[3] * v0[3]) + (v1[0] * v1[0] + v1[1] * v1[1]) + (v1[2] * v1[2] + v1[3] * v1[3]); }

struct EpiWinEven {
    static constexpr bool PERM = true;
    unsigned char* big; float* rsq; const float* rope64; const float* rope32;
    __device__ __forceinline__ void operator()(const f32x4 (&acc)[2][2][4][2], const pg8::Unit& u, int wr, int wc, int fr, int fq) const {
        const int row0 = u.pm * 256 + wr * 64 + fr;
        const bool lat = (u.pm * 256) < NLAT;
        bf16_t* dst; int ldc;
        if (u.pn < 2) { dst = (bf16_t*)(big + BG_AQ) + u.pn * 256; ldc = 512; }
        else if (u.pn == 2) { dst = (bf16_t*)(big + BG_AKV); ldc = 256; }
        else if (u.pn == 3) { dst = (bf16_t*)(big + BG_CQ); ldc = 256; }
        else { dst = (bf16_t*)(big + BG_CKVR); ldc = 256; }
        const bool r64 = lat && (u.pn <= 2), r32 = lat && (u.pn == 4) && (wc == 0);
        const int i0 = r64 ? (((wc & 1) * 32 + 8 * fq) >> 1) : 4 * fq;
        const int nfa = r64 ? 16 : 8;
        const f32x4 rv = rope_rv(i0 & (nfa - 1), r64 ? (1.0f / 16.0f) : (1.0f / 8.0f));
#pragma unroll
        for (int ai = 0; ai < 2; ++ai) {
            f32x4 cs[4], sn[4];
#pragma unroll
            for (int mh = 0; mh < 2; ++mh) {
            if (r64 || r32) {
#pragma unroll
                for (int m = 2 * mh; m < 2 * mh + 2; ++m) { const int sp = (row0 + ai * 128 + m * 16) & (SEQ - 1); rope_cs((float)((i0 < nfa) ? (sp >> 6) : (sp & 63)), rv, cs[m], sn[m]); }
            }
#pragma unroll
            for (int m = 2 * mh; m < 2 * mh + 2; ++m) {
                const int row = row0 + ai * 128 + m * 16;
                float ssq = 0.f;
#pragma unroll
                for (int bj = 0; bj < 2; ++bj) {
                    const int cl = bj * 128 + wc * 32 + 8 * fq;
                    f32x4 v0 = acc[ai][bj][m][0], v1 = acc[ai][bj][m][1];
                    if (u.pn < 2 || (u.pn == 2 && bj == 0)) { if (r64) rope4v(v0, v1, cs[m], sn[m]); if (u.pn < 2) { v0 = v0 * (0.125f * LOG2E); v1 = v1 * (0.125f * LOG2E); } }
                    else if (u.pn == 3) { ssq += sumsq8(v0, v1); }
                    else if (u.pn == 4) { if (bj == 0) ssq += sumsq8(v0, v1); else if (r32) rope4v(v0, v1, cs[m], sn[m]); }
                    *(u32x4*)(dst + (size_t)row * ldc + cl) = pack8(v0, v1);
                }
                if (u.pn >= 3) { ssq += xshfl<16>(ssq); ssq += xshfl<32>(ssq); if (fq == 0) rsq[(size_t)row * 8 + (u.pn - 3) * 4 + wc] = ssq; }
            }
            }
        }
    }
};
struct EpiUq {
    static constexpr bool PERM = true;
    bf16_t* qm; const float* rsq; const float* rope32;
    __device__ __forceinline__ void operator()(const f32x4 (&acc)[2][2][4][2], const pg8::Unit& u, int wr, int wc, int fr, int fq) const {
        const int row0 = u.pm * 256 + wr * 64 + fr; const bool lat = (u.pm * 256) < NLAT;
        const int colb0 = u.pn * 256 + wc * 32 + 8 * fq, colb1 = colb0 + 128;
        const int d0 = colb0 % 96, d1 = colb1 % 96;
        const bool rp0 = lat && d0 >= 64, rp1 = lat && d1 >= 64;
        const int i00 = rp0 ? ((d0 - 64) >> 1) : 0, i01 = rp1 ? ((d1 - 64) >> 1) : 0;
        const f32x4 rv0 = rope_rv(i00 & 7, 1.0f / 8.0f), rv1 = rope_rv(i01 & 7, 1.0f / 8.0f);
#pragma unroll
        for (int ai = 0; ai < 2; ++ai) {
            f32x4 pq[4], c0[4], s0[4], c1[4], s1[4];
#pragma unroll
            for (int m = 0; m < 4; ++m) { const int row = row0 + ai * 128 + m * 16; const int sp = row & (SEQ - 1);
                pq[m] = *(const f32x4*)(rsq + (size_t)row * 8);
                if (rp0) rope_cs((float)((i00 < 8) ? (sp >> 6) : (sp & 63)), rv0, c0[m], s0[m]);
                if (rp1) rope_cs((float)((i01 < 8) ? (sp >> 6) : (sp & 63)), rv1, c1[m], s1[m]); }
#pragma unroll
            for (int m = 0; m < 4; ++m) {
                const int row = row0 + ai * 128 + m * 16;
                const float rs = __builtin_amdgcn_rsqf(((pq[m][0] + pq[m][1]) + (pq[m][2] + pq[m][3])) * (1.0f / 256.0f) + NORM_EPS) * (0.10206207261596575f * LOG2E);
                { f32x4 v0 = acc[ai][0][m][0] * rs, v1 = acc[ai][0][m][1] * rs; if (rp0) rope4v(v0, v1, c0[m], s0[m]); *(u32x4*)(qm + (size_t)row * 768 + colb0) = pack8(v0, v1); }
                { f32x4 v0 = acc[ai][1][m][0] * rs, v1 = acc[ai][1][m][1] * rs; if (rp1) rope4v(v0, v1, c1[m], s1[m]); *(u32x4*)(qm + (size_t)row * 768 + colb1) = pack8(v0, v1); }
            }
        }
    }
};
struct EpiUkv {
    static constexpr bool PERM = true;
    bf16_t* kvm; const float* rsq;
    __device__ __forceinline__ void operator()(const f32x4 (&acc)[2][2][4][2], const pg8::Unit& u, int wr, int wc, int fr, int fq) const {
        const int row0 = u.pm * 256 + wr * 64 + fr;
        f32x4 pq[2][4];
#pragma unroll
        for (int ai = 0; ai < 2; ++ai)
#pragma unroll
            for (int m = 0; m < 4; ++m) pq[ai][m] = *(const f32x4*)(rsq + (size_t)(row0 + ai * 128 + m * 16) * 8 + 4);
#pragma unroll
        for (int ai = 0; ai < 2; ++ai)
#pragma unroll
            for (int m = 0; m < 4; ++m) {
                const int row = row0 + ai * 128 + m * 16; const f32x4 p = pq[ai][m];
                const float rs = __builtin_amdgcn_rsqf(((p[0] + p[1]) + (p[2] + p[3])) * (1.0f / 128.0f) + NORM_EPS);
#pragma unroll
                for (int bj = 0; bj < 2; ++bj) {
                    const int col = u.pn * 256 + bj * 128 + wc * 32 + 8 * fq;
                    const f32x4 v0 = acc[ai][bj][m][0] * rs, v1 = acc[ai][bj][m][1] * rs;
                    *(u32x4*)(kvm + (size_t)row * 1024 + col) = pack8(v0, v1);
                }
            }
    }
};
struct EpiWinOdd {
    static constexpr bool PERM = true;
    bf16_t* qkv; const float* rope64;
    __device__ __forceinline__ void operator()(const f32x4 (&acc)[2][2][4][2], const pg8::Unit& u, int wr, int wc, int fr, int fq) const {
        const int row0 = u.pm * 256 + wr * 64 + fr; const bool dorope = ((u.pm * 256) < NLAT) && (u.pn < 8);
        const int i0 = ((wc & 1) * 32 + 8 * fq) >> 1;
        const f32x4 rv = rope_rv(i0 & 15, 1.0f / 16.0f);
#pragma unroll
        for (int ai = 0; ai < 2; ++ai) {
            f32x4 cs[4], sn[4];
            if (dorope) {
#pragma unroll
                for (int m = 0; m < 4; ++m) { const int sp = (row0 + ai * 128 + m * 16) & (SEQ - 1); rope_cs((float)((i0 < 16) ? (sp >> 6) : (sp & 63)), rv, cs[m], sn[m]); }
            }
#pragma unroll
            for (int m = 0; m < 4; ++m) {
                const int row = row0 + ai * 128 + m * 16;
#pragma unroll
                for (int bj = 0; bj < 2; ++bj) {
                    const int col = u.pn * 256 + bj * 128 + wc * 32 + 8 * fq;
                    f32x4 v0 = acc[ai][bj][m][0], v1 = acc[ai][bj][m][1];
                    if (dorope) rope4v(v0, v1, cs[m], sn[m]);
                    if (u.pn < 4) { v0 = v0 * (0.125f * LOG2E); v1 = v1 * (0.125f * LOG2E); }
                    *(u32x4*)(qkv + (size_t)row * 3072 + col) = pack8(v0, v1);
                }
            }
        }
    }
};
struct EpiResid {
    static constexpr bool PERM = false;
    const float* src_lat; const float* src_ctx; float* dst_lat; float* dst_ctx; const float* mod; int gate_off;
    float* rs16;
    __device__ __forceinline__ void operator()(const f32x4 (&acc)[2][2][4][2], const pg8::Unit& u, int wr, int wc, int fr, int fq) const {
        const int rowt = u.pm * 256; const bool lat = rowt < NLAT;
        const float* sp = lat ? src_lat + (size_t)rowt * DM : src_ctx + (size_t)(rowt - NLAT) * DM;
        float* dp = lat ? dst_lat + (size_t)rowt * DM : dst_ctx + (size_t)(rowt - NLAT) * DM;
        const float* g = mod + (size_t)(lat ? (rowt >> 12) : 16) * 6144 + gate_off;
        const int r0 = wr * 64 + fr, col0 = u.pn * 256 + wc * 32 + 4 * fq;
        f32x4 gv[2][2];
#pragma unroll
        for (int bj = 0; bj < 2; ++bj)
#pragma unroll
            for (int n = 0; n < 2; ++n) gv[bj][n] = *(const f32x4*)(g + col0 + bj * 128 + n * 16);
#pragma unroll
        for (int ai = 0; ai < 2; ++ai) {
            f32x4 xv[4][2][2];
#pragma unroll
            for (int m = 0; m < 4; ++m) { const size_t ro = (size_t)(r0 + ai * 128 + m * 16) * DM + col0;
#pragma unroll
                for (int bj = 0; bj < 2; ++bj)
#pragma unroll
                    for (int n = 0; n < 2; ++n) xv[m][bj][n] = *(const f32x4*)(sp + ro + bj * 128 + n * 16); }
#pragma unroll
            for (int m = 0; m < 4; ++m) { const size_t ro = (size_t)(r0 + ai * 128 + m * 16) * DM + col0; float ss = 0.f;
#pragma unroll
                for (int bj = 0; bj < 2; ++bj)
#pragma unroll
                    for (int n = 0; n < 2; ++n) { const f32x4 y = xv[m][bj][n] + gv[bj][n] * acc[ai][bj][m][n]; *(f32x4*)(dp + ro + bj * 128 + n * 16) = y; ss += (y[0] * y[0] + y[1] * y[1]) + (y[2] * y[2] + y[3] * y[3]); }
                ss += xshfl<16>(ss); ss += xshfl<32>(ss);
                if (fq == 0) rs16[(size_t)(rowt + r0 + ai * 128 + m * 16) * 16 + u.pn * 4 + wc] = ss; }
        }
    }
};
struct EpiSwiglu {
    static constexpr bool PERM = true;
    bf16_t* act;
    __device__ __forceinline__ void operator()(const f32x4 (&acc)[2][2][4][2], const pg8::Unit& u, int wr, int wc, int fr, int fq) const {
        const int row0 = u.pm * 256 + wr * 64 + fr;
#pragma unroll
        for (int ai = 0; ai < 2; ++ai)
#pragma unroll
            for (int m = 0; m < 4; ++m) {
                const int row = row0 + ai * 128 + m * 16;
#pragma unroll
                for (int bj = 0; bj < 2; ++bj) {
                    const int col = u.pn * 256 + bj * 128 + wc * 32 + 8 * fq;
                    const f32x4 v0 = acc[ai][bj][m][0], v1 = acc[ai][bj][m][1];
                    float o[4];
                    { const float a = v0[0], b = v0[1]; o[0] = a / (1.f + __expf(-a)) * b; }
                    { const float a = v0[2], b = v0[3]; o[1] = a / (1.f + __expf(-a)) * b; }
                    { const float a = v1[0], b = v1[1]; o[2] = a / (1.f + __expf(-a)) * b; }
                    { const float a = v1[2], b = v1[3]; o[3] = a / (1.f + __expf(-a)) * b; }
                    u32x2 w; w.x = pk2(o[0], o[1]); w.y = pk2(o[2], o[3]);
                    *(u32x2*)(act + (size_t)row * EFF + (col >> 1)) = w;
                }
            }
    }
};
struct EpiMoe2 {
    static constexpr bool PERM = true;
    bf16_t* yb; const float* slot_gate;
    __device__ __forceinline__ void operator()(const f32x4 (&acc)[2][2][4][2], const pg8::Unit& u, int wr, int wc, int fr, int fq) const {
        const int row0 = u.pm * 256 + wr * 64 + fr;
        float gt[2][4];
#pragma unroll
        for (int ai = 0; ai < 2; ++ai)
#pragma unroll
            for (int m = 0; m < 4; ++m) gt[ai][m] = slot_gate[row0 + ai * 128 + m * 16];
#pragma unroll
        for (int ai = 0; ai < 2; ++ai)
#pragma unroll
            for (int m = 0; m < 4; ++m) {
                const int row = row0 + ai * 128 + m * 16; const float g = gt[ai][m];
#pragma unroll
                for (int bj = 0; bj < 2; ++bj) {
                    const int col = u.pn * 256 + bj * 128 + wc * 32 + 8 * fq;
                    const f32x4 v0 = acc[ai][bj][m][0] * g, v1 = acc[ai][bj][m][1] * g;
                    *(u32x4*)(yb + (size_t)row * DM + col) = pack8(v0, v1);
                }
            }
    }
};
struct MoeSched {
    const LAS int* tile_exp; int ntiles; int G, c;
    __device__ __forceinline__ bool next(int i, pg8::Unit& u) const {
        const int L = i * G + c; if (L >= ntiles * 4) return false;
        u.pm = L >> 2; u.pn = L & 3; u.aux = i; return true;
    }
};
struct GemmMoe1 {
    const char* H; const char* W13l; const LAS int* idx; const LAS int* tile_exp; int K;
    __device__ __forceinline__ const char* a_base() const { return H; }
    __device__ __forceinline__ unsigned a_off(const pg8::Unit& u, int r) const { return (unsigned)idx[u.aux * 256 + r] * (unsigned)(DM * 2); }
    __device__ __forceinline__ const char* b_base(const pg8::Unit& u) const { return W13l + ((size_t)tile_exp[u.pm] * 1024 + (size_t)u.pn * 256) * 1024 * 2; }
};
struct GemmMoe2 {
    const char* ACT; const char* W2l; const LAS int* tile_exp; int K;
    __device__ __forceinline__ const char* a_base() const { return ACT; }
    __device__ __forceinline__ unsigned a_off(const pg8::Unit& u, int r) const { return (unsigned)(u.pm * 256 + r) * (unsigned)(EFF * 2); }
    __device__ __forceinline__ const char* b_base(const pg8::Unit& u) const { return W2l + ((size_t)tile_exp[u.pm] * 1024 + (size_t)u.pn * 256) * 512 * 2; }
};

namespace att {
enum { MLA = 0, SWA = 1, DIFF = 2 };
template <int MODE> struct Cfg;
template <> struct Cfg<MLA>  { static constexpr int DQK = 96, DV = 64,  NKCH = 12, QB = 256; };
template <> struct Cfg<SWA>  { static constexpr int DQK = 64, DV = 64,  NKCH = 8,  QB = 256; };
template <> struct Cfg<DIFF> { static constexpr int DQK = 64, DV = 128, NKCH = 16, QB = 128; };
struct Unit {
    int qrow0;
    int lat_row0;
    int nlat;
    int ctx_row0;
    int head;
    int qpos0;
    int kpos0;
};
struct Tensors {
    const bf16_t* q; const bf16_t* k; const bf16_t* k2; const bf16_t* v; bf16_t* o;
    const float* sink; float lam; const float* subln; float post;
    float c2;
};
__device__ __forceinline__ s16x4 vtr(const LAS unsigned char* p) {
    typedef short v4i16_t __attribute__((ext_vector_type(4)));
    return __builtin_bit_cast(s16x4, __builtin_amdgcn_ds_read_tr16_b64_v4i16((LAS v4i16_t*)p));
}
template <int MODE>
__device__ __forceinline__ void issue_tile(lptr lds, int buf, int row0, const Tensors& T, int head, int wid, int lane) {
    typedef Cfg<MODE> C;
    constexpr int KB = C::NKCH * 1024, VB = C::DV * 128;
    for (int p = wid; p < C::NKCH; p += 8) {
        const bf16_t* src;
        const size_t row = (size_t)(row0 + lane);
        if (MODE == MLA) src = (p < 8) ? T.k + row * 1024 + head * 128 + p * 8 : T.k2 + row * 256 + 128 + (p - 8) * 8;
        else if (MODE == SWA) src = T.k + row * 256 + (head >> 2) * 64 + p * 8;
        else src = T.k + row * 3072 + 1024 + head * 128 + p * 8;
        __builtin_amdgcn_global_load_lds((const unsigned*)src, (LAS unsigned*)(lds + buf * KB + p * 1024), 16, 0, 0);
    }
    for (int p = wid; p < C::DV / 8; p += 8) {
        const size_t row = (size_t)(row0 + 16 * (p & 3) + (lane >> 2)); const int col = (p >> 2) * 32 + (lane & 3) * 8;
        const bf16_t* src;
        if (MODE == MLA) src = T.v + row * 1024 + head * 128 + 64 + col;
        else if (MODE == SWA) src = T.v + row * 256 + 128 + (head >> 2) * 64 + col;
        else src = T.v + row * 3072 + 2048 + head * 128 + col;
        __builtin_amdgcn_global_load_lds((const unsigned*)src, (LAS unsigned*)(lds + 2 * KB + buf * VB + p * 1024), 16, 0, 0);
    }
}
template <int MODE, bool GUARDED>
__device__ __forceinline__ bool attn_unit(lptr lds, const Unit& U, const Tensors& T, int wv) {
    typedef Cfg<MODE> C;
    constexpr int KB = C::NKCH * 1024, VB = C::DV * 128, NKS = C::DQK / 16, ND = C::DV / 32;
    const int tid = opaque_tid(wv), lane = tid & 63, r32 = lane & 31, hi = lane >> 5; const int wid = __builtin_amdgcn_readfirstlane(tid >> 6);
    const int br = (MODE == DIFF) ? (wid >> 2) : 0;
    const int wq = (MODE == DIFF) ? (wid & 3) : wid;
    const int NT = U.nlat + 4;
    issue_tile<MODE>(lds, 0, U.nlat > 0 ? U.lat_row0 : U.ctx_row0, T, U.head, wid, lane);
    bf16x8 qf[NKS];
    {
        const size_t qrow = (size_t)(U.qrow0 + wq * 32 + r32);
        const bf16_t* qp;
        if (MODE == MLA) qp = T.q + qrow * 768 + U.head * 96 + hi * 8;
        else if (MODE == SWA) qp = T.q + qrow * 512 + U.head * 64 + hi * 8;
        else qp = T.q + qrow * 3072 + U.head * 128 + br * 64 + hi * 8;
#pragma unroll
        for (int ks = 0; ks < NKS; ++ks) qf[ks] = *(const bf16x8*)(qp + ks * 16);
    }
    f32x16 o[ND];
#pragma unroll
    for (int d = 0; d < ND; ++d) o[d] = f32x16{};
    float m = GUARDED ? -INFINITY : 0.f, l = 0.f;
    const float c2 = T.c2;
    const int qpos = U.qpos0 + wq * 32 + r32, qa = U.qpos0 + wq * 32;
    const int koff = (MODE == DIFF ? br * 8192 : 0) + hi * 1024 + r32 * 16;
    const int voff = ((lane >> 4) & 1) * 32 + (lane & 3) * 8 + (4 * hi + ((lane & 15) >> 2)) * 64;
    asm volatile("s_waitcnt vmcnt(0)" ::: "memory");
    __syncthreads();
    for (int j = 0; j < NT; ++j) {
        const int buf = j & 1;
        if (j + 1 < NT) { const int jn = j + 1; issue_tile<MODE>(lds, buf ^ 1, jn < U.nlat ? U.lat_row0 + 64 * jn : U.ctx_row0 + 64 * (jn - U.nlat), T, U.head, wid, lane); }
        bool active = true; const bool latt = j < U.nlat; const int kt = U.kpos0 + 64 * j;
        if (MODE == SWA && latt) active = (kt <= qa + 31 + 128) && (kt + 63 >= qa - 128);
        if (active) {
            const lptr kb = lds + buf * KB + koff;
            f32x16 s0 = f32x16{}, s1 = f32x16{};
#pragma unroll
            for (int ks = 0; ks < NKS; ++ks) {
                const bf16x8 k0 = *(const LAS bf16x8*)(kb + ks * 2048), k1 = *(const LAS bf16x8*)(kb + ks * 2048 + 512);
                s0 = __builtin_amdgcn_mfma_f32_32x32x16_bf16(k0, qf[ks], s0, 0, 0, 0);
                s1 = __builtin_amdgcn_mfma_f32_32x32x16_bf16(k1, qf[ks], s1, 0, 0, 0);
            }
            if (MODE == SWA && latt) {
#pragma unroll
                for (int r = 0; r < 16; ++r) { const int kp = kt + crow(r, hi); int d0 = qpos - kp; d0 = d0 < 0 ? -d0 : d0; int d1 = qpos - kp - 32; d1 = d1 < 0 ? -d1 : d1;
                    if (d0 > 128) s0[r] = -INFINITY; if (d1 > 128) s1[r] = -INFINITY; }
            }
            float ps = 0.f;
            if (GUARDED) {
                float mt = fmaxf(s0[0], s1[0]);
#pragma unroll
                for (int r = 1; r < 16; ++r) mt = fmaxf(mt, fmaxf(s0[r], s1[r]));
                mt = fmaxf(mt, xshfl<32>(mt)) * c2;
                const float mn = fmaxf(m, mt);
                const float mu = (mn == -INFINITY) ? 0.f : mn;
                const float alpha = __builtin_amdgcn_exp2f(m - mu);
                m = mn;
#pragma unroll
                for (int r = 0; r < 16; ++r) { s0[r] = __builtin_amdgcn_exp2f(s0[r] * c2 - mu); s1[r] = __builtin_amdgcn_exp2f(s1[r] * c2 - mu); ps += s0[r] + s1[r]; }
                l = l * alpha + ps;
#pragma unroll
                for (int d = 0; d < ND; ++d)
#pragma unroll
                    for (int r = 0; r < 16; ++r) o[d][r] *= alpha;
            } else {
#pragma unroll
                for (int r = 0; r < 16; ++r) { s0[r] = __builtin_amdgcn_exp2f(s0[r]); s1[r] = __builtin_amdgcn_exp2f(s1[r]); ps += s0[r] + s1[r]; }
                l += ps;
            }
            bf16x8 pw[4];
            { u32x4 w;
              w.x = pk2(s0[0], s0[1]); w.y = pk2(s0[2], s0[3]); w.z = pk2(s0[4], s0[5]); w.w = pk2(s0[6], s0[7]); pw[0] = __builtin_bit_cast(bf16x8, w);
              w.x = pk2(s0[8], s0[9]); w.y = pk2(s0[10], s0[11]); w.z = pk2(s0[12], s0[13]); w.w = pk2(s0[14], s0[15]); pw[1] = __builtin_bit_cast(bf16x8, w);
              w.x = pk2(s1[0], s1[1]); w.y = pk2(s1[2], s1[3]); w.z = pk2(s1[4], s1[5]); w.w = pk2(s1[6], s1[7]); pw[2] = __builtin_bit_cast(bf16x8, w);
              w.x = pk2(s1[8], s1[9]); w.y = pk2(s1[10], s1[11]); w.z = pk2(s1[12], s1[13]); w.w = pk2(s1[14], s1[15]); pw[3] = __builtin_bit_cast(bf16x8, w); }
            const lptr vb = lds + 2 * KB + buf * VB + voff;
#pragma unroll
            for (int d = 0; d < ND; ++d)
#pragma unroll
                for (int kk = 0; kk < 4; ++kk) {
                    const s16x4 lo = vtr(vb + d * 4096 + kk * 1024), hh = vtr(vb + d * 4096 + kk * 1024 + 512);
                    const bf16x8 vf = (bf16x8){lo[0], lo[1], lo[2], lo[3], hh[0], hh[1], hh[2], hh[3]};
                    o[d] = __builtin_amdgcn_mfma_f32_32x32x16_bf16(vf, pw[kk], o[d], 0, 0, 0);
                }
        }
        asm volatile("s_waitcnt vmcnt(0)" ::: "memory");
        __syncthreads();
    }
    l += xshfl<32>(l);
    if (MODE == SWA) l += __builtin_amdgcn_exp2f(T.sink[U.head] * LOG2E - m);
    if (!GUARDED) {
        float oa = 0.f;
#pragma unroll
        for (int d = 0; d < ND; ++d)
#pragma unroll
            for (int r = 0; r < 16; ++r) oa += __builtin_fabsf(o[d][r]);
        const bool badl = !(l > 0x1p-100f && l < 0x1p100f) || !(oa < 0x1p120f);
        LAS unsigned* flg = (LAS unsigned*)(lds + LDS_MISC + 4608);
        const bool wbad = __builtin_amdgcn_ballot_w64(badl) != 0ull;
        if (lane == 0) flg[wid] = wbad ? 1u : 0u;
        __syncthreads();
        unsigned anyb = 0u;
#pragma unroll
        for (int w = 0; w < 8; ++w) anyb |= flg[w];
        __syncthreads();
        if (__builtin_amdgcn_readfirstlane(anyb) != 0u) return true;
    }
    const float inv = 1.0f / l;
#pragma unroll
    for (int d = 0; d < ND; ++d)
#pragma unroll
        for (int r = 0; r < 16; ++r) o[d][r] *= inv;
    const size_t orow = (size_t)(U.qrow0 + wq * 32 + r32);
    if (MODE == DIFF) {
        LAS float* xch = (LAS float*)lds + (size_t)(wid & 3) * 4096 + lane;
        if (br == 1) {
#pragma unroll
            for (int d = 0; d < ND; ++d)
#pragma unroll
                for (int r = 0; r < 16; ++r) xch[(d * 16 + r) * 64] = o[d][r];
        }
        __syncthreads();
        if (br == 0) {
            float ss = 0.f;
#pragma unroll
            for (int d = 0; d < ND; ++d)
#pragma unroll
                for (int r = 0; r < 16; ++r) { const float v = o[d][r] - T.lam * xch[(d * 16 + r) * 64]; o[d][r] = v; ss += v * v; }
            ss += xshfl<32>(ss);
            const float rs = __builtin_amdgcn_rsqf(ss * (1.0f / 128.0f) + DIFF_EPS) * T.post;
            bf16_t* op = T.o + orow * 1024 + U.head * 128;
#pragma unroll
            for (int d = 0; d < ND; ++d)
#pragma unroll
                for (int g = 0; g < 4; ++g) {
                    const int dv0 = 32 * d + 8 * g + 4 * hi; const f32x4 gn = *(const f32x4*)(T.subln + dv0);
                    u32x2 w; w.x = pk2(o[d][4 * g] * rs * gn[0], o[d][4 * g + 1] * rs * gn[1]); w.y = pk2(o[d][4 * g + 2] * rs * gn[2], o[d][4 * g + 3] * rs * gn[3]);
                    *(u32x2*)(op + dv0) = w;
                }
        }
        __syncthreads();
    } else {
        bf16_t* op = T.o + orow * 1024 + (MODE == MLA ? 512 + U.head * 64 : U.head * 64);
#pragma unroll
        for (int d = 0; d < ND; ++d)
#pragma unroll
            for (int g = 0; g < 4; ++g) {
                const int dv0 = 32 * d + 8 * g + 4 * hi;
                u32x2 w; w.x = pk2(o[d][4 * g], o[d][4 * g + 1]); w.y = pk2(o[d][4 * g + 2], o[d][4 * g + 3]);
                *(u32x2*)(op + dv0) = w;
            }
    }
    return false;
}
__device__ __forceinline__ void glds16(const void* gsrc, unsigned lds_dst) { unsigned keep;
    asm volatile("s_mov_b32 %0, m0\n\ts_mov_b32 m0, %2\n\ts_nop 0\n\tglobal_load_lds_dwordx4 %1, off\n\ts_mov_b32 m0, %0" : "=&s"(keep) : "v"(gsrc), "s"(lds_dst) : "memory"); }
template <int MODE>
__device__ __forceinline__ void issue_k(lptr lds, int kbyte, int row0, const Tensors& T, int head, int wid, int lane) {
    typedef Cfg<MODE> C;
#pragma unroll
    for (int q = 0; q < (C::NKCH + 7) / 8; ++q) {
        int p = wid + 8 * q; if (p >= C::NKCH) p -= 8;
        const bf16_t* src; const size_t row = (size_t)(row0 + lane);
        if (MODE == MLA) src = (p < 8) ? T.k + row * 1024 + head * 128 + p * 8 : T.k2 + row * 256 + 128 + (p - 8) * 8;
        else if (MODE == SWA) src = T.k + row * 256 + (head >> 2) * 64 + p * 8;
        else {
            const int r = 4 * p + (lane >> 4), sl = lane & 15;
            src = T.k + (size_t)(row0 + r) * 3072 + 1024 + head * 128 + ((sl ^ (r & 15)) * 8);
        }
        glds16(src, (unsigned)__builtin_amdgcn_readfirstlane((int)(unsigned)(size_t)(lds + kbyte + p * 1024)));
    }
}
template <int MODE>
__device__ __forceinline__ void issue_v(lptr lds, int vbyte, int row0, const Tensors& T, int head, int wid, int lane) {
    typedef Cfg<MODE> C;
#pragma unroll
    for (int q = 0; q < C::DV / 64; ++q) {
        const int p = wid + 8 * q;
        const size_t row = (size_t)(row0 + 16 * (p & 3) + (lane >> 2)); const int col = (p >> 2) * 32 + (lane & 3) * 8;
        const bf16_t* src;
        if (MODE == MLA) src = T.v + row * 1024 + head * 128 + 64 + col;
        else if (MODE == SWA) src = T.v + row * 256 + 128 + (head >> 2) * 64 + col;
        else {
            const int r = 4 * p + (lane >> 4), sl = lane & 15;
            src = T.v + (size_t)(row0 + r) * 3072 + 2048 + head * 128 + ((((sl >> 2) ^ (r & 3)) * 4 + (sl & 3)) * 8);
        }
        glds16(src, (unsigned)__builtin_amdgcn_readfirstlane((int)(unsigned)(size_t)(lds + vbyte + p * 1024)));
    }
}
template <int MODE>
__device__ __forceinline__ void attn_unit_p(lptr lds, const Unit& U, const Tensors& T, int wv) {
    typedef Cfg<MODE> C;
    constexpr int KB = C::NKCH * 1024, VB = C::DV * 128, NKS = C::DQK / 16, ND = C::DV / 32;
    constexpr float THR = 8.0f;
    const int tid = opaque_tid(wv), lane = tid & 63, r32 = lane & 31, hi = lane >> 5; const int wid = __builtin_amdgcn_readfirstlane(tid >> 6);
    const int br = (MODE == DIFF) ? (wid >> 2) : 0;
    const int wq = (MODE == DIFF) ? (wid & 3) : wid;
    const int NT = U.nlat + 4;
#define TROW(j) ((j) < U.nlat ? U.lat_row0 + 64 * (j) : U.ctx_row0 + 64 * ((j) - U.nlat))
    issue_k<MODE>(lds, 0, TROW(0), T, U.head, wid, lane);
    issue_v<MODE>(lds, 2 * KB, TROW(0), T, U.head, wid, lane);
    issue_k<MODE>(lds, KB, TROW(1), T, U.head, wid, lane);
    bf16x8 qf[NKS];
    {
        const size_t qrow = (size_t)(U.qrow0 + wq * 32 + r32);
        const bf16_t* qp;
        if (MODE == MLA) qp = T.q + qrow * 768 + U.head * 96 + hi * 8;
        else if (MODE == SWA) qp = T.q + qrow * 512 + U.head * 64 + hi * 8;
        else qp = T.q + qrow * 3072 + U.head * 128 + br * 64 + hi * 8;
#pragma unroll
        for (int ks = 0; ks < NKS; ++ks) qf[ks] = *(const bf16x8*)(qp + ks * 16);
    }
    f32x16 o[ND];
#pragma unroll
    for (int d = 0; d < ND; ++d) o[d] = f32x16{};
    float mref = -INFINITY, l = 0.f;
    const float c2 = T.c2;
    const int koff = (MODE == DIFF ? br * 8192 : 0) + hi * 1024 + r32 * 16;
    const int voff = ((lane >> 4) & 1) * 32 + (lane & 3) * 8 + (4 * hi + ((lane & 15) >> 2)) * 64;
#define QKT(D0, D1, KBUF) do { const lptr kb_ = lds + (KBUF) * KB + koff; D0 = f32x16{}; D1 = f32x16{}; \
        _Pragma("unroll") for (int ks = 0; ks < NKS; ++ks) { const bf16x8 k0_ = *(const LAS bf16x8*)(kb_ + ks * 2048), k1_ = *(const LAS bf16x8*)(kb_ + ks * 2048 + 512); \
            D0 = __builtin_amdgcn_mfma_f32_32x32x16_bf16(k0_, qf[ks], D0, 0, 0, 0); D1 = __builtin_amdgcn_mfma_f32_32x32x16_bf16(k1_, qf[ks], D1, 0, 0, 0); } } while (0)
#define SOFTMAX_PV(VBUF) do { \
        float mt_ = fmaxf(s0[0], s1[0]); \
        _Pragma("unroll") for (int r = 1; r < 16; ++r) mt_ = fmaxf(mt_, fmaxf(s0[r], s1[r])); \
        mt_ = fmaxf(mt_, xshfl<32>(mt_)) * c2; \
        if (__builtin_amdgcn_ballot_w64(mt_ > mref + THR) != 0ull) { \
            const float mn_ = fmaxf(mref, mt_); const float mu_ = (mn_ == -INFINITY) ? 0.f : mn_; const float alpha_ = __builtin_amdgcn_exp2f(mref - mu_); \
            mref = mn_; l *= alpha_; \
            _Pragma("unroll") for (int d = 0; d < ND; ++d) _Pragma("unroll") for (int r = 0; r < 16; ++r) o[d][r] *= alpha_; } \
        const float mu2_ = (mref == -INFINITY) ? 0.f : mref; float ps_ = 0.f; \
        _Pragma("unroll") for (int r = 0; r < 16; ++r) { s0[r] = __builtin_amdgcn_exp2f(s0[r] * c2 - mu2_); s1[r] = __builtin_amdgcn_exp2f(s1[r] * c2 - mu2_); ps_ += s0[r] + s1[r]; } \
        l += ps_; \
        bf16x8 pw_[4]; { u32x4 w_; \
          w_.x = pk2(s0[0], s0[1]); w_.y = pk2(s0[2], s0[3]); w_.z = pk2(s0[4], s0[5]); w_.w = pk2(s0[6], s0[7]); pw_[0] = __builtin_bit_cast(bf16x8, w_); \
          w_.x = pk2(s0[8], s0[9]); w_.y = pk2(s0[10], s0[11]); w_.z = pk2(s0[12], s0[13]); w_.w = pk2(s0[14], s0[15]); pw_[1] = __builtin_bit_cast(bf16x8, w_); \
          w_.x = pk2(s1[0], s1[1]); w_.y = pk2(s1[2], s1[3]); w_.z = pk2(s1[4], s1[5]); w_.w = pk2(s1[6], s1[7]); pw_[2] = __builtin_bit_cast(bf16x8, w_); \
          w_.x = pk2(s1[8], s1[9]); w_.y = pk2(s1[10], s1[11]); w_.z = pk2(s1[12], s1[13]); w_.w = pk2(s1[14], s1[15]); pw_[3] = __builtin_bit_cast(bf16x8, w_); } \
        const lptr vb_ = lds + 2 * KB + (VBUF) * VB + voff; \
        _Pragma("unroll") for (int d = 0; d < ND; ++d) _Pragma("unroll") for (int kk = 0; kk < 4; ++kk) { \
            const s16x4 lo_ = vtr(vb_ + d * 4096 + kk * 1024), hh_ = vtr(vb_ + d * 4096 + kk * 1024 + 512); \
            const bf16x8 vf_ = (bf16x8){lo_[0], lo_[1], lo_[2], lo_[3], hh_[0], hh_[1], hh_[2], hh_[3]}; \
            o[d] = __builtin_amdgcn_mfma_f32_32x32x16_bf16(vf_, pw_[kk], o[d], 0, 0, 0); } } while (0)
    asm volatile("s_waitcnt vmcnt(0)" ::: "memory");
    __syncthreads();
    f32x16 s0, s1;
    QKT(s0, s1, 0);
    __syncthreads();
    for (int j = 0; j + 1 < NT; ++j) {
        if (j + 2 < NT) issue_k<MODE>(lds, (j & 1) * KB, TROW(j + 2), T, U.head, wid, lane);
        issue_v<MODE>(lds, 2 * KB + ((j + 1) & 1) * VB, TROW(j + 1), T, U.head, wid, lane);
        f32x16 n0, n1;
        QKT(n0, n1, (j + 1) & 1);
        SOFTMAX_PV(j & 1);
        s0 = n0; s1 = n1;
        asm volatile("s_waitcnt vmcnt(0)" ::: "memory");
        __syncthreads();
    }
    SOFTMAX_PV((NT - 1) & 1);
    __syncthreads();
#undef TROW
#undef QKT
#undef SOFTMAX_PV
    l += xshfl<32>(l);
    const float inv = 1.0f / l;
#pragma unroll
    for (int d = 0; d < ND; ++d)
#pragma unroll
        for (int r = 0; r < 16; ++r) o[d][r] *= inv;
    const size_t orow = (size_t)(U.qrow0 + wq * 32 + r32);
    if (MODE == DIFF) {
        LAS float* xch = (LAS float*)lds + (size_t)(wid & 3) * 4096 + lane;
        if (br == 1) {
#pragma unroll
            for (int d = 0; d < ND; ++d)
#pragma unroll
                for (int r = 0; r < 16; ++r) xch[(d * 16 + r) * 64] = o[d][r];
        }
        __syncthreads();
        if (br == 0) {
            float ss = 0.f;
#pragma unroll
            for (int d = 0; d < ND; ++d)
#pragma unroll
                for (int r = 0; r < 16; ++r) { const float v = o[d][r] - T.lam * xch[(d * 16 + r) * 64]; o[d][r] = v; ss += v * v; }
            ss += xshfl<32>(ss);
            const float rs = __builtin_amdgcn_rsqf(ss * (1.0f / 128.0f) + DIFF_EPS) * T.post;
            bf16_t* op = T.o + orow * 1024 + U.head * 128;
#pragma unroll
            for (int d = 0; d < ND; ++d)
#pragma unroll
                for (int g = 0; g < 4; ++g) {
                    const int dv0 = 32 * d + 8 * g + 4 * hi; const f32x4 gn = *(const f32x4*)(T.subln + dv0);
                    u32x2 w; w.x = pk2(o[d][4 * g] * rs * gn[0], o[d][4 * g + 1] * rs * gn[1]); w.y = pk2(o[d][4 * g + 2] * rs * gn[2], o[d][4 * g + 3] * rs * gn[3]);
                    *(u32x2*)(op + dv0) = w;
                }
        }
        __syncthreads();
    } else {
        bf16_t* op = T.o + orow * 1024 + (MODE == MLA ? 512 + U.head * 64 : U.head * 64);
#pragma unroll
        for (int d = 0; d < ND; ++d)
#pragma unroll
            for (int g = 0; g < 4; ++g) {
                const int dv0 = 32 * d + 8 * g + 4 * hi;
                u32x2 w; w.x = pk2(o[d][4 * g], o[d][4 * g + 1]); w.y = pk2(o[d][4 * g + 2], o[d][4 * g + 3]);
                *(u32x2*)(op + dv0) = w;
            }
    }
}

template <int MODE, bool GUARDED>
__device__ __forceinline__ bool attn_unit_q(lptr lds, const Unit& U, const Tensors& T, int wv) {
    typedef Cfg<MODE> C;
    constexpr int KB = C::NKCH * 1024, VB = C::DV * 128, NKS = C::DQK / 16, ND = C::DV / 32;
    constexpr int NQK = 2 * NKS, NPV = 4 * ND;
    constexpr int EA = GUARDED ? 0 : ((MODE == MLA) ? 18 : 8);
    const int tid = opaque_tid(wv), lane = tid & 63, r32 = lane & 31, hi = lane >> 5; const int wid = __builtin_amdgcn_readfirstlane(tid >> 6);
    const int br = (MODE == DIFF) ? (wid >> 2) : 0;
    const int wq = (MODE == DIFF) ? (wid & 3) : wid;
    const int NT = U.nlat + 4;
#define TROW(j) ((j) < U.nlat ? U.lat_row0 + 64 * (j) : U.ctx_row0 + 64 * ((j) - U.nlat))
#define SBAR() __builtin_amdgcn_sched_barrier(0)
    issue_k<MODE>(lds, 0, TROW(0), T, U.head, wid, lane);
    issue_k<MODE>(lds, KB, TROW(1), T, U.head, wid, lane);
    issue_k<MODE>(lds, 2 * KB, TROW(2), T, U.head, wid, lane);
    issue_v<MODE>(lds, 3 * KB, TROW(0), T, U.head, wid, lane);
    bf16x8 qf[NKS];
    {
        const size_t qrow = (size_t)(U.qrow0 + wq * 32 + r32);
        const bf16_t* qp;
        if (MODE == MLA) qp = T.q + qrow * 768 + U.head * 96 + hi * 8;
        else qp = T.q + qrow * 3072 + U.head * 128 + br * 64 + hi * 8;
#pragma unroll
        for (int ks = 0; ks < NKS; ++ks) qf[ks] = *(const bf16x8*)(qp + ks * 16);
    }
    f32x16 o[ND];
#pragma unroll
    for (int d = 0; d < ND; ++d) o[d] = f32x16{};
    float mref = 0.f, mtrue = -INFINITY, l = 0.f; bool general = false;
    constexpr float GUARD = 64.0f;
    const int x15 = r32 & 15, q4 = (lane & 15) >> 2;
    const int koff = (MODE == DIFF) ? (r32 * 256 + ((br ^ (x15 >> 3)) * 128) + ((hi ^ (x15 & 1)) * 16)) : (hi * 1024 + r32 * 16);
    const int kx = (x15 >> 1) & 3;
    const int voff = (MODE == DIFF) ? ((4 * hi + q4) * 256 + ((lane >> 4) & 1) * 32 + (lane & 3) * 8) : (((lane >> 4) & 1) * 32 + (lane & 3) * 8 + (4 * hi + q4) * 64);
    f32x16 sA0, sA1, sB0, sB1;
    u32x4 pA[4], pB[4];
    float alpha = 1.f, negmu = 0.f; bool need = false; float psa = 0.f, psb = 0.f;
#define KFRAG(KBUF, i) ((MODE == DIFF) ? *(const LAS bf16x8*)(lds + (KBUF) + koff + ((((i) >> 1) ^ kx) * 32) + ((i) & 1) * 8192) : *(const LAS bf16x8*)(lds + (KBUF) + koff + ((i) >> 1) * 2048 + ((i) & 1) * 512))
#define EXPS(E0, E1, sc0, sc1, pkn) do { _Pragma("unroll") for (int e = (E0); e < (E1); ++e) { float p_; if (e < 16) { p_ = __builtin_amdgcn_exp2f(sc0[e & 15]); sc0[e & 15] = p_; } else { p_ = __builtin_amdgcn_exp2f(sc1[e & 15]); sc1[e & 15] = p_; } \
            if (e & 1) { psb += p_; const float q_ = (e < 16) ? sc0[(e - 1) & 15] : sc1[(e - 1) & 15]; unsigned w_ = pk2(q_, p_); asm volatile("" : "+v"(w_), "+v"(psa), "+v"(psb));   pkn[e >> 3][(e >> 1) & 3] = w_; } else psa += p_; } } while (0)
#define BLOCK_A(KBUF, DOMAX, n0, n1, sc0, sc1, pkn, DOEXPA) do { \
        bf16x8 kf_[3]; kf_[0] = KFRAG(KBUF, 0); kf_[1] = KFRAG(KBUF, 1); SBAR(); \
        _Pragma("unroll") for (int i = 0; i < NQK; ++i) { \
            if (i + 2 < NQK) kf_[(i + 2) % 3] = KFRAG(KBUF, i + 2); \
            if ((i & 1) == 0) n0 = __builtin_amdgcn_mfma_f32_32x32x16_bf16(kf_[i % 3], qf[i >> 1], (i < 2) ? f32x16{} : n0, 0, 0, 0); \
            else              n1 = __builtin_amdgcn_mfma_f32_32x32x16_bf16(kf_[i % 3], qf[i >> 1], (i < 2) ? f32x16{} : n1, 0, 0, 0); \
            if (GUARDED && DOMAX) { _Pragma("unroll") for (int e = (i * 32) / NQK; e < ((i + 1) * 32) / NQK; ++e) { const float x_ = (e < 16) ? sc0[e & 15] : sc1[e & 15]; if (e & 1) mb = fmaxf(mb, x_); else ma = fmaxf(ma, x_); } } \
            if (DOEXPA && EA > 0) EXPS((i * EA) / NQK, ((i + 1) * EA) / NQK, sc0, sc1, pkn); \
            SBAR(); } \
        if (DOEXPA && EA > 0) { l += psa + psb; psa = 0.f; psb = 0.f; } } while (0)
#define DECIDE() do { if (!GUARDED) break; float mt_ = fmaxf(ma, mb); mt_ = fmaxf(mt_, xshfl<32>(mt_)); mtrue = fmaxf(mtrue, mt_); \
        need = __builtin_amdgcn_ballot_w64((mt_ - mref > GUARD) || (mtrue - mref < -GUARD)) != 0ull; alpha = 1.f; \
        if (need) { const float mn_ = (mtrue == -INFINITY) ? mref : mtrue; alpha = __builtin_amdgcn_exp2f(fminf(mref - mn_, 126.0f)); mref = mn_; l *= alpha; general = true; } \
        negmu = -mref; } while (0)
#define VFRAG(DST, VBUF, i) do { const lptr vp_ = (MODE == DIFF) ? (lds + (VBUF) + voff + ((((i) >> 2) ^ q4) * 64) + ((i) & 3) * 4096) : (lds + (VBUF) + voff + ((i) >> 2) * 4096 + ((i) & 3) * 1024);     const s16x4 lo_ = vtr(vp_), hh_ = vtr(vp_ + ((MODE == DIFF) ? 2048 : 512)); \
        DST = (bf16x8){lo_[0], lo_[1], lo_[2], lo_[3], hh_[0], hh_[1], hh_[2], hh_[3]}; } while (0)
#define BLOCK_B(VBUF, DOPV, DOEXP, sc0, sc1, pk, pkn, ELO) do { \
        if (GUARDED && DOEXP && general) { _Pragma("unroll") for (int e = 0; e < 16; ++e) { sc0[e] += negmu; sc1[e] += negmu; } }     \
        if (DOPV) { bf16x8 vf_[3]; VFRAG(vf_[0], VBUF, 0); VFRAG(vf_[1], VBUF, 1); SBAR(); \
            _Pragma("unroll") for (int i = 0; i < NPV; ++i) { \
                if (i + 2 < NPV) VFRAG(vf_[(i + 2) % 3], VBUF, i + 2); \
                o[i >> 2] = __builtin_amdgcn_mfma_f32_32x32x16_bf16(vf_[i % 3], __builtin_bit_cast(bf16x8, pk[i & 3]), o[i >> 2], 0, 0, 0); \
                if (DOEXP) EXPS((ELO) + (i * (32 - (ELO))) / NPV, (ELO) + ((i + 1) * (32 - (ELO))) / NPV, sc0, sc1, pkn); \
                SBAR(); } } \
        else if (DOEXP) EXPS((ELO), 32, sc0, sc1, pkn); \
        if (DOEXP) { l += psa + psb; psa = 0.f; psb = 0.f; } } while (0)
#define RESCALE_O() do { if (GUARDED && need) { _Pragma("unroll") for (int d = 0; d < ND; ++d) _Pragma("unroll") for (int r = 0; r < 16; ++r) o[d][r] *= alpha; } } while (0)
    constexpr int NDMA = (C::NKCH + 7) / 8 + C::DV / 64;
#define WAIT_BAR_KEEP() do { if (NDMA == 4) asm volatile("s_waitcnt vmcnt(4) lgkmcnt(0)\n\ts_barrier" ::: "memory"); else asm volatile("s_waitcnt vmcnt(3) lgkmcnt(0)\n\ts_barrier" ::: "memory"); } while (0)
#define WAIT_BAR_ALL() asm volatile("s_waitcnt vmcnt(0) lgkmcnt(0)\n\ts_barrier" ::: "memory")
    if (wid >= 4) __builtin_amdgcn_s_setprio(1);
    WAIT_BAR_ALL();
    { float ma = -INFINITY, mb = -INFINITY; (void)ma; (void)mb; BLOCK_A(0, false, sA0, sA1, sA0, sA1, pA, false); }
    WAIT_BAR_ALL();
    int kn = KB;
#define VSLOT(t) (3 * KB + (((t) & 3) * VB))
#define KNEXT() do { kn = (kn == 2 * KB) ? 0 : kn + KB; } while (0)
#define ISSUE(j_) do { const int kfree = (kn == 0) ? 2 * KB : kn - KB; if ((j_) + 3 < NT) issue_k<MODE>(lds, kfree, TROW((j_) + 3), T, U.head, wid, lane); \
        issue_v<MODE>(lds, VSLOT((j_) + 1), TROW((j_) + 1), T, U.head, wid, lane); } while (0)
#define ENDW(j_) do { if ((j_) + 3 < NT) WAIT_BAR_KEEP(); else WAIT_BAR_ALL(); } while (0)
    if (wid < 4) {
        {
            float ma = -INFINITY, mb = -INFINITY;
            BLOCK_A(kn, true, sB0, sB1, sA0, sA1, pA, true);
            issue_k<MODE>(lds, 0, TROW(3), T, U.head, wid, lane); issue_v<MODE>(lds, VSLOT(1), TROW(1), T, U.head, wid, lane);
            DECIDE();
            BLOCK_B(0, false, true, sA0, sA1, pB, pA, EA);
            WAIT_BAR_KEEP(); KNEXT();
        }
#define STEP1(j_, N0, N1, SC0, SC1, PK, PKN) do { float ma = -INFINITY, mb = -INFINITY; \
            BLOCK_A(kn, true, N0, N1, SC0, SC1, PKN, true); ISSUE(j_); DECIDE(); BLOCK_B(VSLOT((j_) - 1), true, true, SC0, SC1, PK, PKN, EA); RESCALE_O(); ENDW(j_); KNEXT(); } while (0)
        for (int j = 1; j + 1 < NT; j += 2) { STEP1(j, sA0, sA1, sB0, sB1, pA, pB); STEP1(j + 1, sB0, sB1, sA0, sA1, pB, pA); }
#undef STEP1
        {
            float ma = -INFINITY, mb = -INFINITY;
            if (GUARDED) {
#pragma unroll
                for (int e = 0; e < 16; ++e) { ma = fmaxf(ma, sB0[e]); mb = fmaxf(mb, sB1[e]); } }
            DECIDE();
            BLOCK_B(VSLOT(NT - 2), true, true, sB0, sB1, pA, pB, 0);
            RESCALE_O();
            BLOCK_B(VSLOT(NT - 1), true, false, sB0, sB1, pB, pA, 0);
        }
    } else {
        float mcar;
        {
            float ma = -INFINITY, mb = -INFINITY;
            issue_k<MODE>(lds, 0, TROW(3), T, U.head, wid, lane); issue_v<MODE>(lds, VSLOT(1), TROW(1), T, U.head, wid, lane);
            BLOCK_A(kn, true, sB0, sB1, sA0, sA1, pA, true);
            mcar = fmaxf(ma, mb);
            WAIT_BAR_KEEP(); KNEXT();
        }
#define STEP2(j_, SC0, SC1, PK, PKN, SM0, SM1, DOPV) do { float ma = mcar, mb = mcar; \
            ISSUE(j_); DECIDE(); BLOCK_B(VSLOT((j_) - 2), DOPV, true, SC0, SC1, PK, PKN, EA); RESCALE_O(); \
            ma = -INFINITY; mb = -INFINITY; BLOCK_A(kn, true, SC0, SC1, SM0, SM1, PK, true); mcar = fmaxf(ma, mb); ENDW(j_); KNEXT(); } while (0)
        STEP2(1, sA0, sA1, pB, pA, sB0, sB1, false);
        STEP2(2, sB0, sB1, pA, pB, sA0, sA1, true);
        for (int j = 3; j + 1 < NT; j += 2) { STEP2(j, sA0, sA1, pB, pA, sB0, sB1, true); STEP2(j + 1, sB0, sB1, pA, pB, sA0, sA1, true); }
#undef STEP2
        {
            float ma = mcar, mb = mcar;
            DECIDE();
            BLOCK_B(VSLOT(NT - 3), true, true, sA0, sA1, pB, pA, EA);
            RESCALE_O();
            ma = -INFINITY; mb = -INFINITY;
            if (GUARDED) {
#pragma unroll
                for (int e = 0; e < 16; ++e) { ma = fmaxf(ma, sB0[e]); mb = fmaxf(mb, sB1[e]); } }
            DECIDE();
            BLOCK_B(VSLOT(NT - 2), true, true, sB0, sB1, pA, pB, 0);
            RESCALE_O();
            BLOCK_B(VSLOT(NT - 1), true, false, sB0, sB1, pB, pA, 0);
        }
    }
#undef VSLOT
#undef KNEXT
#undef ISSUE
#undef ENDW
    __builtin_amdgcn_s_setprio(0);
    WAIT_BAR_ALL();
#undef WAIT_BAR_KEEP
#undef WAIT_BAR_ALL
#undef TROW
#undef SBAR
#undef KFRAG
#undef BLOCK_A
#undef DECIDE
#undef VFRAG
#undef EXPS
#undef BLOCK_B
#undef RESCALE_O
    l += xshfl<32>(l);
    if (!GUARDED) {
        float oa = 0.f;
#pragma unroll
        for (int d = 0; d < ND; ++d)
#pragma unroll
            for (int r = 0; r < 16; ++r) oa += __builtin_fabsf(o[d][r]);
        const bool badl = !(l > 0x1p-100f && l < 0x1p100f) || !(oa < 0x1p120f);
        LAS unsigned* flg = (LAS unsigned*)(lds + LDS_MISC + 4608);
        const bool wbad = __builtin_amdgcn_ballot_w64(badl) != 0ull;
        if (lane == 0) flg[wid] = wbad ? 1u : 0u;
        __syncthreads();
        unsigned anyb = 0u;
#pragma unroll
        for (int w = 0; w < 8; ++w) anyb |= flg[w];
        __syncthreads();
        if (__builtin_amdgcn_readfirstlane(anyb) != 0u) return true;
    }
    const float inv = 1.0f / l;
#pragma unroll
    for (int d = 0; d < ND; ++d)
#pragma unroll
        for (int r = 0; r < 16; ++r) o[d][r] *= inv;
    const size_t orow = (size_t)(U.qrow0 + wq * 32 + r32);
    if (MODE == DIFF) {
        LAS float* xch = (LAS float*)lds + (size_t)(wid & 3) * 4096 + lane;
        if (br == 1) {
#pragma unroll
            for (int d = 0; d < ND; ++d)
#pragma unroll
                for (int r = 0; r < 16; ++r) xch[(d * 16 + r) * 64] = o[d][r];
        }
        __syncthreads();
        if (br == 0) {
            float ss = 0.f;
#pragma unroll
            for (int d = 0; d < ND; ++d)
#pragma unroll
                for (int r = 0; r < 16; ++r) { const float v = o[d][r] - T.lam * xch[(d * 16 + r) * 64]; o[d][r] = v; ss += v * v; }
            ss += xshfl<32>(ss);
            const float rs = __builtin_amdgcn_rsqf(ss * (1.0f / 128.0f) + DIFF_EPS) * T.post;
            bf16_t* op = T.o + orow * 1024 + U.head * 128;
#pragma unroll
            for (int d = 0; d < ND; ++d)
#pragma unroll
                for (int g = 0; g < 4; g += 2) {
                    u32x2 wa, wb;
                    { const int dv0 = 32 * d + 8 * g + 4 * hi; const f32x4 gn = *(const f32x4*)(T.subln + dv0);
                      wa.x = pk2(o[d][4 * g] * rs * gn[0], o[d][4 * g + 1] * rs * gn[1]); wa.y = pk2(o[d][4 * g + 2] * rs * gn[2], o[d][4 * g + 3] * rs * gn[3]); }
                    { const int dv1 = 32 * d + 8 * (g + 1) + 4 * hi; const f32x4 gn = *(const f32x4*)(T.subln + dv1);
                      wb.x = pk2(o[d][4 * g + 4] * rs * gn[0], o[d][4 * g + 5] * rs * gn[1]); wb.y = pk2(o[d][4 * g + 6] * rs * gn[2], o[d][4 * g + 7] * rs * gn[3]); }
                    const auto rx = __builtin_amdgcn_permlane32_swap(wa.x, wb.x, false, false); const auto ry = __builtin_amdgcn_permlane32_swap(wa.y, wb.y, false, false);
                    *(u32x4*)(op + 32 * d + 8 * g + 8 * hi) = (u32x4){rx[0], ry[0], rx[1], ry[1]};
                }
        }
        __syncthreads();
    } else {
        bf16_t* op = T.o + orow * 1024 + 512 + U.head * 64;
#pragma unroll
        for (int d = 0; d < ND; ++d)
#pragma unroll
            for (int g = 0; g < 4; g += 2) {
                u32x2 wa, wb; wa.x = pk2(o[d][4 * g], o[d][4 * g + 1]); wa.y = pk2(o[d][4 * g + 2], o[d][4 * g + 3]); wb.x = pk2(o[d][4 * g + 4], o[d][4 * g + 5]); wb.y = pk2(o[d][4 * g + 6], o[d][4 * g + 7]);
                const auto rx = __builtin_amdgcn_permlane32_swap(wa.x, wb.x, false, false); const auto ry = __builtin_amdgcn_permlane32_swap(wa.y, wb.y, false, false);
                *(u32x4*)(op + 32 * d + 8 * g + 8 * hi) = (u32x4){rx[0], ry[0], rx[1], ry[1]};
            }
    }
    return false;
}
}

#define LDS_WAIT() asm volatile("s_waitcnt lgkmcnt(0)" ::: "memory")
template <class F> __device__ __forceinline__ void tr_generic_item(const F& f, int Kpad, bf16_t* WT, LAS float* scr, int kb, int nb, int lane) {
    const int k0 = 64 * kb, n0 = 32 * nb;
    float fv[32];
#pragma unroll
    for (int i = 0; i < 32; ++i) fv[i] = f(k0 + 2 * i + (lane >> 5), n0 + (lane & 31));
#pragma unroll
    for (int i = 0; i < 32; ++i) { const int kk = 2 * i + (lane >> 5); scr[kk * 33 + (lane & 31)] = fv[i]; }
    LDS_WAIT();
    const int c = lane & 7;
#pragma unroll
    for (int j = 0; j < 4; ++j) { const int n = (lane >> 3) + 8 * j; const LAS float* s = scr + (8 * c) * 33 + n;
        u32x4 o; o.x = pk2(s[0 * 33], s[1 * 33]); o.y = pk2(s[2 * 33], s[3 * 33]); o.z = pk2(s[4 * 33], s[5 * 33]); o.w = pk2(s[6 * 33], s[7 * 33]);
        *(u32x4*)(WT + (size_t)(n0 + n) * Kpad + k0 + 8 * c) = o; }
    LDS_WAIT();
}
struct FWinEven { const float* W;
    __device__ __forceinline__ float operator()(int k, int n) const {
        int oc;
        if (n < 640) { const int blk = n >> 6, d = n & 63; oc = blk * 64 + (d & 1) * 32 + (d >> 1); }
        else if (n < 1152) oc = n;
        else if (n < 1184) { const int d = n - 1152; oc = 1152 + (d & 1) * 16 + (d >> 1); }
        else return 0.f;
        return W[(size_t)k * 1184 + oc];
    } };
struct FWuq { const float* W; const float* g;
    __device__ __forceinline__ float operator()(int k, int n) const {
        const int h = n / 96, d = n - h * 96; int oc;
        if (d < 64) oc = h * 96 + d; else { const int dd = d - 64; oc = h * 96 + 64 + (dd & 1) * 16 + (dd >> 1); }
        return W[(size_t)k * 768 + oc] * g[k];
    } };
struct FWukv { const float* W; const float* g;
    __device__ __forceinline__ float operator()(int k, int n) const { return k < 128 ? W[(size_t)k * 1024 + n] * g[k] : 0.f; } };
struct FPlain { const float* W; int N;
    __device__ __forceinline__ float operator()(int k, int n) const { return W[(size_t)k * N + n]; } };
struct FWinOdd { const float* W;
    __device__ __forceinline__ float operator()(int k, int n) const {
        int oc = n; if (n < 2048) { const int blk = n >> 6, d = n & 63; oc = blk * 64 + (d & 1) * 32 + (d >> 1); }
        return W[(size_t)k * 3072 + oc];
    } };
__device__ __forceinline__ void tr_expert_item(int item, LAS float* scr, int lane, const float* w1, const float* w3, const float* w2, bf16_t* W13, bf16_t* W2T) {
    const int q = lane & 15, kr = lane >> 4;
    bf16_t* dst; int Kd, k0, n0;
    if (item < 32768) {
        const int le = item >> 8, kb = (item >> 4) & 15, nb = item & 15; k0 = kb * 64; n0 = nb * 64; Kd = 1024;
        const float* src = ((q < 8) ? w1 : w3) + (size_t)le * 1024 * 512 + (n0 >> 1) + 4 * (q & 7);
        f32x4 v[16];
#pragma unroll
        for (int i = 0; i < 16; ++i) v[i] = *(const f32x4*)(src + (size_t)(k0 + 4 * i + kr) * 512);
#pragma unroll
        for (int i = 0; i < 16; ++i) { const int kk = 4 * i + kr; LAS float* p = scr + kk * 65 + 8 * (q & 7) + (q >> 3); p[0] = v[i][0]; p[2] = v[i][1]; p[4] = v[i][2]; p[6] = v[i][3]; }
        dst = W13 + (size_t)le * 1024 * 1024;
    } else {
        const int it = item - 32768, le = it >> 7, kb = (it >> 4) & 7, nb = it & 15; k0 = kb * 64; n0 = nb * 64; Kd = 512;
        const float* src = w2 + (size_t)le * 512 * 1024 + n0 + 4 * q;
        f32x4 v[16];
#pragma unroll
        for (int i = 0; i < 16; ++i) v[i] = *(const f32x4*)(src + (size_t)(k0 + 4 * i + kr) * 1024);
#pragma unroll
        for (int i = 0; i < 16; ++i) { const int kk = 4 * i + kr; LAS float* p = scr + kk * 65 + 4 * q; p[0] = v[i][0]; p[1] = v[i][1]; p[2] = v[i][2]; p[3] = v[i][3]; }
        dst = W2T + (size_t)le * 1024 * 512;
    }
    LDS_WAIT();
    const int c = lane & 7;
#pragma unroll
    for (int j = 0; j < 8; ++j) { const int n = (lane >> 3) + 8 * j; const LAS float* s = scr + (8 * c) * 65 + n;
        u32x4 o; o.x = pk2(s[0 * 65], s[1 * 65]); o.y = pk2(s[2 * 65], s[3 * 65]); o.z = pk2(s[4 * 65], s[5 * 65]); o.w = pk2(s[6 * 65], s[7 * 65]);
        *(u32x4*)(dst + (size_t)(n0 + n) * Kd + k0 + 8 * c) = o; }
    LDS_WAIT();
}

__device__ __forceinline__ void prologue_a(lptr lds, int vcu, int G, int wv) {
    const int tid = opaque_tid(wv), lane = tid & 63, wave = __builtin_amdgcn_readfirstlane(tid >> 6);
    unsigned char* ws = parg(lds, 31);
    const int gw = vcu * NWAVES + wave, NGW = G * NWAVES;
    LAS float* scr = (LAS float*)(lds + wave * 16640);
    for (int it = gw; it < 49152; it += NGW) tr_expert_item(it, scr, lane, pin(lds, 26), pin(lds, 27), pin(lds, 28), (bf16_t*)(ws + WS_W13), (bf16_t*)(ws + WS_W2T));
    for (int it = gw; it < 6848; it += NGW) {
        const int j = it / 3424; int r = it - j * 3424;
        if (r < 640) { FWinEven f{pin(lds, 8) + (size_t)j * 1024 * 1184}; tr_generic_item(f, 1024, (bf16_t*)(ws + WS_WINE) + (size_t)j * 1280 * 1024, scr, r / 40, r % 40, lane); continue; } r -= 640;
        if (r < 96) { FWuq f{pin(lds, 10) + (size_t)j * 256 * 768, pin(lds, 9) + j * 256}; tr_generic_item(f, 256, (bf16_t*)(ws + WS_WUQ) + (size_t)j * 768 * 256, scr, r / 24, r % 24, lane); continue; } r -= 96;
        if (r < 128) { FWukv f{pin(lds, 12) + (size_t)j * 128 * 1024, pin(lds, 11) + j * 128}; tr_generic_item(f, 256, (bf16_t*)(ws + WS_WUKV) + (size_t)j * 1024 * 256, scr, r / 32, r % 32, lane); continue; } r -= 128;
        if (r < 512) { FPlain f{pin(lds, 14) + (size_t)j * 1024 * 1024, 1024}; tr_generic_item(f, 1024, (bf16_t*)(ws + WS_WOUTE) + (size_t)j * 1024 * 1024, scr, r / 32, r % 32, lane); continue; } r -= 512;
        if (r < 1536) { FWinOdd f{pin(lds, 15) + (size_t)j * 1024 * 3072}; tr_generic_item(f, 1024, (bf16_t*)(ws + WS_WINO) + (size_t)j * 3072 * 1024, scr, r / 96, r % 96, lane); continue; } r -= 1536;
        { FPlain f{pin(lds, 21) + (size_t)j * 1024 * 1024, 1024}; tr_generic_item(f, 1024, (bf16_t*)(ws + WS_WOUTO) + (size_t)j * 1024 * 1024, scr, r / 32, r % 32, lane); }
    }
    {
        const int gt = gw * 64 + lane;
        if (gt < 512) ((unsigned*)(ws + WS_H + (size_t)ZROW * DM * 2))[gt] = 0u;
    }
    {
        float* modp = (float*)(ws + WS_MODP);
        const float* adaw = pin(lds, 6); const float* cvec = pin(lds, 1); const float* cctx = pin(lds, 3);
        __syncthreads();
        LAS float* sil = (LAS float*)lds;
        for (int i = tid; i < 17 * 1024; i += NTHREADS) { const int r = i >> 10, k = i & 1023; const float cv = (r < 16) ? cvec[r * 1024 + k] : cctx[k]; sil[k * 17 + r] = cv / (1.f + __expf(-cv)); }
        __syncthreads();
        for (int it = gw; it < 1536; it += NGW) {
            const int kq = it / 384, rem = it - kq * 384, l = rem / 96, nb = rem - l * 96; const int n = nb * 64 + lane;
            const float* w = adaw + ((size_t)l * 1024 + kq * 256) * 6144 + n;
            float acc[17];
#pragma unroll
            for (int r = 0; r < 17; ++r) acc[r] = 0.f;
#pragma unroll 8
            for (int k = 0; k < 256; ++k) {
                const float wv = w[(size_t)k * 6144];
                const LAS float* sp = sil + (kq * 256 + k) * 17;
#pragma unroll
                for (int r = 0; r < 17; ++r) acc[r] += sp[r] * wv;
            }
#pragma unroll
            for (int r = 0; r < 17; ++r) modp[(((size_t)kq * DEPTH + l) * 17 + r) * 6144 + n] = acc[r];
        }
    }
}
__device__ __forceinline__ void prologue_b(lptr lds, int vcu, int G, int wv) {
    const int tid = opaque_tid(wv), lane = tid & 63, wave = __builtin_amdgcn_readfirstlane(tid >> 6);
    const int gt = (vcu * NWAVES + wave) * 64 + lane, NGT = G * NWAVES * 64;
    unsigned char* ws = parg(lds, 31); const float* adab = pin(lds, 7);
    const float* modp = (const float*)(ws + WS_MODP); float* mod = (float*)(ws + WS_MOD);
    for (int i = gt; i < (int)MOD_ELEMS; i += NGT) { const int l = i / (17 * 6144), n = i % 6144;
        mod[i] = ((modp[i] + modp[MOD_ELEMS + i]) + (modp[2 * MOD_ELEMS + i] + modp[3 * MOD_ELEMS + i])) + adab[l * 6144 + n]; }
}

__device__ __forceinline__ void phase_norm_mix(lptr lds, int l, int vcu, int G, int wv, bool dry = false) {
    const int tid = opaque_tid(wv), lane = tid & 63, wave = __builtin_amdgcn_readfirstlane(tid >> 6);
    unsigned char* ws = parg(lds, 31); float* outp = (float*)parg(lds, 30); const float* xin = pin(lds, 0); const float* cin = pin(lds, 2);
    const int gw = vcu * NWAVES + wave, NGW = G * NWAVES;
    const float* mod = (const float*)(ws + WS_MOD);
    const int* tokd = (const int*)(ws + WS_TOKD); const bf16_t* yb = (const bf16_t*)(ws + WS_BIG + BG_YB);
    bf16_t* H = dry ? (bf16_t*)(ws + WS_END) : (bf16_t*)(ws + WS_H);
    const int nrows = (l == DEPTH) ? NLAT : MTOT;
    const float* gain = (l == DEPTH) ? pin(lds, 29) : pin(lds, 4) + l * DM;
    for (int row0 = gw; row0 < nrows; row0 += 2 * NGW) {
        float* xp[2]; f32x4 v[2][4]; int rr[2]; int dd[2][2];
        const bool docomb = (l > 0);
#pragma unroll
        for (int q = 0; q < 2; ++q) {
            const int row = row0 + q * NGW;
            rr[q] = mod_r(row); xp[q] = xrow_ptr(outp, ws, row);
            const float* xs = (l == 0) ? (row < NLAT ? xin + (size_t)row * DM : cin + (size_t)(row - NLAT) * DM) : xp[q];
            if (docomb) { dd[q][0] = tokd[row * 2]; dd[q][1] = tokd[row * 2 + 1]; }
#pragma unroll
            for (int j = 0; j < 4; ++j) v[q][j] = *(const f32x4*)(xs + 256 * j + 4 * lane);
        }
        if (docomb) {
            u32x2 ya[2][4], yb2[2][4];
#pragma unroll
            for (int q = 0; q < 2; ++q)
#pragma unroll
                for (int j = 0; j < 4; ++j) { ya[q][j] = *(const u32x2*)(yb + (size_t)dd[q][0] * DM + 256 * j + 4 * lane); yb2[q][j] = *(const u32x2*)(yb + (size_t)dd[q][1] * DM + 256 * j + 4 * lane); }
#pragma unroll
            for (int q = 0; q < 2; ++q) {
                const float* g5 = mod + ((size_t)(l - 1) * 17 + rr[q]) * 6144 + 5 * 1024;
#pragma unroll
                for (int j = 0; j < 4; ++j) {
                    const u32x2 a = ya[q][j], b = yb2[q][j];
                    const f32x4 gg = *(const f32x4*)(g5 + 256 * j + 4 * lane);
                    v[q][j][0] += gg[0] * (bflo(a.x) + bflo(b.x)); v[q][j][1] += gg[1] * (bfhi(a.x) + bfhi(b.x));
                    v[q][j][2] += gg[2] * (bflo(a.y) + bflo(b.y)); v[q][j][3] += gg[3] * (bfhi(a.y) + bfhi(b.y));
                }
                if (l < DEPTH && !dry) {
#pragma unroll
                    for (int j = 0; j < 4; ++j) *(f32x4*)(xp[q] + 256 * j + 4 * lane) = v[q][j];
                }
            }
        }
#pragma unroll
        for (int q = 0; q < 2; ++q) {
            const int row = row0 + q * NGW;
            float ss = 0.f;
#pragma unroll
            for (int j = 0; j < 4; ++j) ss += (v[q][j][0] * v[q][j][0] + v[q][j][1] * v[q][j][1]) + (v[q][j][2] * v[q][j][2] + v[q][j][3] * v[q][j][3]);
            const float rs = __builtin_amdgcn_rsqf(wave_sum(ss) * (1.0f / DM) + NORM_EPS);
            if (l == DEPTH) {
                if (!dry)
#pragma unroll
                for (int j = 0; j < 4; ++j) { const f32x4 g = *(const f32x4*)(gain + 256 * j + 4 * lane); *(f32x4*)(xp[q] + 256 * j + 4 * lane) = v[q][j] * rs * g; }
            } else {
                const float* sh = mod + ((size_t)l * 17 + rr[q]) * 6144; const float* sc = sh + 1024;
#pragma unroll
                for (int j = 0; j < 4; ++j) { const int c = 256 * j + 4 * lane; const f32x4 g = *(const f32x4*)(gain + c), s0 = *(const f32x4*)(sh + c), s1 = *(const f32x4*)(sc + c);
                    const f32x4 h = v[q][j] * rs * g * (s1 + 1.0f) + s0;
                    u32x2 w; w.x = pk2(h[0], h[1]); w.y = pk2(h[2], h[3]); *(u32x2*)(H + (size_t)row * DM + c) = w; }
            }
        }
    }
}

constexpr int RW_STRIDE = 1028;
__device__ __forceinline__ void phase_norm_ffn_router(int l, lptr lds, int vcu, int G, int wv, bool dry = false) {
    const int tid = opaque_tid(wv), lane = tid & 63, wave = __builtin_amdgcn_readfirstlane(tid >> 6);
    unsigned char* ws = parg(lds, 31); float* outp = (float*)parg(lds, 30);
    const float* gain = pin(lds, 5) + l * DM;
    const float* bgp = pin(lds, 23) + l * 4; const float* bep = pin(lds, 25) + l * 32;
    LAS float* wl = (LAS float*)lds;
    { const float* wg = pin(lds, 22) + (size_t)l * 1024 * 4; const float* we = pin(lds, 24) + (size_t)l * 1024 * 32;
      for (int i = tid; i < 1024 * 4; i += NTHREADS) wl[(i & 3) * RW_STRIDE + (i >> 2)] = wg[i];
      for (int i = tid; i < 1024 * 32; i += NTHREADS) wl[(4 + (i & 31)) * RW_STRIDE + (i >> 5)] = we[i]; }
    LAS unsigned* hist = (LAS unsigned*)(lds + LDS_MISC + 4608);
    if (tid < 32) hist[tid] = 0u;
    __syncthreads();
    const int gw = vcu * NWAVES + wave, NGW = G * NWAVES;
    const float* mod = (const float*)(ws + WS_MOD);
    bf16_t* H = dry ? (bf16_t*)(ws + WS_END) : (bf16_t*)(ws + WS_H);
    int* toke = (int*)(ws + WS_TOKE); float* tokg = (float*)(ws + WS_TOKG); int* tokp = (int*)(ws + WS_TOKP);
    unsigned* cnt = (unsigned*)(ws + WS_CTL) + CW_CNT + l * 32 * 16;
    const int nrows = (l == DEPTH - 1) ? NLAT : MTOT;
    for (int row = gw; row < nrows; row += NGW) {
        const int r = mod_r(row);
        const float* xp = xrow_ptr(outp, ws, row);
        f32x4 v[4];
#pragma unroll
        for (int j = 0; j < 4; ++j) v[j] = *(const f32x4*)(xp + 256 * j + 4 * lane);
        float ss = 0.f;
#pragma unroll
        for (int j = 0; j < 4; ++j) ss += (v[j][0] * v[j][0] + v[j][1] * v[j][1]) + (v[j][2] * v[j][2] + v[j][3] * v[j][3]);
        const float rs = __builtin_amdgcn_rsqf(wave_sum(ss) * (1.0f / DM) + NORM_EPS);
        const float* sh = mod + ((size_t)l * 17 + r) * 6144 + 3 * 1024; const float* sc = sh + 1024;
#pragma unroll
        for (int j = 0; j < 4; ++j) { const int c = 256 * j + 4 * lane; const f32x4 g = *(const f32x4*)(gain + c), s0 = *(const f32x4*)(sh + c), s1 = *(const f32x4*)(sc + c);
            v[j] = v[j] * rs * g * (s1 + 1.0f) + s0;
            u32x2 w; w.x = pk2(v[j][0], v[j][1]); w.y = pk2(v[j][2], v[j][3]); *(u32x2*)(H + (size_t)row * DM + c) = w; }
        float a[36];
        int wo = 4 * lane; asm volatile("" : "+v"(wo));
        const LAS float* wlr = wl + wo;
#pragma unroll
        for (int c = 0; c < 36; ++c) {
            float s = 0.f;
#pragma unroll
            for (int j = 0; j < 4; ++j) { const f32x4 w = *(const LAS f32x4*)(wlr + c * RW_STRIDE + 256 * j); s += (v[j][0] * w[0] + v[j][1] * w[1]) + (v[j][2] * w[2] + v[j][3] * w[3]); }
            a[c] = s;
        }
#pragma unroll
        for (int c = 0; c < 4; ++c) a[c] = wave_sum(a[c]) + bgp[c];
#define HALVE(N, MASK) _Pragma("unroll") for (int i = 0; i < (N) / 2; ++i) { const bool up = (lane & (MASK)) != 0; const float send = up ? a[4 + i] : a[4 + i + (N) / 2]; \
            const float keep = up ? a[4 + i + (N) / 2] : a[4 + i]; a[4 + i] = keep + xshfl<(MASK)>(send); }
        HALVE(32, 32) HALVE(16, 16) HALVE(8, 8) HALVE(4, 4) HALVE(2, 2)
#undef HALVE
        float ev = a[4] + xshfl<1>(a[4]);
        ev += bep[lane >> 1];
        int grp = 0; float gm = a[0];
#pragma unroll
        for (int c = 1; c < 4; ++c) if (a[c] > gm) { gm = a[c]; grp = c; }
        float gs = 0.f;
#pragma unroll
        for (int c = 0; c < 4; ++c) gs += __expf(a[c] - gm);
        const float pgrp = 1.0f / gs;
        float el[8];
        const int grpu = __builtin_amdgcn_readfirstlane(grp);
#pragma unroll
        for (int i = 0; i < 8; ++i) el[i] = __builtin_bit_cast(float, __builtin_amdgcn_readlane(__builtin_bit_cast(int, ev), (grpu * 8 + i) * 2));
        int i1 = 0; float m1 = el[0];
#pragma unroll
        for (int i = 1; i < 8; ++i) if (el[i] > m1) { m1 = el[i]; i1 = i; }
        int i2 = -1; float m2 = -INFINITY;
#pragma unroll
        for (int i = 0; i < 8; ++i) if (i != i1 && el[i] > m2) { m2 = el[i]; i2 = i; }
        const float e2 = __expf(m2 - m1);
        const float g1 = pgrp / (1.0f + e2), g2 = pgrp * e2 / (1.0f + e2);
        if (lane == 0 && (!dry || g1 < -1.0f)) {
            const int ea = grp * 8 + i1, eb = grp * 8 + i2;
            const unsigned pa = __hip_atomic_fetch_add(hist + ea, 1u, __ATOMIC_RELAXED, __HIP_MEMORY_SCOPE_WORKGROUP), pb = __hip_atomic_fetch_add(hist + eb, 1u, __ATOMIC_RELAXED, __HIP_MEMORY_SCOPE_WORKGROUP);
            toke[row * 2] = ea; toke[row * 2 + 1] = eb; tokg[row * 2] = g1; tokg[row * 2 + 1] = g2; tokp[row * 2] = (int)pa; tokp[row * 2 + 1] = (int)pb;
        }
    }
    __syncthreads();
    if (tid < 32 && !dry) ((int*)(ws + WS_WGB))[vcu * 32 + tid] = (int)atomicAdd(cnt + tid * 16, hist[tid]);
}

constexpr int RW2_STRIDE = 2080, RW2_TAB = 48 * RW2_STRIDE, RW2_SCR = RW2_TAB + 16384;
__device__ __forceinline__ void phase_router_mfma(int l, lptr lds, int vcu, int G, int wv) {
    const int tid = opaque_tid(wv), lane = tid & 63, wave = __builtin_amdgcn_readfirstlane(tid >> 6);
    unsigned char* ws = parg(lds, 31); float* outp = (float*)parg(lds, 30);
    const float* gain = pin(lds, 5) + l * DM;
    const float* bgp = pin(lds, 23) + l * 4; const float* bep = pin(lds, 25) + l * 32;
    const float* mod = (const float*)(ws + WS_MOD);
    const int nrows = (l == DEPTH - 1) ? NLAT : MTOT;
    const int RPW = nrows / G;
    const int row_lo = vcu * RPW; const int r_lo = mod_r(row_lo), r_hi = mod_r(row_lo + RPW - 1);
    {
        const float* wg = pin(lds, 22) + (size_t)l * 1024 * 4; const float* we = pin(lds, 24) + (size_t)l * 1024 * 32;
        for (int i = tid; i < 1024 * 32; i += NTHREADS) *(LAS bf16_t*)(lds + (i & 31) * RW2_STRIDE + (i >> 5) * 2) = (bf16_t)f2bf(we[i]);
        for (int i = tid; i < 1024 * 4; i += NTHREADS) *(LAS bf16_t*)(lds + (32 + (i & 3)) * RW2_STRIDE + (i >> 2) * 2) = (bf16_t)f2bf(wg[i]);
        for (int i = tid; i < 12 * 512; i += NTHREADS) *(LAS unsigned*)(lds + (36 + i / 512) * RW2_STRIDE + (i % 512) * 4) = 0u;
        LAS float* tab = (LAS float*)(lds + RW2_TAB);
        for (int i = tid; i < 2048; i += NTHREADS) { const int t = i >> 10, c = i & 1023; const int r = t ? r_hi : r_lo;
            const float* sh = mod + ((size_t)l * 17 + r) * 6144 + 3 * 1024;
            tab[t * 2048 + c] = gain[c] * (1.0f + sh[1024 + c]); tab[t * 2048 + 1024 + c] = sh[c]; }
        if (tid < 32) ((LAS unsigned*)(lds + LDS_MISC + 4608))[tid] = 0u;
    }
    __syncthreads();
    LAS unsigned* hist = (LAS unsigned*)(lds + LDS_MISC + 4608);
    bf16_t* H = (bf16_t*)(ws + WS_H);
    const float* rs16 = (const float*)(ws + WS_RS16);
    int* toke = (int*)(ws + WS_TOKE); float* tokg = (float*)(ws + WS_TOKG); int* tokp = (int*)(ws + WS_TOKP);
    const int rl = lane & 15, kq = lane >> 4;
    LAS float* scr = (LAS float*)(lds + RW2_SCR + wave * 3136);
    for (int b = wave; b < RPW / 16; b += NWAVES) {
        const int row0 = row_lo + 16 * b, row = row0 + rl;
        const int t = (mod_r(row0) == r_lo) ? 0 : 1;
        const LAS float* tA = (const LAS float*)(lds + RW2_TAB) + t * 2048 + 8 * kq; const LAS float* tB = tA + 1024;
        float rs;
        { const f32x4 p0 = *(const f32x4*)(rs16 + (size_t)row * 16), p1 = *(const f32x4*)(rs16 + (size_t)row * 16 + 4), p2 = *(const f32x4*)(rs16 + (size_t)row * 16 + 8), p3 = *(const f32x4*)(rs16 + (size_t)row * 16 + 12);
          const f32x4 q = (p0 + p1) + (p2 + p3); rs = __builtin_amdgcn_rsqf(((q[0] + q[1]) + (q[2] + q[3])) * (1.0f / DM) + NORM_EPS); }
        const float* xp = xrow_ptr(outp, ws, row) + 8 * kq;
        bf16_t* hp = H + (size_t)row * DM + 8 * kq;
        const LAS unsigned char* wp = lds + rl * RW2_STRIDE + 16 * kq;
        f32x4 acc0 = {0.f, 0.f, 0.f, 0.f}, acc1 = acc0, acc2 = acc0;
#pragma unroll 8
        for (int s = 0; s < 32; ++s) {
            const f32x4 x0 = *(const f32x4*)(xp + 32 * s), x1 = *(const f32x4*)(xp + 32 * s + 4);
            const f32x4 a0 = *(const LAS f32x4*)(tA + 32 * s), a1 = *(const LAS f32x4*)(tA + 32 * s + 4), b0 = *(const LAS f32x4*)(tB + 32 * s), b1 = *(const LAS f32x4*)(tB + 32 * s + 4);
            const f32x4 h0 = x0 * rs * a0 + b0, h1 = x1 * rs * a1 + b1;
            const u32x4 hw = pack8(h0, h1);
            *(u32x4*)(hp + 32 * s) = hw;
            const bf16x8 af = __builtin_bit_cast(bf16x8, hw);
            const bf16x8 w0 = *(const LAS bf16x8*)(wp + 64 * s), w1 = *(const LAS bf16x8*)(wp + 16 * RW2_STRIDE + 64 * s), w2 = *(const LAS bf16x8*)(wp + 32 * RW2_STRIDE + 64 * s);
            acc0 = __builtin_amdgcn_mfma_f32_16x16x32_bf16(af, w0, acc0, 0, 0, 0);
            acc1 = __builtin_amdgcn_mfma_f32_16x16x32_bf16(af, w1, acc1, 0, 0, 0);
            acc2 = __builtin_amdgcn_mfma_f32_16x16x32_bf16(af, w2, acc2, 0, 0, 0);
        }
#pragma unroll
        for (int j = 0; j < 4; ++j) { scr[(4 * kq + j) * 49 + rl] = acc0[j]; scr[(4 * kq + j) * 49 + 16 + rl] = acc1[j]; scr[(4 * kq + j) * 49 + 32 + rl] = acc2[j]; }
        LDS_WAIT();
        if (lane < 16) {
            const LAS float* lg = scr + lane * 49;
            float g[4];
#pragma unroll
            for (int c = 0; c < 4; ++c) g[c] = lg[32 + c] + bgp[c];
            int grp = 0; float gm = g[0];
#pragma unroll
            for (int c = 1; c < 4; ++c) if (g[c] > gm) { gm = g[c]; grp = c; }
            float gs = 0.f;
#pragma unroll
            for (int c = 0; c < 4; ++c) gs += __expf(g[c] - gm);
            const float pgrp = 1.0f / gs;
            float el[8];
#pragma unroll
            for (int i = 0; i < 8; ++i) el[i] = lg[grp * 8 + i] + bep[grp * 8 + i];
            int i1 = 0; float m1 = el[0];
#pragma unroll
            for (int i = 1; i < 8; ++i) if (el[i] > m1) { m1 = el[i]; i1 = i; }
            int i2 = -1; float m2 = -INFINITY;
#pragma unroll
            for (int i = 0; i < 8; ++i) if (i != i1 && el[i] > m2) { m2 = el[i]; i2 = i; }
            const float e2 = __expf(m2 - m1);
            const float g1 = pgrp / (1.0f + e2), g2 = pgrp * e2 / (1.0f + e2);
            const int ea = grp * 8 + i1, eb = grp * 8 + i2;
            const unsigned pa = __hip_atomic_fetch_add(hist + ea, 1u, __ATOMIC_RELAXED, __HIP_MEMORY_SCOPE_WORKGROUP), pb = __hip_atomic_fetch_add(hist + eb, 1u, __ATOMIC_RELAXED, __HIP_MEMORY_SCOPE_WORKGROUP);
            const int rr = row0 + lane;
            toke[rr * 2] = ea; toke[rr * 2 + 1] = eb; tokg[rr * 2] = g1; tokg[rr * 2 + 1] = g2; tokp[rr * 2] = (int)pa; tokp[rr * 2 + 1] = (int)pb;
        }
        LDS_WAIT();
    }
    __syncthreads();
    unsigned* cnt = (unsigned*)(ws + WS_CTL) + CW_CNT + l * 32 * 16;
    if (tid < 32) ((int*)(ws + WS_WGB))[vcu * 32 + tid] = (int)atomicAdd(cnt + tid * 16, hist[tid]);
}

__device__ __forceinline__ void phase_moe_scan(int l, lptr lds, int vcu, int G, int wv) {
    const int tid = opaque_tid(wv);
    unsigned char* ws = parg(lds, 31);
    LAS int* tile_exp = (LAS int*)(lds + LDS_MISC); LAS int* ntl = (LAS int*)(lds + LDS_MISC + 4096); LAS int* pad_start = (LAS int*)(lds + LDS_MISC + 4224); LAS int* cntl = (LAS int*)(lds + LDS_MISC + 4352);
    const unsigned* cnt = (const unsigned*)(ws + WS_CTL) + CW_CNT + l * 32 * 16;
    if (tid < 32) cntl[tid] = (int)__hip_atomic_load(cnt + tid * 16, __ATOMIC_RELAXED, __HIP_MEMORY_SCOPE_AGENT);
    __syncthreads();
    if (tid == 0) { int t = 0; for (int e = 0; e < 32; ++e) { pad_start[e] = t * 256; const int nt = (cntl[e] + 255) >> 8; for (int i = 0; i < nt; ++i) tile_exp[t + i] = e; t += nt; } ntl[0] = t; }
    __syncthreads();
    const int gt = vcu * NTHREADS + tid, NGT = G * NTHREADS;
    const int ntok = (l == DEPTH - 1) ? NLAT : MTOT;
    const int* toke = (const int*)(ws + WS_TOKE); const float* tokg = (const float*)(ws + WS_TOKG); const int* tokp = (const int*)(ws + WS_TOKP);
    int* tokd = (int*)(ws + WS_TOKD); int* slott = (int*)(ws + WS_SLOTT); float* slotg = (float*)(ws + WS_SLOTG);
    const int* wgb = (const int*)(ws + WS_WGB);
    for (int a = gt; a < 2 * ntok; a += NGT) { const int e = toke[a]; const int wgv = (a >> 1) / (ntok / G);
        const int dest = pad_start[e] + wgb[wgv * 32 + e] + tokp[a]; slott[dest] = a >> 1; slotg[dest] = tokg[a]; tokd[a] = dest; }
    for (int i = gt; i < 32 * 256; i += NGT) { const int e = i >> 8, off = i & 255; const int s = pad_start[e] + cntl[e] + off; const int end = pad_start[e] + (((cntl[e] + 255) >> 8) << 8);
        if (s < end) { slott[s] = ZROW; slotg[s] = 0.f; } }
}

struct Params { const float* in[30]; float* out; unsigned char* ws; };

__device__ __forceinline__ void moe_gemms(lptr lds, int l, int tid, int G, int bx) {
}

template <int L> __device__ __forceinline__ void layer_body(lptr lds, int wv) {
    constexpr int jj = L / 2, par = L % 2, l = L; constexpr bool last = (L == DEPTH - 1);
#define GRID_BAR() do { XcdBarrier b_; b_.bar = (unsigned*)(parg(lds, 31) + WS_CTL) + CW_BAR; b_.x = xb_xcc_id(); b_.st = (volatile LAS unsigned*)(lds + LDS_BYTES - 64); xcd_barrier(b_, wv); } while (0)
#define G   (opaque_s((int)gridDim.x))
#define bx  (opaque_s((int)blockIdx.x))
#define vcu (opaque_s((int)((blockIdx.x % 8) * (gridDim.x / 8) + blockIdx.x / 8)))
    const int tid = opaque_tid(wv);
            if (REP_ROW > 1 && l > 0) { phase_norm_mix(lds, l, vcu, G, wv, true); GRID_BAR(); }
            phase_norm_mix(lds, l, vcu, G, wv);
            GRID_BAR();
            if constexpr (par == 0) {
                for (int rep_ = 0; rep_ < REP_WIN; ++rep_)
                {
                    unsigned char* ws = parg(lds, 31);
                    pg8::GemmPlain g{(const char*)(ws + WS_H), (const char*)(ws + WS_WINE) + (size_t)jj * 1280 * 1024 * 2, 1024, 1024};
                    pg8::StaticOrder S; S.init(MTOT / 256, 5, G, bx);
                    EpiWinEven E{ws + WS_BIG, (float*)(ws + WS_RSQ), (const float*)(ws + WS_ROPE64), (const float*)(ws + WS_ROPE32)};
                    pg8::gemm_phase(lds, g, S, E, wv);
                }
                GRID_BAR();
                {
                    unsigned char* ws = parg(lds, 31);
                    pg8::GemmPlain g{(const char*)(ws + WS_BIG + BG_CQ), (const char*)(ws + WS_WUQ) + (size_t)jj * 768 * 256 * 2, 256, 256};
                    pg8::StaticOrder S; S.init(MTOT / 256, 3, G, bx);
                    EpiUq E{(bf16_t*)(ws + WS_BIG + BG_QM), (const float*)(ws + WS_RSQ), (const float*)(ws + WS_ROPE32)};
                    pg8::gemm_phase(lds, g, S, E, wv);
                }
                {
                    unsigned char* ws = parg(lds, 31);
                    pg8::GemmPlain g2{(const char*)(ws + WS_BIG + BG_CKVR), (const char*)(ws + WS_WUKV) + (size_t)jj * 1024 * 256 * 2, 256, 256};
                    pg8::StaticOrder S2; S2.init(MTOT / 256, 4, G, G - 1 - bx);
                    EpiUkv E2{(bf16_t*)(ws + WS_BIG + BG_KVM), (const float*)(ws + WS_RSQ)};
                    pg8::gemm_phase(lds, g2, S2, E2, wv);
                }
                GRID_BAR();
                for (int rep_ = 0; rep_ < REP_ATT; ++rep_) {
                {
                    unsigned char* big = parg(lds, 31) + WS_BIG; bf16_t* Hb = (bf16_t*)(parg(lds, 31) + WS_H);
                    att::Tensors Tm{(const bf16_t*)(big + BG_QM), (const bf16_t*)(big + BG_KVM), (const bf16_t*)(big + BG_CKVR), (const bf16_t*)(big + BG_KVM), Hb, nullptr, 0.f, nullptr, 0.f, 0.10206207261596575f * LOG2E};
                    LAS unsigned* redo = (LAS unsigned*)(lds + LDS_MISC + 4608 + 64);
#pragma unroll 1
                    for (int pass = 0; pass < 2; ++pass) {
#pragma unroll 1
                    for (int i = 0; i < 9; ++i) {
                        att::Unit U;
                        if (i < 8) { const int u = vcu + 256 * i, bh = u >> 4, qb = u & 15, b = bh >> 3, h = bh & 7; U = att::Unit{b * SEQ + qb * 256, b * SEQ, 64, NLAT + b * CTXL, h, 0, 0}; }
                        else { if (vcu >= 128) break; const int b = vcu >> 3, h = vcu & 7; U = att::Unit{NLAT + b * CTXL, 0, 0, NLAT + b * CTXL, h, 0, 0}; }
                        if (pass == 0) { const bool bad = att::attn_unit_q<att::MLA, false>(lds, U, Tm, wv); if (opaque_tid(wv) == 0) redo[i] = bad ? 1u : 0u; }
                        else { __syncthreads(); if (__builtin_amdgcn_readfirstlane(redo[i]) != 0u) (void)att::attn_unit_q<att::MLA, true>(lds, U, Tm, wv); }
                    }
                    }
                }
                {
                    unsigned char* big = parg(lds, 31) + WS_BIG; bf16_t* Hb = (bf16_t*)(parg(lds, 31) + WS_H);
                    att::Tensors Ts{(const bf16_t*)(big + BG_AQ), (const bf16_t*)(big + BG_AKV), nullptr, (const bf16_t*)(big + BG_AKV), Hb, pin(lds, 13) + jj * 8, 0.f, nullptr, 0.f, 1.0f};
                    LAS unsigned* redo = (LAS unsigned*)(lds + LDS_MISC + 4608 + 64);
#pragma unroll 1
                    for (int pass = 0; pass < 2; ++pass) {
#pragma unroll 1
                    for (int i = 0; i < 9; ++i) {
                        att::Unit U;
                        if (i < 8) { const int u = vcu + 256 * i, bh = u >> 4, qb = u & 15, b = bh >> 3, h = bh & 7;
                            const int q0 = qb * 256, t0 = (q0 == 0) ? 0 : (q0 / 64 - 2), t1 = (q0 / 64 + 5 > 63) ? 63 : (q0 / 64 + 5);
                            U = att::Unit{b * SEQ + q0, b * SEQ + 64 * t0, t1 - t0 + 1, NLAT + b * CTXL, h, q0, 64 * t0}; }
                        else { if (vcu < 128) break; const int u = vcu - 128, b = u >> 3, h = u & 7; U = att::Unit{NLAT + b * CTXL, 0, 0, NLAT + b * CTXL, h, 0, 0}; }
                        if (pass == 0) { const bool bad = att::attn_unit<att::SWA, false>(lds, U, Ts, wv); if (opaque_tid(wv) == 0) redo[i] = bad ? 1u : 0u; }
                        else { __syncthreads(); if (__builtin_amdgcn_readfirstlane(redo[i]) != 0u) (void)att::attn_unit<att::SWA, true>(lds, U, Ts, wv); }
                    }
                    }
                }
                }
                GRID_BAR();
                {
                    unsigned char* ws = parg(lds, 31); float* outp = (float*)parg(lds, 30); float* xctx = (float*)(ws + WS_XCTX);
                    pg8::GemmPlain g{(const char*)(ws + WS_H), (const char*)(ws + WS_WOUTE) + (size_t)jj * 1024 * 1024 * 2, 1024, 1024};
                    pg8::StaticOrder S; S.init(MTOT / 256, 4, G, bx);
                    EpiResid E{l == 0 ? pin(lds, 0) : outp, l == 0 ? pin(lds, 2) : xctx, outp, xctx, (const float*)(ws + WS_MOD) + (size_t)l * 17 * 6144, 2 * 1024, (float*)(ws + WS_RS16)};
                    pg8::gemm_phase(lds, g, S, E, wv);
                }
            } else {
                for (int rep_ = 0; rep_ < REP_WIN; ++rep_)
                {
                    unsigned char* ws = parg(lds, 31);
                    pg8::GemmPlain g{(const char*)(ws + WS_H), (const char*)(ws + WS_WINO) + (size_t)jj * 3072 * 1024 * 2, 1024, 1024};
                    pg8::StaticOrder S; S.init(MTOT / 256, 12, G, bx);
                    EpiWinOdd E{(bf16_t*)(ws + WS_BIG), (const float*)(ws + WS_ROPE64)};
                    pg8::gemm_phase(lds, g, S, E, wv);
                }
                GRID_BAR();
                for (int rep_ = 0; rep_ < REP_ATT; ++rep_)
                {
                    unsigned char* big = parg(lds, 31) + WS_BIG; bf16_t* Hb = (bf16_t*)(parg(lds, 31) + WS_H);
                    float d1 = 0.f, d2 = 0.f;
                    { const float* lq1 = pin(lds, 16) + jj * 64; const float* lk1 = pin(lds, 17) + jj * 64; const float* lq2 = pin(lds, 18) + jj * 64; const float* lk2 = pin(lds, 19) + jj * 64;
                      for (int i = 0; i < 64; ++i) { d1 += lq1[i] * lk1[i]; d2 += lq2[i] * lk2[i]; } }
                    const float lam_init = 0.8f - 0.6f * expf(-0.3f * (float)l);
                    const float lam = expf(d1) - expf(d2) + lam_init;
                    att::Tensors Td{(const bf16_t*)big, (const bf16_t*)big, nullptr, (const bf16_t*)big, Hb, nullptr, lam, pin(lds, 20) + jj * 128, 1.0f - lam_init, 0.125f * LOG2E};
                    LAS unsigned* redo = (LAS unsigned*)(lds + LDS_MISC + 4608 + 64);
#pragma unroll 1
                    for (int pass = 0; pass < 2; ++pass) {
#pragma unroll 1
                    for (int i = 0; i < 17; ++i) {
                        att::Unit U;
                        if (i < 16) { const int u = vcu + 256 * i, bh = u >> 5, qb = u & 31, b = bh >> 3, h = bh & 7; U = att::Unit{b * SEQ + qb * 128, b * SEQ, 64, NLAT + b * CTXL, h, 0, 0}; }
                        else { if (last) break; const int bh = vcu >> 1, half = vcu & 1, b = bh >> 3, h = bh & 7; U = att::Unit{NLAT + b * CTXL + half * 128, 0, 0, NLAT + b * CTXL, h, 0, 0}; }
                        if (pass == 0) { const bool bad = att::attn_unit_q<att::DIFF, false>(lds, U, Td, wv); if (opaque_tid(wv) == 0) redo[i] = bad ? 1u : 0u; }
                        else { __syncthreads(); if (__builtin_amdgcn_readfirstlane(redo[i]) != 0u) (void)att::attn_unit_q<att::DIFF, true>(lds, U, Td, wv); }
                    }
                    }
                }
                GRID_BAR();
                {
                    unsigned char* ws = parg(lds, 31); float* outp = (float*)parg(lds, 30); float* xctx = (float*)(ws + WS_XCTX);
                    pg8::GemmPlain g{(const char*)(ws + WS_H), (const char*)(ws + WS_WOUTO) + (size_t)jj * 1024 * 1024 * 2, 1024, 1024};
                    pg8::StaticOrder S; S.init((last ? NLAT : MTOT) / 256, 4, G, bx);
                    EpiResid E{outp, xctx, outp, xctx, (const float*)(ws + WS_MOD) + (size_t)l * 17 * 6144, 2 * 1024, (float*)(ws + WS_RS16)};
                    pg8::gemm_phase(lds, g, S, E, wv);
                }
            }
            GRID_BAR();
            phase_router_mfma(l, lds, vcu, G, wv);
            GRID_BAR();
            phase_moe_scan(l, lds, vcu, G, wv);
            GRID_BAR();
            for (int rep_ = 0; rep_ < REP_MOE; ++rep_)
            {
                unsigned char* ws = parg(lds, 31);
                LAS int* tile_exp = (LAS int*)(lds + LDS_MISC); LAS int* idx = (LAS int*)(lds + 131072); const int nt = *(LAS int*)(lds + LDS_MISC + 4096); const int* slott = (const int*)(ws + WS_SLOTT);
                const int cu_ = vcu;
                { const int t_ = opaque_tid(wv); for (int i = 0; i * G + cu_ < nt * 4; ++i) { const int pm = (i * G + cu_) >> 2; if (t_ < 256) idx[i * 256 + t_] = slott[pm * 256 + t_]; } }
                __syncthreads();
                GemmMoe1 g{(const char*)(ws + WS_H), (const char*)(ws + WS_W13) + (size_t)l * NEXP * 1024 * 1024 * 2, idx, tile_exp, 1024};
                MoeSched S{tile_exp, nt, G, cu_};
                EpiSwiglu E{(bf16_t*)(ws + WS_BIG + BG_ACT)};
                pg8::gemm_phase(lds, g, S, E, wv);
            }
            GRID_BAR();
            for (int rep_ = 0; rep_ < REP_MOE; ++rep_)
            {
                unsigned char* ws = parg(lds, 31);
                LAS int* tile_exp = (LAS int*)(lds + LDS_MISC); const int nt = *(LAS int*)(lds + LDS_MISC + 4096);
                GemmMoe2 g{(const char*)(ws + WS_BIG + BG_ACT), (const char*)(ws + WS_W2T) + (size_t)l * NEXP * 1024 * 512 * 2, tile_exp, 512};
                MoeSched S{tile_exp, nt, G, vcu};
                EpiMoe2 E{(bf16_t*)(ws + WS_BIG + BG_YB), (const float*)(ws + WS_SLOTG)};
                pg8::gemm_phase(lds, g, S, E, wv);
            }
            GRID_BAR();
}
#undef GRID_BAR
#undef G
#undef bx
#undef vcu
__global__ void __launch_bounds__(NTHREADS, 2) fwd_kernel(Params P) {
    extern __shared__ __attribute__((aligned(16))) unsigned char lds_raw[];
    const lptr lds = (lptr)lds_raw;
    const int tid = threadIdx.x;
    const int wv = __builtin_amdgcn_readfirstlane(tid >> 6);
#define G   (opaque_s((int)gridDim.x))
#define bx  (opaque_s((int)blockIdx.x))
#define vcu (opaque_s((int)((blockIdx.x % 8) * (gridDim.x / 8) + blockIdx.x / 8)))
    volatile LAS unsigned* bst = (volatile LAS unsigned*)(lds + LDS_BYTES - 64);
    if (tid < 16) bst[tid] = 0u;
    if (tid < 32) {
        const unsigned long long* ka = (const unsigned long long*)__builtin_amdgcn_kernarg_segment_ptr();
        ((LAS unsigned long long*)(lds + LDS_PB))[tid] = ka[tid];
    }
    __syncthreads();
    (void)xcd_barrier_post((unsigned*)(parg(lds, 31) + WS_CTL) + CW_BAR, bst, wv);
#define GRID_BAR() do { XcdBarrier b_; b_.bar = (unsigned*)(parg(lds, 31) + WS_CTL) + CW_BAR; b_.x = xb_xcc_id(); b_.st = (volatile LAS unsigned*)(lds + LDS_BYTES - 64); xcd_barrier(b_, wv); } while (0)

    for (int rep_ = 0; rep_ < REP_PRO; ++rep_) prologue_a(lds, vcu, G, wv);
    GRID_BAR();
    prologue_b(lds, vcu, G, wv);
    GRID_BAR();

    layer_body<0>(lds, wv);
    layer_body<1>(lds, wv);
    layer_body<2>(lds, wv);
    layer_body<3>(lds, wv);
    phase_norm_mix(lds, DEPTH, vcu, G, wv);
#undef G
#undef bx
#undef vcu
}

extern "C" void kernel_launch(void* const* d_in, const int* in_sizes, int n_in, void* d_out, int out_size, void* d_ws, size_t ws_size, hipStream_t stream) {
    static int grid = 0;
    if (grid == 0) {
        if (n_in != 30 || out_size != NLAT * DM || ws_size < WS_END + (REP_ROW > 1 ? (size_t)MTOT * DM * 2 : 0)) { fprintf(stderr, "kernel_launch: unexpected shapes (n_in %d out %d ws %zu need %zu)\n", n_in, out_size, ws_size, (size_t)WS_END); grid = -1; return; }
        int dev = 0, cus = 0, per_cu = 0;
        if (hipGetDevice(&dev) != hipSuccess || hipDeviceGetAttribute(&cus, hipDeviceAttributeMultiprocessorCount, dev) != hipSuccess) { grid = -1; return; }
        if (hipFuncSetAttribute((const void*)fwd_kernel, hipFuncAttributeMaxDynamicSharedMemorySize, LDS_BYTES) != hipSuccess) { fprintf(stderr, "kernel_launch: hipFuncSetAttribute failed\n"); grid = -1; return; }
        if (hipOccupancyMaxActiveBlocksPerMultiprocessor(&per_cu, (const void*)fwd_kernel, NTHREADS, LDS_BYTES) != hipSuccess || per_cu < 1) { fprintf(stderr, "kernel_launch: occupancy query says %d\n", per_cu); }
        (void)hipGetLastError();
        grid = cus;
        if (grid % 8 != 0 || grid < 8) { fprintf(stderr, "kernel_launch: unexpected CU count %d\n", cus); grid = -1; return; }
    }
    if (grid < 0) return;
    (void)hipMemsetAsync((char*)d_ws + WS_CTL, 0, CTL_ZERO, stream);
    Params p{};
    for (int i = 0; i < 30; ++i) p.in[i] = (const float*)d_in[i];
    p.out = (float*)d_out; p.ws = (unsigned char*)d_ws;
    hipLaunchKernelGGL(fwd_kernel, dim3(grid), dim3(NTHREADS), LDS_BYTES, stream, p);
}
```

```cpp
#include <hip/hip_runtime.h>
#include <cstdio>
#include <cstdint>

#define GAS __attribute__((address_space(1)))
#ifndef NT_EPI
#define NT_EPI 0
#endif
#if NT_EPI
#define NTST(p, v) __builtin_nontemporal_store((v), (p))
#else
#define NTST(p, v) (*(p) = (v))
#endif
#define LAS __attribute__((address_space(3)))
#define GAS __attribute__((address_space(1)))
typedef unsigned short bf16_t;
typedef short bf16x8 __attribute__((ext_vector_type(8)));
typedef short s16x4 __attribute__((ext_vector_type(4)));
typedef float f32x4 __attribute__((ext_vector_type(4)));
typedef float f32x16 __attribute__((ext_vector_type(16)));
typedef unsigned u32x4 __attribute__((ext_vector_type(4)));
typedef unsigned u32x2 __attribute__((ext_vector_type(2)));
typedef LAS unsigned char* lptr;

#ifndef REP_ATT
#define REP_ATT 1
#endif
#ifndef REP_PRO
#define REP_PRO 1
#endif
#ifndef REP_MOE
#define REP_MOE 1
#endif
#ifndef REP_WIN
#define REP_WIN 1
#endif
#ifndef REP_NOST
#define REP_NOST 0
#endif
#ifndef DPH_TICKS
#define DPH_TICKS 0
#endif
#ifndef CODE_PAD
#define CODE_PAD 16
#endif
#ifndef REP_ROW
#define REP_ROW 1
#endif
constexpr int DM = 1024, NB = 16, SEQ = 4096, CTXL = 256, DEPTH = 4;
constexpr int NLAT = NB * SEQ, NCTX = NB * CTXL, MTOT = NLAT + NCTX;
constexpr int NEXP = 32, EFF = 512;
constexpr int MAXSLOTS = 147456;
constexpr int MAXTILES = MAXSLOTS / 256;
constexpr int ZROW = MTOT;
constexpr int NWAVES = 8, NTHREADS = 512;
constexpr float NORM_EPS = 1e-6f, DIFF_EPS = 1e-5f;
constexpr float LOG2E = 1.4426950408889634f;

constexpr size_t al256(size_t x) { return (x + 255) & ~(size_t)255; }
constexpr size_t WS_CTL = 0, CTL_BYTES = 1u << 20, CTL_ZERO = 131072;
constexpr size_t WS_MODP = WS_CTL + CTL_BYTES;
constexpr size_t MOD_ELEMS = (size_t)DEPTH * 17 * 6144;
constexpr size_t WS_MOD = WS_MODP + al256(4 * MOD_ELEMS * 4);
constexpr size_t WS_ROPE64 = WS_MOD + al256(MOD_ELEMS * 4);
constexpr size_t WS_ROPE32 = WS_ROPE64 + (size_t)2 * SEQ * 32 * 4;
constexpr size_t WS_WINE = WS_ROPE32 + (size_t)2 * SEQ * 16 * 4;
constexpr size_t WS_WUQ = WS_WINE + (size_t)2 * 1280 * 1024 * 2;
constexpr size_t WS_WUKV = WS_WUQ + (size_t)2 * 768 * 256 * 2;
constexpr size_t WS_WOUTE = WS_WUKV + (size_t)2 * 1024 * 256 * 2;
constexpr size_t WS_WINO = WS_WOUTE + (size_t)2 * 1024 * 1024 * 2;
constexpr size_t WS_WOUTO = WS_WINO + (size_t)2 * 3072 * 1024 * 2;
constexpr size_t WS_W13 = WS_WOUTO + (size_t)2 * 1024 * 1024 * 2;
constexpr size_t WS_W2T = WS_W13 + (size_t)DEPTH * NEXP * 1024 * 1024 * 2;
constexpr size_t WS_XCTX = WS_W2T + (size_t)DEPTH * NEXP * 1024 * 512 * 2;
constexpr size_t WS_H = WS_XCTX + (size_t)NCTX * DM * 4;
constexpr size_t WS_BIG = WS_H + al256((size_t)(MTOT + 1) * DM * 2);
constexpr size_t BIG_BYTES = (size_t)MAXSLOTS * (512 + 1024) * 2;
constexpr size_t BG_AQ = 0;
constexpr size_t BG_AKV = BG_AQ + (size_t)MTOT * 512 * 2;
constexpr size_t BG_CQ = BG_AKV + (size_t)MTOT * 256 * 2;
constexpr size_t BG_CKVR = BG_CQ + (size_t)MTOT * 256 * 2;
constexpr size_t BG_QM = BG_CKVR + (size_t)MTOT * 256 * 2;
constexpr size_t BG_KVM = BG_QM + (size_t)MTOT * 768 * 2;
static_assert(BG_KVM + (size_t)MTOT * 1024 * 2 <= BIG_BYTES, "even view fits");
static_assert((size_t)MTOT * 3072 * 2 <= BIG_BYTES, "odd view fits");
constexpr size_t BG_ACT = 0;
constexpr size_t BG_YB = (size_t)MAXSLOTS * 512 * 2;
constexpr size_t WS_RSQ = WS_BIG + BIG_BYTES;
constexpr size_t WS_TOKE = WS_RSQ + (size_t)MTOT * 8 * 4;
constexpr size_t WS_TOKG = WS_TOKE + (size_t)MTOT * 2 * 4;
constexpr size_t WS_TOKP = WS_TOKG + (size_t)MTOT * 2 * 4;
constexpr size_t WS_TOKD = WS_TOKP + (size_t)MTOT * 2 * 4;
constexpr size_t WS_SLOTT = WS_TOKD + (size_t)MTOT * 2 * 4;
constexpr size_t WS_SLOTG = WS_SLOTT + (size_t)MAXSLOTS * 4;
constexpr size_t WS_WGB = WS_SLOTG + (size_t)MAXSLOTS * 4;
constexpr size_t WS_RS16 = WS_WGB + (size_t)256 * 32 * 4;
constexpr size_t WS_XB = WS_RS16 + (size_t)MTOT * 16 * 4;
constexpr size_t WS_END = WS_XB + (size_t)MTOT * DM * 2;
constexpr int CW_BAR = 4096;
constexpr int CW_CNT = 16384;
static_assert((CW_BAR + 3456) * 4 <= 131072 && (CW_CNT + DEPTH * 32 * 16) * 4 <= 131072, "control words inside the per-call memset");

constexpr int LDS_MISC = 147456;
constexpr int LDS_BYTES = 155648;
constexpr int LDS_PB = LDS_BYTES - 1024;

__device__ __forceinline__ unsigned f2bf(float f) { unsigned u = __builtin_bit_cast(unsigned, f); return (u + 0x7fffu + ((u >> 16) & 1u)) >> 16; }
typedef float f32x2_t __attribute__((ext_vector_type(2))); typedef __bf16 bf16x2_t __attribute__((ext_vector_type(2)));
__device__ __forceinline__ unsigned pk2(float lo, float hi) { const f32x2_t v = {lo, hi}; const bf16x2_t b = __builtin_convertvector(v, bf16x2_t); return __builtin_bit_cast(unsigned, b); }
__device__ __forceinline__ float bf2f(unsigned short b) { return __builtin_bit_cast(float, ((unsigned)b) << 16); }
__device__ __forceinline__ float bflo(unsigned w) { return __builtin_bit_cast(float, w << 16); }
__device__ __forceinline__ float bfhi(unsigned w) { return __builtin_bit_cast(float, w & 0xffff0000u); }
template <int MASK> __device__ __forceinline__ float xshfl(float v) {
    if (MASK == 32) { const auto rr = __builtin_amdgcn_permlane32_swap(__builtin_bit_cast(unsigned, v), __builtin_bit_cast(unsigned, v), false, false);
        const unsigned a = rr[0], b = rr[1]; const unsigned own = __builtin_bit_cast(unsigned, v); return __builtin_bit_cast(float, a ^ b ^ own); }
    else return __builtin_bit_cast(float, __builtin_amdgcn_ds_swizzle(__builtin_bit_cast(int, v), (MASK << 10) | 0x1f));
}
__device__ __forceinline__ float wave_sum(float v) {
    v += xshfl<1>(v); v += xshfl<2>(v); v += xshfl<4>(v); v += xshfl<8>(v); v += xshfl<16>(v); v += xshfl<32>(v);
    return v;
}
__device__ __forceinline__ int opaque_tid(int wv) { int t; asm volatile("v_mbcnt_lo_u32_b32 %0, -1, 0\n\tv_mbcnt_hi_u32_b32 %0, -1, %0" : "=v"(t)); return t | (wv << 6); }
__device__ __forceinline__ int opaque_s(int x) { asm volatile("" : "+s"(x)); return x; }
__device__ __forceinline__ int crow(int r, int hi) { return (r & 3) + 8 * (r >> 2) + 4 * hi; }
__device__ __forceinline__ unsigned char* parg(lptr lds, int i) {
    int pbo = LDS_PB; asm volatile("" : "+v"(pbo));
    const LAS unsigned* p = (const LAS unsigned*)(lds + pbo) + 2 * i;
    const unsigned lo = __builtin_amdgcn_readfirstlane(p[0]), hi = __builtin_amdgcn_readfirstlane(p[1]);
    return (unsigned char*)(((unsigned long long)hi << 32) | lo);
}
__device__ __forceinline__ const float* pin(lptr lds, int i) { return (const float*)parg(lds, i); }

#define XB_TMO      128
#define XB_XCNT(j)  (256  + 64 * (j))
#define XB_XSUB(j)  (1280 + 64 * (j))
#define XB_XGEN(j)  (2304 + 64 * (j))
#define XB_TOP      3328
#define XB_TOPGEN   3392
#define XCD_BAR_WORDS 3456
#define XB_SPIN_CAP (1u << 22)
__device__ __forceinline__ unsigned xb_ld(unsigned* p)              { return __hip_atomic_load(p, __ATOMIC_RELAXED, __HIP_MEMORY_SCOPE_AGENT); }
__device__ __forceinline__ unsigned xb_add(unsigned* p, unsigned v) { return __hip_atomic_fetch_add(p, v, __ATOMIC_RELAXED, __HIP_MEMORY_SCOPE_AGENT); }
__device__ __forceinline__ unsigned xb_xcc_id() { return (unsigned)__builtin_amdgcn_s_getreg((3 << 11) | 20) & 0xFu; }
#define XB_SPIN(cond, bar) do { unsigned _sp = 0; while (cond) { __builtin_amdgcn_s_sleep(1); \
    if ((++_sp & 255u) == 0u) { if (xb_ld(&(bar)[XB_TMO])) break; if (_sp > XB_SPIN_CAP) { atomicAdd(&(bar)[XB_TMO], 1u); break; } } } } while (0)
struct XcdBarrier { unsigned* bar; unsigned x; volatile LAS unsigned* st; };
__device__ __forceinline__ XcdBarrier xcd_barrier_post(unsigned* bar, volatile LAS unsigned* st, int wv) {
    XcdBarrier b; b.bar = bar; b.x = xb_xcc_id(); b.st = st;
    if (opaque_tid(wv) == 0) (void)xb_add(&bar[XB_XCNT(b.x)], 1u);
    return b;
}
__device__ __forceinline__ void xcd_barrier_complete(unsigned* bar, unsigned x, unsigned& nloc, unsigned& nx) {
    const unsigned G = gridDim.x * gridDim.y * gridDim.z;
    unsigned sum, cnt, mine, sp = 0u;
    for (;;) {
        sum = 0u; cnt = 0u; mine = 0u;
#pragma unroll
        for (unsigned j = 0; j < 16; ++j) { const unsigned c = xb_ld(&bar[XB_XCNT(j)]); sum += c; cnt += (c > 0u) ? 1u : 0u; mine = (j == x) ? c : mine; }
        if (sum == G) break;
        __builtin_amdgcn_s_sleep(1);
        if ((++sp & 255u) == 0u) { if (xb_ld(&bar[XB_TMO])) break; if (sp > XB_SPIN_CAP) { atomicAdd(&bar[XB_TMO], 1u); break; } }
    }
    nloc = mine > 0u ? mine : 1u; nx = cnt > 0u ? cnt : 1u;
}
__device__ __forceinline__ void xcd_barrier(const XcdBarrier& b, int wv) {
    asm volatile("s_waitcnt vmcnt(0)" ::: "memory");
    __syncthreads();
    if (opaque_tid(wv) == 0) {
        unsigned* bar = b.bar;
        __builtin_amdgcn_s_waitcnt(0);
        unsigned nloc = b.st[0], nx = b.st[1];
        if (nloc == 0u) { xcd_barrier_complete(bar, b.x, nloc, nx); b.st[0] = nloc; b.st[1] = nx; }
        const unsigned old = xb_add(&bar[XB_XSUB(b.x)], 1u);
        const unsigned gen = old / nloc;
        if (old + 1u == (gen + 1u) * nloc) {
            __builtin_amdgcn_fence(__ATOMIC_RELEASE, "agent");
            asm volatile("s_waitcnt vmcnt(0)" ::: "memory");
            const unsigned og = xb_add(&bar[XB_TOP], 1u);
            const unsigned tg = og / nx;
            if (og + 1u == (tg + 1u) * nx) xb_add(&bar[XB_TOPGEN], 1u);
            else XB_SPIN(xb_ld(&bar[XB_TOPGEN]) == tg, bar);
            __builtin_amdgcn_fence(__ATOMIC_ACQUIRE, "agent");
            xb_add(&bar[XB_XGEN(b.x)], 1u);
            asm volatile("s_waitcnt vmcnt(0)" ::: "memory");
        } else {
            XB_SPIN(xb_ld(&bar[XB_XGEN(b.x)]) == gen, bar);
            __builtin_amdgcn_fence(__ATOMIC_ACQUIRE, "agent");
            asm volatile("s_waitcnt vmcnt(0)" ::: "memory");
        }
    }
    __syncthreads();
}

struct Ctx {
    lptr lds;
    int tid, lane, wave, vcu, G;
    const float* const* in;
    float* out; unsigned char* ws;
};
__device__ __forceinline__ float* xrow_ptr(float* out, unsigned char* ws, int row) {
    return row < NLAT ? out + (size_t)row * DM : (float*)(ws + WS_XCTX) + (size_t)(row - NLAT) * DM;
}
__device__ __forceinline__ int mod_r(int row) { return row < NLAT ? (row >> 12) : 16; }

namespace pg8 {
constexpr int BM = 256, BK = 64, HALF = 128, HTB = HALF * BK * 2, STAGE_BYTES = 8 * HTB;
__device__ __forceinline__ int lds_byte(int r, int c) { const int st = (r >> 4) * 2 + (c >> 5), rr = r & 15, cc = c & 31, ob = rr * 64 + cc * 2; return st * 1024 + (ob ^ (((ob >> 9) & 1) << 5)); }
__device__ __forceinline__ void stage_rc(int b, int& R, int& C) { const int st = b / 1024, sb = b % 1024, swz = sb ^ (((sb >> 9) & 1) << 5); R = (st >> 1) * 16 + swz / 64; C = (st & 1) * 32 + (swz % 64) / 2; }
__device__ __forceinline__ int perm32(int rho) { const int n = rho >> 4, i = rho & 15; return 8 * (i >> 2) + 4 * n + (i & 3); }
struct Unit { int pm, pn, aux; };
template <class GD, class Sched, class Epi>
__device__ __forceinline__ void gemm_phase(lptr lds, const GD& G, const Sched& S, const Epi& E, int wv) {
    const int tid = opaque_tid(wv), wid = __builtin_amdgcn_readfirstlane(tid >> 6), lane = tid & 63, wr = wid >> 2, wc = wid & 3, fr = lane & 15, fq = lane >> 4;
    const int K = G.K, nt = K / BK;
    unsigned voffB[2];
#pragma unroll
    for (int i = 0; i < 2; ++i) { int R, C; stage_rc(tid * 16 + i * 8192, R, C); const int Rb = Epi::PERM ? ((R & ~31) + perm32(R & 31)) : R; voffB[i] = (unsigned)(Rb * K + C) * 2u; }
#define PG8_AOFFS(u, o00, o01, o10, o11) do { int R0_, C0_, R1_, C1_; stage_rc(tid * 16, R0_, C0_); stage_rc(tid * 16 + 8192, R1_, C1_); \
        o00 = G.a_off(u, R0_) + C0_ * 2; o01 = G.a_off(u, R1_) + C1_ * 2; o10 = G.a_off(u, HALF + R0_) + C0_ * 2; o11 = G.a_off(u, HALF + R1_) + C1_ * 2; } while (0)
    const size_t kstep = (size_t)(BK * 2);
    const size_t hstep = (size_t)HALF * K * 2;
    const unsigned ldsw = (unsigned)wid * 1024u;
    const int aoff = lds_byte(wr * 64 + fr, fq * 8), boff = lds_byte(wc * 32 + fr, fq * 8);
    const char* const Ab = G.a_base();
#define PG8_SA(b, h) (((b) * 2 + (h)) * HTB)
#define PG8_SB(b, h) ((4 + (b) * 2 + (h)) * HTB)
#define PG8_STAGE_B(bufoff, gbase) do { _Pragma("unroll") for (int _i = 0; _i < 2; ++_i) \
        __builtin_amdgcn_global_load_lds((const unsigned*)((const char*)(gbase) + voffB[_i]), (LAS unsigned*)(lds + (bufoff) + ldsw + _i * 8192), 16, 0, 0); } while (0)
#define PG8_STAGE_A(bufoff, o0, o1, kb) do { const char* ub_ = Ab + (size_t)(kb);     \
        __builtin_amdgcn_global_load_lds((const unsigned*)(ub_ + (o0)), (LAS unsigned*)(lds + (bufoff) + ldsw), 16, 0, 0); \
        __builtin_amdgcn_global_load_lds((const unsigned*)(ub_ + (o1)), (LAS unsigned*)(lds + (bufoff) + ldsw + 8192), 16, 0, 0); } while (0)
#define PG8_LDA(dst, b, h) do { _Pragma("unroll") for (int m = 0; m < 4; ++m) _Pragma("unroll") for (int k = 0; k < 2; ++k) dst[m][k] = *(const LAS bf16x8*)(lds + PG8_SA(b, h) + aoff + m * 2048 + k * 1024); } while (0)
#define PG8_LDB(dst, b, h) do { _Pragma("unroll") for (int n = 0; n < 2; ++n) _Pragma("unroll") for (int k = 0; k < 2; ++k) dst[n][k] = *(const LAS bf16x8*)(lds + PG8_SB(b, h) + boff + n * 2048 + k * 1024); } while (0)
#define PG8_MMA(ai, bj, At, Bt) do { __builtin_amdgcn_s_setprio(1); _Pragma("unroll") for (int m = 0; m < 4; ++m) _Pragma("unroll") for (int n = 0; n < 2; ++n) _Pragma("unroll") for (int k = 0; k < 2; ++k) \
        acc[ai][bj][m][n] = __builtin_amdgcn_mfma_f32_16x16x32_bf16(Bt[n][k], At[m][k], acc[ai][bj][m][n], 0, 0, 0); __builtin_amdgcn_s_setprio(0); } while (0)
#define PG8_WAIT_V(n) asm volatile("s_waitcnt vmcnt(" #n ")" ::: "memory")
#define PG8_WAIT_L(n) asm volatile("s_waitcnt lgkmcnt(" #n ")" ::: "memory")
#define PG8_BAR __builtin_amdgcn_s_barrier()
#define PG8_SCHED __builtin_amdgcn_sched_barrier(0)
    Unit cur, nxt; int ui = 0;
    if (!S.next(0, cur)) return;
    if (DPH_TICKS > 0) {
        const unsigned dly = ((blockIdx.x >> 3) & 7u) * (unsigned)DPH_TICKS;
        const unsigned long long t0 = __builtin_amdgcn_s_memrealtime();
        while ((unsigned)(__builtin_amdgcn_s_memrealtime() - t0) < dly) __builtin_amdgcn_s_sleep(4);
    }
    f32x4 acc[2][2][4][2];
    float zf = 0.f; asm volatile("" : "+v"(zf));
#pragma unroll
    for (int a = 0; a < 2; ++a)
#pragma unroll
        for (int b = 0; b < 2; ++b)
#pragma unroll
            for (int m = 0; m < 4; ++m)
#pragma unroll
                for (int n = 0; n < 2; ++n) acc[a][b][m][n] = (f32x4){zf, zf, zf, zf};
    bf16x8 At[4][2], B0[2][2], B1[2][2];
    unsigned c00, c01, c10, c11; PG8_AOFFS(cur, c00, c01, c10, c11);
    const char* cB = G.b_base(cur);
    PG8_STAGE_B(PG8_SB(0, 0), cB); PG8_STAGE_A(PG8_SA(0, 0), c00, c01, 0); PG8_STAGE_B(PG8_SB(0, 1), cB + hstep); PG8_STAGE_A(PG8_SA(0, 1), c10, c11, 0);
    if (wr == 1) PG8_BAR;
    PG8_WAIT_V(4); PG8_BAR;
    PG8_STAGE_B(PG8_SB(1, 0), cB + kstep); PG8_STAGE_A(PG8_SA(1, 0), c00, c01, kstep); PG8_STAGE_B(PG8_SB(1, 1), cB + hstep + kstep);
    PG8_WAIT_V(6); PG8_BAR;
    for (;;) {
        const bool has_next = S.next(ui + 1, nxt);
        const char* nB = has_next ? G.b_base(nxt) : cB;
        for (int t = 0; t < nt; t += 2) {
            const bool last = (t == nt - 2);
            const size_t k1 = (size_t)(t + 1) * kstep;
            const size_t k2 = last ? 0 : (size_t)(t + 2) * kstep, k3 = k2 + kstep;
            unsigned a00 = c00, a01 = c01, a10 = c10, a11 = c11;
            if (last && has_next) PG8_AOFFS(nxt, a00, a01, a10, a11);
            const char* b2 = last ? nB : cB + (size_t)(t + 2) * kstep; const char* b3 = b2 + kstep;
            PG8_LDB(B0, 0, 0); PG8_SCHED; PG8_LDA(At, 0, 0); PG8_STAGE_A(PG8_SA(1, 1), c10, c11, k1);
            PG8_WAIT_L(8); PG8_BAR; PG8_WAIT_L(0); PG8_MMA(0, 0, At, B0); PG8_BAR; PG8_SCHED;
            PG8_LDB(B1, 0, 1); PG8_STAGE_B(PG8_SB(0, 0), b2);
            PG8_BAR; PG8_WAIT_L(0); PG8_MMA(0, 1, At, B1); PG8_BAR;
            PG8_LDA(At, 0, 1); PG8_STAGE_A(PG8_SA(0, 0), a00, a01, k2);
            PG8_BAR; PG8_WAIT_L(0); PG8_MMA(1, 0, At, B0); PG8_BAR; PG8_SCHED;
            PG8_STAGE_B(PG8_SB(0, 1), b2 + hstep);
            PG8_WAIT_V(6); PG8_BAR; PG8_MMA(1, 1, At, B1); PG8_BAR;
            PG8_LDB(B0, 1, 0); PG8_SCHED; PG8_LDA(At, 1, 0); PG8_STAGE_A(PG8_SA(0, 1), a10, a11, k2);
            PG8_WAIT_L(8); PG8_BAR; PG8_WAIT_L(0); PG8_MMA(0, 0, At, B0); PG8_BAR; PG8_SCHED;
            PG8_LDB(B1, 1, 1); PG8_STAGE_B(PG8_SB(1, 0), b3);
            PG8_BAR; PG8_WAIT_L(0); PG8_MMA(0, 1, At, B1); PG8_BAR;
            PG8_LDA(At, 1, 1); PG8_STAGE_A(PG8_SA(1, 0), a00, a01, k3);
            PG8_BAR; PG8_WAIT_L(0); PG8_MMA(1, 0, At, B0); PG8_BAR; PG8_SCHED;
            PG8_STAGE_B(PG8_SB(1, 1), b3 + hstep);
            PG8_WAIT_V(6); PG8_BAR; PG8_MMA(1, 1, At, B1); PG8_BAR;
        }
        { int fr_ = fr, fq_ = fq; asm volatile("" : "+v"(fr_), "+v"(fq_));
          E(acc, cur, wr, wc, fr_, fq_); }
        if (!has_next) break;
#pragma unroll
        for (int a = 0; a < 2; ++a)
#pragma unroll
            for (int b = 0; b < 2; ++b)
#pragma unroll
                for (int m = 0; m < 4; ++m)
#pragma unroll
                    for (int n = 0; n < 2; ++n) acc[a][b][m][n] = (f32x4){zf, zf, zf, zf};
        cur = nxt; cB = nB; PG8_AOFFS(cur, c00, c01, c10, c11); ++ui;
    }
    PG8_WAIT_V(0);
    if (wr == 0) PG8_BAR;
    PG8_BAR;
#undef PG8_AOFFS
#undef PG8_SA
#undef PG8_SB
#undef PG8_STAGE_A
#undef PG8_STAGE_B
#undef PG8_LDA
#undef PG8_LDB
#undef PG8_MMA
#undef PG8_WAIT_V
#undef PG8_WAIT_L
#undef PG8_BAR
#undef PG8_SCHED
}

struct GemmPlain {
    const char* A; const char* Bt; int K; int lda;
    __device__ __forceinline__ const char* a_base() const { return A; }
    __device__ __forceinline__ unsigned a_off(const Unit& u, int r) const { return (unsigned)(((size_t)(u.pm * 256 + r) * lda) * 2); }
    __device__ __forceinline__ const char* b_base(const Unit& u) const { return Bt + (size_t)u.pn * 256 * K * 2; }
};
struct StaticOrder {
    int nM, nN, nwg, G, c;
    __device__ __forceinline__ void init(int nM_, int nN_, int G_, int c_) { nM = nM_; nN = nN_; nwg = nM * nN; G = G_; c = c_; }
    __device__ __forceinline__ bool next(int i, Unit& u) const {
        const long L = (long)i * G + c; if (L >= nwg) return false;
        int wgid = (int)L; { const int q = nwg / 8, r = nwg % 8, xcd = wgid % 8, off = wgid / 8; wgid = (xcd < r ? xcd * (q + 1) : r * (q + 1) + (xcd - r) * q) + off; }
        const int nig = 8 * nN, gid = wgid / nig, fm = gid * 8, gsz = (nM - fm) < 8 ? (nM - fm) : 8;
        u.pm = fm + ((wgid % nig) % gsz); u.pn = (wgid % nig) / gsz; u.aux = 0; return true;
    }
};
}

__device__ __forceinline__ void rope4(f32x4& v0, f32x4& v1, const float* cs, const float* sn) {
    const f32x4 c = *(const f32x4*)cs, s = *(const f32x4*)sn;
    const float a0 = v0[0] * c[0] - v0[1] * s[0], b0 = v0[1] * c[0] + v0[0] * s[0];
    const float a1 = v0[2] * c[1] - v0[3] * s[1], b1 = v0[3] * c[1] + v0[2] * s[1];
    const float a2 = v1[0] * c[2] - v1[1] * s[2], b2 = v1[1] * c[2] + v1[0] * s[2];
    const float a3 = v1[2] * c[3] - v1[3] * s[3], b3 = v1[3] * c[3] + v1[2] * s[3];
    v0 = (f32x4){a0, b0, a1, b1}; v1 = (f32x4){a2, b2, a3, b3};
}
__device__ __forceinline__ void rope_cs(float pos, const f32x4& rv, f32x4& c, f32x4& s) {
#pragma unroll
    for (int e = 0; e < 4; ++e) { const float r = __builtin_amdgcn_fractf(pos * rv[e]); c[e] = __builtin_amdgcn_cosf(r); s[e] = __builtin_amdgcn_sinf(r); }
}
__device__ __forceinline__ f32x4 rope_rv(int j0, float inv_nf) {
    f32x4 rv;
#pragma unroll
    for (int e = 0; e < 4; ++e) rv[e] = __builtin_amdgcn_exp2f(-(float)(j0 + e) * inv_nf * 13.287712379549449f) * 0.15915494309189535f;
    return rv;
}
__device__ __forceinline__ void rope4v(f32x4& v0, f32x4& v1, const f32x4& c, const f32x4& s) {
    const float a0 = v0[0] * c[0] - v0[1] * s[0], b0 = v0[1] * c[0] + v0[0] * s[0];
    const float a1 = v0[2] * c[1] - v0[3] * s[1], b1 = v0[3] * c[1] + v0[2] * s[1];
    const float a2 = v1[0] * c[2] - v1[1] * s[2], b2 = v1[1] * c[2] + v1[0] * s[2];
    const float a3 = v1[2] * c[3] - v1[3] * s[3], b3 = v1[3] * c[3] + v1[2] * s[3];
    v0 = (f32x4){a0, b0, a1, b1}; v1 = (f32x4){a2, b2, a3, b3};
}
typedef float f32x2 __attribute__((ext_vector_type(2)));
template <int SEL> __device__ __forceinline__ f32x2 rope_pair(f32x2 xy, f32x2 cc, f32x2 ss) {
    f32x2 t, o;
    if constexpr (SEL == 0) {
        asm("v_pk_mul_f32 %0, %1, %2 op_sel_hi:[1,0]" : "=v"(t) : "v"(xy), "v"(cc));
        asm("v_pk_fma_f32 %0, %1, %2, %3 op_sel:[1,0,0] op_sel_hi:[0,0,1] neg_lo:[0,1,0]" : "=v"(o) : "v"(xy), "v"(ss), "v"(t));
    } else {
        asm("v_pk_mul_f32 %0, %1, %2 op_sel:[0,1] op_sel_hi:[1,1]" : "=v"(t) : "v"(xy), "v"(cc));
        asm("v_pk_fma_f32 %0, %1, %2, %3 op_sel:[1,1,0] op_sel_hi:[0,1,1] neg_lo:[0,1,0]" : "=v"(o) : "v"(xy), "v"(ss), "v"(t));
    }
    return o;
}
__device__ __forceinline__ u32x4 rope8_pack(const f32x4& v0, const f32x4& v1, const f32x4& c, const f32x4& s) {
    const f32x2 c01 = {c[0], c[1]}, c23 = {c[2], c[3]}, s01 = {s[0], s[1]}, s23 = {s[2], s[3]};
    const f32x2 o0 = rope_pair<0>((f32x2){v0[0], v0[1]}, c01, s01), o1 = rope_pair<1>((f32x2){v0[2], v0[3]}, c01, s01);
    const f32x2 o2 = rope_pair<0>((f32x2){v1[0], v1[1]}, c23, s23), o3 = rope_pair<1>((f32x2){v1[2], v1[3]}, c23, s23);
    u32x4 w; w.x = pk2(o0[0], o0[1]); w.y = pk2(o1[0], o1[1]); w.z = pk2(o2[0], o2[1]); w.w = pk2(o3[0], o3[1]); return w;
}
__device__ __forceinline__ u32x4 pack8(const f32x4& v0, const f32x4& v1) { u32x4 w; w.x = pk2(v0[0], v0[1]); w.y = pk2(v0[2], v0[3]); w.z = pk2(v1[0], v1[1]); w.w = pk2(v1[2], v1[3]); return w; }
__device__ __forceinline__ float sumsq8(const f32x4& v0, const f32x4& v1) { return (v0[0] * v0[0] + v0[1] * v0[1]) + (v0[2] * v0[2] + v0[3] * v0[3]) + (v1[0] * v1[0] + v1[1] * v1[1]) + (v1[2] * v1[2] + v1[3] * v1[3]); }

struct EpiWinEven {
    static constexpr bool PERM = true;
    unsigned char* big; float* rsq; const float* rope64; const float* rope32; bool nost;
    __device__ __forceinline__ void operator()(const f32x4 (&acc)[2][2][4][2], const pg8::Unit& u, int wr, int wc, int fr, int fq) const {
        const int row0 = u.pm * 256 + wr * 64 + fr;
        const bool lat = (u.pm * 256) < NLAT;
        bf16_t* dst; int ldc;
        if (u.pn < 2) { dst = (bf16_t*)(big + BG_AQ) + u.pn * 256; ldc = 512; }
        else if (u.pn == 2) { dst = (bf16_t*)(big + BG_AKV); ldc = 256; }
        else if (u.pn == 3) { dst = (bf16_t*)(big + BG_CQ); ldc = 256; }
        else { dst = (bf16_t*)(big + BG_CKVR); ldc = 256; }
        const bool r64 = lat && (u.pn <= 2), r32 = lat && (u.pn == 4) && (wc == 0);
        const int i0 = r64 ? (((wc & 1) * 32 + 8 * fq) >> 1) : 4 * fq;
        const int nfa = r64 ? 16 : 8;
        const f32x4 rv = rope_rv(i0 & (nfa - 1), r64 ? (1.0f / 16.0f) : (1.0f / 8.0f));
#pragma unroll
        for (int ai = 0; ai < 2; ++ai) {
            f32x4 cs[4], sn[4];
#pragma unroll
            for (int mh = 0; mh < 2; ++mh) {
            if (r64 || r32) {
#pragma unroll
                for (int m = 2 * mh; m < 2 * mh + 2; ++m) { const int sp = (row0 + ai * 128 + m * 16) & (SEQ - 1); rope_cs((float)((i0 < nfa) ? (sp >> 6) : (sp & 63)), rv, cs[m], sn[m]); }
            }
#pragma unroll
            for (int m = 2 * mh; m < 2 * mh + 2; ++m) {
                const int row = row0 + ai * 128 + m * 16;
                float ssq = 0.f;
#pragma unroll
                for (int bj = 0; bj < 2; ++bj) {
                    const int cl = bj * 128 + wc * 32 + 8 * fq;
                    f32x4 v0 = acc[ai][bj][m][0], v1 = acc[ai][bj][m][1];
                    if (u.pn < 2 || (u.pn == 2 && bj == 0)) { if (r64) rope4v(v0, v1, cs[m], sn[m]); if (u.pn < 2) { v0 = v0 * (0.125f * LOG2E); v1 = v1 * (0.125f * LOG2E); } }
                    else if (u.pn == 3) { ssq += sumsq8(v0, v1); }
                    else if (u.pn == 4) { if (bj == 0) ssq += sumsq8(v0, v1); else if (r32) rope4v(v0, v1, cs[m], sn[m]); }
                    { const u32x4 w_ = pack8(v0, v1); if (!nost) NTST((GAS u32x4*)(dst + (size_t)row * ldc + cl), w_); else asm volatile("" :: "v"(w_)); }
                }
                if (u.pn >= 3) { ssq += xshfl<16>(ssq); ssq += xshfl<32>(ssq); if (fq == 0) { if (!nost) *(GAS float*)(rsq + (size_t)row * 8 + (u.pn - 3) * 4 + wc) = ssq; else asm volatile("" :: "v"(ssq)); } }
            }
            }
        }
    }
};
struct EpiUq {
    static constexpr bool PERM = true;
    bf16_t* qm; const float* rsq; const float* rope32;
    __device__ __forceinline__ void operator()(const f32x4 (&acc)[2][2][4][2], const pg8::Unit& u, int wr, int wc, int fr, int fq) const {
        const int row0 = u.pm * 256 + wr * 64 + fr; const bool lat = (u.pm * 256) < NLAT;
        const int colb0 = u.pn * 256 + wc * 32 + 8 * fq, colb1 = colb0 + 128;
        const int d0 = colb0 % 96, d1 = colb1 % 96;
        const bool rp0 = lat && d0 >= 64, rp1 = lat && d1 >= 64;
        const int i00 = rp0 ? ((d0 - 64) >> 1) : 0, i01 = rp1 ? ((d1 - 64) >> 1) : 0;
        const f32x4 rv0 = rope_rv(i00 & 7, 1.0f / 8.0f), rv1 = rope_rv(i01 & 7, 1.0f / 8.0f);
#pragma unroll
        for (int ai = 0; ai < 2; ++ai) {
            f32x4 pq[4], c0[4], s0[4], c1[4], s1[4];
#pragma unroll
            for (int m = 0; m < 4; ++m) { const int row = row0 + ai * 128 + m * 16; const int sp = row & (SEQ - 1);
                pq[m] = *(const GAS f32x4*)(rsq + (size_t)row * 8);
                if (rp0) rope_cs((float)((i00 < 8) ? (sp >> 6) : (sp & 63)), rv0, c0[m], s0[m]);
                if (rp1) rope_cs((float)((i01 < 8) ? (sp >> 6) : (sp & 63)), rv1, c1[m], s1[m]); }
#pragma unroll
            for (int m = 0; m < 4; ++m) {
                const int row = row0 + ai * 128 + m * 16;
                const float rs = __builtin_amdgcn_rsqf(((pq[m][0] + pq[m][1]) + (pq[m][2] + pq[m][3])) * (1.0f / 256.0f) + NORM_EPS) * (0.10206207261596575f * LOG2E);
                { f32x4 v0 = acc[ai][0][m][0] * rs, v1 = acc[ai][0][m][1] * rs; if (rp0) rope4v(v0, v1, c0[m], s0[m]); NTST((GAS u32x4*)(qm + (size_t)row * 768 + colb0), pack8(v0, v1)); }
                { f32x4 v0 = acc[ai][1][m][0] * rs, v1 = acc[ai][1][m][1] * rs; if (rp1) rope4v(v0, v1, c1[m], s1[m]); NTST((GAS u32x4*)(qm + (size_t)row * 768 + colb1), pack8(v0, v1)); }
            }
        }
    }
};
struct EpiUkv {
    static constexpr bool PERM = true;
    bf16_t* kvm; const float* rsq;
    __device__ __forceinline__ void operator()(const f32x4 (&acc)[2][2][4][2], const pg8::Unit& u, int wr, int wc, int fr, int fq) const {
        const int row0 = u.pm * 256 + wr * 64 + fr;
        f32x4 pq[2][4];
#pragma unroll
        for (int ai = 0; ai < 2; ++ai)
#pragma unroll
            for (int m = 0; m < 4; ++m) pq[ai][m] = *(const GAS f32x4*)(rsq + (size_t)(row0 + ai * 128 + m * 16) * 8 + 4);
#pragma unroll
        for (int ai = 0; ai < 2; ++ai)
#pragma unroll
            for (int m = 0; m < 4; ++m) {
                const int row = row0 + ai * 128 + m * 16; const f32x4 p = pq[ai][m];
                const float rs = __builtin_amdgcn_rsqf(((p[0] + p[1]) + (p[2] + p[3])) * (1.0f / 128.0f) + NORM_EPS);
#pragma unroll
                for (int bj = 0; bj < 2; ++bj) {
                    const int col = u.pn * 256 + bj * 128 + wc * 32 + 8 * fq;
                    const f32x4 v0 = acc[ai][bj][m][0] * rs, v1 = acc[ai][bj][m][1] * rs;
                    NTST((GAS u32x4*)(kvm + (size_t)row * 1024 + col), pack8(v0, v1));
                }
            }
    }
};
struct EpiWinOdd {
    static constexpr bool PERM = true;
    bf16_t* qkv; const float* rope64; bool nost;
    template <bool ROWAX>
    __device__ __forceinline__ void body(const f32x4 (&acc)[2][2][4][2], const pg8::Unit& u, int wr, int wc, int fr, int fq) const {
        const int row0 = u.pm * 256 + wr * 64 + fr; const bool lat = (u.pm * 256) < NLAT;
        GAS bf16_t* const p0 = (GAS bf16_t*)qkv + (size_t)row0 * 3072 + (u.pn * 256 + wc * 32 + 8 * fq);
        if (u.pn >= 8) {
#pragma unroll
            for (int ai = 0; ai < 2; ++ai)
#pragma unroll
                for (int m = 0; m < 4; ++m)
#pragma unroll
                    for (int bj = 0; bj < 2; ++bj) { const u32x4 w_ = pack8(acc[ai][bj][m][0], acc[ai][bj][m][1]); if (!nost) NTST((GAS u32x4*)(p0 + (size_t)(ai * 128 + m * 16) * 3072 + bj * 128), w_); else asm volatile("" :: "v"(w_)); }
            return;
        }
        const float kf = (u.pn < 4) ? (0.125f * LOG2E) : 1.0f;
        const f32x4 rv = rope_rv(4 * fq, 1.0f / 16.0f);
        f32x4 cs[4], sn[4];
#pragma unroll
        for (int ai = 0; ai < 2; ++ai) {
            if (!lat) {
#pragma unroll
                for (int m = 0; m < 4; ++m) { cs[m] = (f32x4){kf, kf, kf, kf}; sn[m] = (f32x4){0.f, 0.f, 0.f, 0.f}; }
            } else if (ROWAX) {
                f32x4 c, sv; rope_cs((float)((u.pm * 4 + wr + 2 * ai) & 63), rv, c, sv); c = c * kf; sv = sv * kf;
#pragma unroll
                for (int m = 0; m < 4; ++m) { cs[m] = c; sn[m] = sv; }
            } else if (ai == 0) {
#pragma unroll
                for (int m = 0; m < 4; ++m) { rope_cs((float)(m * 16 + fr), rv, cs[m], sn[m]); cs[m] = cs[m] * kf; sn[m] = sn[m] * kf; }
            }
#pragma unroll
            for (int m = 0; m < 4; ++m)
#pragma unroll
                for (int bj = 0; bj < 2; ++bj) {
                    const u32x4 w_ = rope8_pack(acc[ai][bj][m][0], acc[ai][bj][m][1], cs[m], sn[m]);
                    if (!nost) NTST((GAS u32x4*)(p0 + (size_t)(ai * 128 + m * 16) * 3072 + bj * 128), w_); else asm volatile("" :: "v"(w_));
                }
        }
    }
    __device__ __forceinline__ void operator()(const f32x4 (&acc)[2][2][4][2], const pg8::Unit& u, int wr, int wc, int fr, int fq) const {
        if ((wc & 1) == 0) body<true>(acc, u, wr, wc, fr, fq); else body<false>(acc, u, wr, wc, fr, fq);
    }
};
template <bool SRC_F32>
struct EpiResid {
    static constexpr bool PERM = true;
    const float* src_lat; const float* src_ctx; bf16_t* xb; const float* mod; int gate_off;
    float* rs16;
    __device__ __forceinline__ void operator()(const f32x4 (&acc)[2][2][4][2], const pg8::Unit& u, int wr, int wc, int fr, int fq) const {
        const int rowt = u.pm * 256; const bool lat = rowt < NLAT;
        const float* sp = lat ? src_lat + (size_t)rowt * DM : src_ctx + (size_t)(rowt - NLAT) * DM;
        const float* g = mod + (size_t)(lat ? (rowt >> 12) : 16) * 6144 + gate_off;
        const int r0 = wr * 64 + fr, col0 = u.pn * 256 + wc * 32 + 8 * fq;
        GAS bf16_t* const xp = (GAS bf16_t*)xb + (size_t)(rowt + r0) * DM + col0;
        f32x4 gv[2][2];
#pragma unroll
        for (int bj = 0; bj < 2; ++bj)
#pragma unroll
            for (int n = 0; n < 2; ++n) gv[bj][n] = *(const GAS f32x4*)(g + col0 + bj * 128 + n * 4);
#pragma unroll
        for (int ai = 0; ai < 2; ++ai) {
            f32x4 xv[4][2][2];
            if constexpr (SRC_F32) {
#pragma unroll
                for (int m = 0; m < 4; ++m) { const size_t ro = (size_t)(r0 + ai * 128 + m * 16) * DM + col0;
#pragma unroll
                    for (int bj = 0; bj < 2; ++bj)
#pragma unroll
                        for (int n = 0; n < 2; ++n) xv[m][bj][n] = *(const GAS f32x4*)(sp + ro + bj * 128 + n * 4); }
            } else {
                u32x4 xw[4][2];
#pragma unroll
                for (int m = 0; m < 4; ++m)
#pragma unroll
                    for (int bj = 0; bj < 2; ++bj) xw[m][bj] = *(const GAS u32x4*)(xp + (size_t)(ai * 128 + m * 16) * DM + bj * 128);
#pragma unroll
                for (int m = 0; m < 4; ++m)
#pragma unroll
                    for (int bj = 0; bj < 2; ++bj) { const u32x4 t = xw[m][bj]; xv[m][bj][0] = (f32x4){bflo(t.x), bfhi(t.x), bflo(t.y), bfhi(t.y)}; xv[m][bj][1] = (f32x4){bflo(t.z), bfhi(t.z), bflo(t.w), bfhi(t.w)}; }
            }
#pragma unroll
            for (int m = 0; m < 4; ++m) { float ss = 0.f;
#pragma unroll
                for (int bj = 0; bj < 2; ++bj) {
                    const f32x4 y0 = xv[m][bj][0] + gv[bj][0] * acc[ai][bj][m][0], y1 = xv[m][bj][1] + gv[bj][1] * acc[ai][bj][m][1];
                    *(GAS u32x4*)(xp + (size_t)(ai * 128 + m * 16) * DM + bj * 128) = pack8(y0, y1); ss += sumsq8(y0, y1); }
                ss += xshfl<16>(ss); ss += xshfl<32>(ss);
                if (fq == 0) *(GAS float*)(rs16 + (size_t)(rowt + r0 + ai * 128 + m * 16) * 16 + u.pn * 4 + wc) = ss; }
        }
    }
};
struct EpiSwiglu {
    static constexpr bool PERM = true;
    bf16_t* act;
    __device__ __forceinline__ void operator()(const f32x4 (&acc)[2][2][4][2], const pg8::Unit& u, int wr, int wc, int fr, int fq) const {
        const int row0 = u.pm * 256 + wr * 64 + fr;
#pragma unroll
        for (int ai = 0; ai < 2; ++ai)
#pragma unroll
            for (int m = 0; m < 4; ++m) {
                const int row = row0 + ai * 128 + m * 16;
#pragma unroll
                for (int bj = 0; bj < 2; ++bj) {
                    const int col = u.pn * 256 + bj * 128 + wc * 32 + 8 * fq;
                    const f32x4 v0 = acc[ai][bj][m][0], v1 = acc[ai][bj][m][1];
                    float o[4];
                    { const float a = v0[0], b = v0[1]; o[0] = a * __builtin_amdgcn_rcpf(1.f + __builtin_amdgcn_exp2f(-LOG2E * a)) * b; }
                    { const float a = v0[2], b = v0[3]; o[1] = a * __builtin_amdgcn_rcpf(1.f + __builtin_amdgcn_exp2f(-LOG2E * a)) * b; }
                    { const float a = v1[0], b = v1[1]; o[2] = a * __builtin_amdgcn_rcpf(1.f + __builtin_amdgcn_exp2f(-LOG2E * a)) * b; }
                    { const float a = v1[2], b = v1[3]; o[3] = a * __builtin_amdgcn_rcpf(1.f + __builtin_amdgcn_exp2f(-LOG2E * a)) * b; }
                    u32x2 w; w.x = pk2(o[0], o[1]); w.y = pk2(o[2], o[3]);
                    NTST((GAS u32x2*)(act + (size_t)row * EFF + (col >> 1)), w);
                }
            }
    }
};
struct EpiMoe2 {
    static constexpr bool PERM = true;
    bf16_t* yb; const LAS float* gl;
    __device__ __forceinline__ void operator()(const f32x4 (&acc)[2][2][4][2], const pg8::Unit& u, int wr, int wc, int fr, int fq) const {
        const int row0 = u.pm * 256 + wr * 64 + fr;
        float gt[2][4];
#pragma unroll
        for (int ai = 0; ai < 2; ++ai)
#pragma unroll
            for (int m = 0; m < 4; ++m) gt[ai][m] = gl[u.aux * 256 + wr * 64 + fr + ai * 128 + m * 16];
#pragma unroll
        for (int ai = 0; ai < 2; ++ai)
#pragma unroll
            for (int m = 0; m < 4; ++m) {
                const int row = row0 + ai * 128 + m * 16; const float g = gt[ai][m];
#pragma unroll
                for (int bj = 0; bj < 2; ++bj) {
                    const int col = u.pn * 256 + bj * 128 + wc * 32 + 8 * fq;
                    const f32x4 v0 = acc[ai][bj][m][0] * g, v1 = acc[ai][bj][m][1] * g;
                    NTST((GAS u32x4*)(yb + (size_t)row * DM + col), pack8(v0, v1));
                }
            }
    }
};
struct MoeSched {
    const LAS int* tile_exp; int ntiles; int G, c;
    __device__ __forceinline__ bool next(int i, pg8::Unit& u) const {
        const int L = i * G + c; if (L >= ntiles * 4) return false;
        u.pm = L >> 2; u.pn = L & 3; u.aux = i; return true;
    }
};
struct GemmMoe1 {
    const char* H; const char* W13l; const LAS int* idx; const LAS int* tile_exp; int K;
    __device__ __forceinline__ const char* a_base() const { return H; }
    __device__ __forceinline__ unsigned a_off(const pg8::Unit& u, int r) const { return (unsigned)idx[u.aux * 256 + r] * (unsigned)(DM * 2); }
    __device__ __forceinline__ const char* b_base(const pg8::Unit& u) const { return W13l + ((size_t)tile_exp[u.pm] * 1024 + (size_t)u.pn * 256) * 1024 * 2; }
};
struct GemmMoe2 {
    const char* ACT; const char* W2l; const LAS int* tile_exp; int K;
    __device__ __forceinline__ const char* a_base() const { return ACT; }
    __device__ __forceinline__ unsigned a_off(const pg8::Unit& u, int r) const { return (unsigned)(u.pm * 256 + r) * (unsigned)(EFF * 2); }
    __device__ __forceinline__ const char* b_base(const pg8::Unit& u) const { return W2l + ((size_t)tile_exp[u.pm] * 1024 + (size_t)u.pn * 256) * 512 * 2; }
};

namespace att {
enum { MLA = 0, SWA = 1, DIFF = 2 };
template <int MODE> struct Cfg;
template <> struct Cfg<MLA>  { static constexpr int DQK = 96, DV = 64,  NKCH = 12, QB = 256; };
template <> struct Cfg<SWA>  { static constexpr int DQK = 64, DV = 64,  NKCH = 8,  QB = 256; };
template <> struct Cfg<DIFF> { static constexpr int DQK = 64, DV = 128, NKCH = 16, QB = 128; };
struct Unit {
    int qrow0;
    int lat_row0;
    int nlat;
    int ctx_row0;
    int head;
    int qpos0;
    int kpos0;
};
struct Tensors {
    const bf16_t* q; const bf16_t* k; const bf16_t* k2; const bf16_t* v; bf16_t* o;
    const float* sink; float lam; const float* subln; float post;
    float c2;
};
__device__ __forceinline__ s16x4 vtr(const LAS unsigned char* p) {
    typedef short v4i16_t __attribute__((ext_vector_type(4)));
    return __builtin_bit_cast(s16x4, __builtin_amdgcn_ds_read_tr16_b64_v4i16((LAS v4i16_t*)p));
}
template <int MODE>
__device__ __forceinline__ void issue_tile(lptr lds, int buf, int row0, const Tensors& T, int head, int wid, int lane) {
    typedef Cfg<MODE> C;
    constexpr int KB = C::NKCH * 1024, VB = C::DV * 128;
    for (int p = wid; p < C::NKCH; p += 8) {
        const bf16_t* src;
        const size_t row = (size_t)(row0 + lane);
        if (MODE == MLA) src = (p < 8) ? T.k + row * 1024 + head * 128 + p * 8 : T.k2 + row * 256 + 128 + (p - 8) * 8;
        else if (MODE == SWA) src = T.k + row * 256 + (head >> 2) * 64 + p * 8;
        else src = T.k + row * 3072 + 1024 + head * 128 + p * 8;
        __builtin_amdgcn_global_load_lds((const unsigned*)src, (LAS unsigned*)(lds + buf * KB + p * 1024), 16, 0, 0);
    }
    for (int p = wid; p < C::DV / 8; p += 8) {
        const size_t row = (size_t)(row0 + 16 * (p & 3) + (lane >> 2)); const int col = (p >> 2) * 32 + (lane & 3) * 8;
        const bf16_t* src;
        if (MODE == MLA) src = T.v + row * 1024 + head * 128 + 64 + col;
        else if (MODE == SWA) src = T.v + row * 256 + 128 + (head >> 2) * 64 + col;
        else src = T.v + row * 3072 + 2048 + head * 128 + col;
        __builtin_amdgcn_global_load_lds((const unsigned*)src, (LAS unsigned*)(lds + 2 * KB + buf * VB + p * 1024), 16, 0, 0);
    }
}
template <int MODE, bool GUARDED>
__device__ __forceinline__ bool attn_unit(lptr lds, const Unit& U, const Tensors& T, int wv) {
    typedef Cfg<MODE> C;
    constexpr int KB = C::NKCH * 1024, VB = C::DV * 128, NKS = C::DQK / 16, ND = C::DV / 32;
    const int tid = opaque_tid(wv), lane = tid & 63, r32 = lane & 31, hi = lane >> 5; const int wid = __builtin_amdgcn_readfirstlane(tid >> 6);
    const int br = (MODE == DIFF) ? (wid >> 2) : 0;
    const int wq = (MODE == DIFF) ? (wid & 3) : wid;
    const int NT = U.nlat + 4;
    issue_tile<MODE>(lds, 0, U.nlat > 0 ? U.lat_row0 : U.ctx_row0, T, U.head, wid, lane);
    bf16x8 qf[NKS];
    {
        const size_t qrow = (size_t)(U.qrow0 + wq * 32 + r32);
        const bf16_t* qp;
        if (MODE == MLA) qp = T.q + qrow * 768 + U.head * 96 + hi * 8;
        else if (MODE == SWA) qp = T.q + qrow * 512 + U.head * 64 + hi * 8;
        else qp = T.q + qrow * 3072 + U.head * 128 + br * 64 + hi * 8;
#pragma unroll
        for (int ks = 0; ks < NKS; ++ks) qf[ks] = *(const GAS bf16x8*)(qp + ks * 16);
    }
    f32x16 o[ND];
#pragma unroll
    for (int d = 0; d < ND; ++d) o[d] = f32x16{};
    float m = GUARDED ? -INFINITY : 0.f, l = 0.f;
    const float c2 = T.c2;
    const int qpos = U.qpos0 + wq * 32 + r32, qa = U.qpos0 + wq * 32;
    const int koff = (MODE == DIFF ? br * 8192 : 0) + hi * 1024 + r32 * 16;
    const int voff = ((lane >> 4) & 1) * 32 + (lane & 3) * 8 + (4 * hi + ((lane & 15) >> 2)) * 64;
    asm volatile("s_waitcnt vmcnt(0)" ::: "memory");
    __syncthreads();
    for (int j = 0; j < NT; ++j) {
        const int buf = j & 1;
        if (j + 1 < NT) { const int jn = j + 1; issue_tile<MODE>(lds, buf ^ 1, jn < U.nlat ? U.lat_row0 + 64 * jn : U.ctx_row0 + 64 * (jn - U.nlat), T, U.head, wid, lane); }
        bool active = true; const bool latt = j < U.nlat; const int kt = U.kpos0 + 64 * j;
        if (MODE == SWA && latt) active = (kt <= qa + 31 + 128) && (kt + 63 >= qa - 128);
        if (active) {
            const lptr kb = lds + buf * KB + koff;
            f32x16 s0 = f32x16{}, s1 = f32x16{};
#pragma unroll
            for (int ks = 0; ks < NKS; ++ks) {
                const bf16x8 k0 = *(const LAS bf16x8*)(kb + ks * 2048), k1 = *(const LAS bf16x8*)(kb + ks * 2048 + 512);
                s0 = __builtin_amdgcn_mfma_f32_32x32x16_bf16(k0, qf[ks], s0, 0, 0, 0);
                s1 = __builtin_amdgcn_mfma_f32_32x32x16_bf16(k1, qf[ks], s1, 0, 0, 0);
            }
            if (MODE == SWA && latt) {
#pragma unroll
                for (int r = 0; r < 16; ++r) { const int kp = kt + crow(r, hi); int d0 = qpos - kp; d0 = d0 < 0 ? -d0 : d0; int d1 = qpos - kp - 32; d1 = d1 < 0 ? -d1 : d1;
                    if (d0 > 128) s0[r] = -INFINITY; if (d1 > 128) s1[r] = -INFINITY; }
            }
            float ps = 0.f;
            if (GUARDED) {
                float mt = fmaxf(s0[0], s1[0]);
#pragma unroll
                for (int r = 1; r < 16; ++r) mt = fmaxf(mt, fmaxf(s0[r], s1[r]));
                mt = fmaxf(mt, xshfl<32>(mt)) * c2;
                const float mn = fmaxf(m, mt);
                const float mu = (mn == -INFINITY) ? 0.f : mn;
                const float alpha = __builtin_amdgcn_exp2f(m - mu);
                m = mn;
#pragma unroll
                for (int r = 0; r < 16; ++r) { s0[r] = __builtin_amdgcn_exp2f(s0[r] * c2 - mu); s1[r] = __builtin_amdgcn_exp2f(s1[r] * c2 - mu); ps += s0[r] + s1[r]; }
                l = l * alpha + ps;
#pragma unroll
                for (int d = 0; d < ND; ++d)
#pragma unroll
                    for (int r = 0; r < 16; ++r) o[d][r] *= alpha;
            } else {
#pragma unroll
                for (int r = 0; r < 16; ++r) { s0[r] = __builtin_amdgcn_exp2f(s0[r]); s1[r] = __builtin_amdgcn_exp2f(s1[r]); ps += s0[r] + s1[r]; }
                l += ps;
            }
            bf16x8 pw[4];
            { u32x4 w;
              w.x = pk2(s0[0], s0[1]); w.y = pk2(s0[2], s0[3]); w.z = pk2(s0[4], s0[5]); w.w = pk2(s0[6], s0[7]); pw[0] = __builtin_bit_cast(bf16x8, w);
              w.x = pk2(s0[8], s0[9]); w.y = pk2(s0[10], s0[11]); w.z = pk2(s0[12], s0[13]); w.w = pk2(s0[14], s0[15]); pw[1] = __builtin_bit_cast(bf16x8, w);
              w.x = pk2(s1[0], s1[1]); w.y = pk2(s1[2], s1[3]); w.z = pk2(s1[4], s1[5]); w.w = pk2(s1[6], s1[7]); pw[2] = __builtin_bit_cast(bf16x8, w);
              w.x = pk2(s1[8], s1[9]); w.y = pk2(s1[10], s1[11]); w.z = pk2(s1[12], s1[13]); w.w = pk2(s1[14], s1[15]); pw[3] = __builtin_bit_cast(bf16x8, w); }
            const lptr vb = lds + 2 * KB + buf * VB + voff;
#pragma unroll
            for (int d = 0; d < ND; ++d)
#pragma unroll
                for (int kk = 0; kk < 4; ++kk) {
                    const s16x4 lo = vtr(vb + d * 4096 + kk * 1024), hh = vtr(vb + d * 4096 + kk * 1024 + 512);
                    const bf16x8 vf = (bf16x8){lo[0], lo[1], lo[2], lo[3], hh[0], hh[1], hh[2], hh[3]};
                    o[d] = __builtin_amdgcn_mfma_f32_32x32x16_bf16(vf, pw[kk], o[d], 0, 0, 0);
                }
        }
        asm volatile("s_waitcnt vmcnt(0)" ::: "memory");
        __syncthreads();
    }
    l += xshfl<32>(l);
    if (MODE == SWA) l += __builtin_amdgcn_exp2f(T.sink[U.head] * LOG2E - m);
    if (!GUARDED) {
        float oa = 0.f;
#pragma unroll
        for (int d = 0; d < ND; ++d)
#pragma unroll
            for (int r = 0; r < 16; ++r) oa += __builtin_fabsf(o[d][r]);
        const bool badl = !(l > 0x1p-100f && l < 0x1p100f) || !(oa < 0x1p120f);
        LAS unsigned* flg = (LAS unsigned*)(lds + LDS_MISC + 4608);
        const bool wbad = __builtin_amdgcn_ballot_w64(badl) != 0ull;
        if (lane == 0) flg[wid] = wbad ? 1u : 0u;
        __syncthreads();
        unsigned anyb = 0u;
#pragma unroll
        for (int w = 0; w < 8; ++w) anyb |= flg[w];
        __syncthreads();
        if (__builtin_amdgcn_readfirstlane(anyb) != 0u) return true;
    }
    const float inv = 1.0f / l;
#pragma unroll
    for (int d = 0; d < ND; ++d)
#pragma unroll
        for (int r = 0; r < 16; ++r) o[d][r] *= inv;
    const size_t orow = (size_t)(U.qrow0 + wq * 32 + r32);
    if (MODE == DIFF) {
        LAS float* xch = (LAS float*)lds + (size_t)(wid & 3) * 4096 + lane;
        if (br == 1) {
#pragma unroll
            for (int d = 0; d < ND; ++d)
#pragma unroll
                for (int r = 0; r < 16; ++r) xch[(d * 16 + r) * 64] = o[d][r];
        }
        __syncthreads();
        if (br == 0) {
            float ss = 0.f;
#pragma unroll
            for (int d = 0; d < ND; ++d)
#pragma unroll
                for (int r = 0; r < 16; ++r) { const float v = o[d][r] - T.lam * xch[(d * 16 + r) * 64]; o[d][r] = v; ss += v * v; }
            ss += xshfl<32>(ss);
            const float rs = __builtin_amdgcn_rsqf(ss * (1.0f / 128.0f) + DIFF_EPS) * T.post;
            bf16_t* op = T.o + orow * 1024 + U.head * 128;
#pragma unroll
            for (int d = 0; d < ND; ++d)
#pragma unroll
                for (int g = 0; g < 4; ++g) {
                    const int dv0 = 32 * d + 8 * g + 4 * hi; const f32x4 gn = *(const GAS f32x4*)(T.subln + dv0);
                    u32x2 w; w.x = pk2(o[d][4 * g] * rs * gn[0], o[d][4 * g + 1] * rs * gn[1]); w.y = pk2(o[d][4 * g + 2] * rs * gn[2], o[d][4 * g + 3] * rs * gn[3]);
                    *(GAS u32x2*)(op + dv0) = w;
                }
        }
        __syncthreads();
    } else {
        bf16_t* op = T.o + orow * 1024 + (MODE == MLA ? 512 + U.head * 64 : U.head * 64);
#pragma unroll
        for (int d = 0; d < ND; ++d)
#pragma unroll
            for (int g = 0; g < 4; ++g) {
                const int dv0 = 32 * d + 8 * g + 4 * hi;
                u32x2 w; w.x = pk2(o[d][4 * g], o[d][4 * g + 1]); w.y = pk2(o[d][4 * g + 2], o[d][4 * g + 3]);
                *(GAS u32x2*)(op + dv0) = w;
            }
    }
    return false;
}
__device__ __forceinline__ void glds16(const void* gsrc, unsigned lds_dst) { unsigned keep;
    asm volatile("s_mov_b32 %0, m0\n\ts_mov_b32 m0, %2\n\ts_nop 0\n\tglobal_load_lds_dwordx4 %1, off\n\ts_mov_b32 m0, %0" : "=&s"(keep) : "v"(gsrc), "s"(lds_dst) : "memory"); }
template <int MODE>
__device__ __forceinline__ void issue_k(lptr lds, int kbyte, int row0, const Tensors& T, int head, int wid, int lane) {
    typedef Cfg<MODE> C;
#pragma unroll
    for (int q = 0; q < (C::NKCH + 7) / 8; ++q) {
        int p = wid + 8 * q; if (p >= C::NKCH) p -= 8;
        const bf16_t* src; const size_t row = (size_t)(row0 + lane);
        if (MODE == MLA) src = (p < 8) ? T.k + row * 1024 + head * 128 + p * 8 : T.k2 + row * 256 + 128 + (p - 8) * 8;
        else if (MODE == SWA) src = T.k + row * 256 + (head >> 2) * 64 + p * 8;
        else {
            const int r = 4 * p + (lane >> 4), sl = lane & 15;
            src = T.k + (size_t)(row0 + r) * 3072 + 1024 + head * 128 + ((sl ^ (r & 15)) * 8);
        }
        glds16(src, (unsigned)__builtin_amdgcn_readfirstlane((int)(unsigned)(size_t)(lds + kbyte + p * 1024)));
    }
}
template <int MODE>
__device__ __forceinline__ void issue_v(lptr lds, int vbyte, int row0, const Tensors& T, int head, int wid, int lane) {
    typedef Cfg<MODE> C;
#pragma unroll
    for (int q = 0; q < C::DV / 64; ++q) {
        const int p = wid + 8 * q;
        const size_t row = (size_t)(row0 + 16 * (p & 3) + (lane >> 2)); const int col = (p >> 2) * 32 + (lane & 3) * 8;
        const bf16_t* src;
        if (MODE == MLA) src = T.v + row * 1024 + head * 128 + 64 + col;
        else if (MODE == SWA) src = T.v + row * 256 + 128 + (head >> 2) * 64 + col;
        else {
            const int r = 4 * p + (lane >> 4), sl = lane & 15;
            src = T.v + (size_t)(row0 + r) * 3072 + 2048 + head * 128 + ((((sl >> 2) ^ (r & 3)) * 4 + (sl & 3)) * 8);
        }
        glds16(src, (unsigned)__builtin_amdgcn_readfirstlane((int)(unsigned)(size_t)(lds + vbyte + p * 1024)));
    }
}
template <int MODE>
__device__ __forceinline__ void attn_unit_p(lptr lds, const Unit& U, const Tensors& T, int wv) {
    typedef Cfg<MODE> C;
    constexpr int KB = C::NKCH * 1024, VB = C::DV * 128, NKS = C::DQK / 16, ND = C::DV / 32;
    constexpr float THR = 8.0f;
    const int tid = opaque_tid(wv), lane = tid & 63, r32 = lane & 31, hi = lane >> 5; const int wid = __builtin_amdgcn_readfirstlane(tid >> 6);
    const int br = (MODE == DIFF) ? (wid >> 2) : 0;
    const int wq = (MODE == DIFF) ? (wid & 3) : wid;
    const int NT = U.nlat + 4;
#define TROW(j) ((j) < U.nlat ? U.lat_row0 + 64 * (j) : U.ctx_row0 + 64 * ((j) - U.nlat))
    issue_k<MODE>(lds, 0, TROW(0), T, U.head, wid, lane);
    issue_v<MODE>(lds, 2 * KB, TROW(0), T, U.head, wid, lane);
    issue_k<MODE>(lds, KB, TROW(1), T, U.head, wid, lane);
    bf16x8 qf[NKS];
    {
        const size_t qrow = (size_t)(U.qrow0 + wq * 32 + r32);
        const bf16_t* qp;
        if (MODE == MLA) qp = T.q + qrow * 768 + U.head * 96 + hi * 8;
        else if (MODE == SWA) qp = T.q + qrow * 512 + U.head * 64 + hi * 8;
        else qp = T.q + qrow * 3072 + U.head * 128 + br * 64 + hi * 8;
#pragma unroll
        for (int ks = 0; ks < NKS; ++ks) qf[ks] = *(const GAS bf16x8*)(qp + ks * 16);
    }
    f32x16 o[ND];
#pragma unroll
    for (int d = 0; d < ND; ++d) o[d] = f32x16{};
    float mref = -INFINITY, l = 0.f;
    const float c2 = T.c2;
    const int koff = (MODE == DIFF ? br * 8192 : 0) + hi * 1024 + r32 * 16;
    const int voff = ((lane >> 4) & 1) * 32 + (lane & 3) * 8 + (4 * hi + ((lane & 15) >> 2)) * 64;
#define QKT(D0, D1, KBUF) do { const lptr kb_ = lds + (KBUF) * KB + koff; D0 = f32x16{}; D1 = f32x16{}; \
        _Pragma("unroll") for (int ks = 0; ks < NKS; ++ks) { const bf16x8 k0_ = *(const LAS bf16x8*)(kb_ + ks * 2048), k1_ = *(const LAS bf16x8*)(kb_ + ks * 2048 + 512); \
            D0 = __builtin_amdgcn_mfma_f32_32x32x16_bf16(k0_, qf[ks], D0, 0, 0, 0); D1 = __builtin_amdgcn_mfma_f32_32x32x16_bf16(k1_, qf[ks], D1, 0, 0, 0); } } while (0)
#define SOFTMAX_PV(VBUF) do { \
        float mt_ = fmaxf(s0[0], s1[0]); \
        _Pragma("unroll") for (int r = 1; r < 16; ++r) mt_ = fmaxf(mt_, fmaxf(s0[r], s1[r])); \
        mt_ = fmaxf(mt_, xshfl<32>(mt_)) * c2; \
        if (__builtin_amdgcn_ballot_w64(mt_ > mref + THR) != 0ull) { \
            const float mn_ = fmaxf(mref, mt_); const float mu_ = (mn_ == -INFINITY) ? 0.f : mn_; const float alpha_ = __builtin_amdgcn_exp2f(mref - mu_); \
            mref = mn_; l *= alpha_; \
            _Pragma("unroll") for (int d = 0; d < ND; ++d) _Pragma("unroll") for (int r = 0; r < 16; ++r) o[d][r] *= alpha_; } \
        const float mu2_ = (mref == -INFINITY) ? 0.f : mref; float ps_ = 0.f; \
        _Pragma("unroll") for (int r = 0; r < 16; ++r) { s0[r] = __builtin_amdgcn_exp2f(s0[r] * c2 - mu2_); s1[r] = __builtin_amdgcn_exp2f(s1[r] * c2 - mu2_); ps_ += s0[r] + s1[r]; } \
        l += ps_; \
        bf16x8 pw_[4]; { u32x4 w_; \
          w_.x = pk2(s0[0], s0[1]); w_.y = pk2(s0[2], s0[3]); w_.z = pk2(s0[4], s0[5]); w_.w = pk2(s0[6], s0[7]); pw_[0] = __builtin_bit_cast(bf16x8, w_); \
          w_.x = pk2(s0[8], s0[9]); w_.y = pk2(s0[10], s0[11]); w_.z = pk2(s0[12], s0[13]); w_.w = pk2(s0[14], s0[15]); pw_[1] = __builtin_bit_cast(bf16x8, w_); \
          w_.x = pk2(s1[0], s1[1]); w_.y = pk2(s1[2], s1[3]); w_.z = pk2(s1[4], s1[5]); w_.w = pk2(s1[6], s1[7]); pw_[2] = __builtin_bit_cast(bf16x8, w_); \
          w_.x = pk2(s1[8], s1[9]); w_.y = pk2(s1[10], s1[11]); w_.z = pk2(s1[12], s1[13]); w_.w = pk2(s1[14], s1[15]); pw_[3] = __builtin_bit_cast(bf16x8, w_); } \
        const lptr vb_ = lds + 2 * KB + (VBUF) * VB + voff; \
        _Pragma("unroll") for (int d = 0; d < ND; ++d) _Pragma("unroll") for (int kk = 0; kk < 4; ++kk) { \
            const s16x4 lo_ = vtr(vb_ + d * 4096 + kk * 1024), hh_ = vtr(vb_ + d * 4096 + kk * 1024 + 512); \
            const bf16x8 vf_ = (bf16x8){lo_[0], lo_[1], lo_[2], lo_[3], hh_[0], hh_[1], hh_[2], hh_[3]}; \
            o[d] = __builtin_amdgcn_mfma_f32_32x32x16_bf16(vf_, pw_[kk], o[d], 0, 0, 0); } } while (0)
    asm volatile("s_waitcnt vmcnt(0)" ::: "memory");
    __syncthreads();
    f32x16 s0, s1;
    QKT(s0, s1, 0);
    __syncthreads();
    for (int j = 0; j + 1 < NT; ++j) {
        if (j + 2 < NT) issue_k<MODE>(lds, (j & 1) * KB, TROW(j + 2), T, U.head, wid, lane);
        issue_v<MODE>(lds, 2 * KB + ((j + 1) & 1) * VB, TROW(j + 1), T, U.head, wid, lane);
        f32x16 n0, n1;
        QKT(n0, n1, (j + 1) & 1);
        SOFTMAX_PV(j & 1);
        s0 = n0; s1 = n1;
        asm volatile("s_waitcnt vmcnt(0)" ::: "memory");
        __syncthreads();
    }
    SOFTMAX_PV((NT - 1) & 1);
    __syncthreads();
#undef TROW
#undef QKT
#undef SOFTMAX_PV
    l += xshfl<32>(l);
    const float inv = 1.0f / l;
#pragma unroll
    for (int d = 0; d < ND; ++d)
#pragma unroll
        for (int r = 0; r < 16; ++r) o[d][r] *= inv;
    const size_t orow = (size_t)(U.qrow0 + wq * 32 + r32);
    if (MODE == DIFF) {
        LAS float* xch = (LAS float*)lds + (size_t)(wid & 3) * 4096 + lane;
        if (br == 1) {
#pragma unroll
            for (int d = 0; d < ND; ++d)
#pragma unroll
                for (int r = 0; r < 16; ++r) xch[(d * 16 + r) * 64] = o[d][r];
        }
        __syncthreads();
        if (br == 0) {
            float ss = 0.f;
#pragma unroll
            for (int d = 0; d < ND; ++d)
#pragma unroll
                for (int r = 0; r < 16; ++r) { const float v = o[d][r] - T.lam * xch[(d * 16 + r) * 64]; o[d][r] = v; ss += v * v; }
            ss += xshfl<32>(ss);
            const float rs = __builtin_amdgcn_rsqf(ss * (1.0f / 128.0f) + DIFF_EPS) * T.post;
            bf16_t* op = T.o + orow * 1024 + U.head * 128;
#pragma unroll
            for (int d = 0; d < ND; ++d)
#pragma unroll
                for (int g = 0; g < 4; ++g) {
                    const int dv0 = 32 * d + 8 * g + 4 * hi; const f32x4 gn = *(const GAS f32x4*)(T.subln + dv0);
                    u32x2 w; w.x = pk2(o[d][4 * g] * rs * gn[0], o[d][4 * g + 1] * rs * gn[1]); w.y = pk2(o[d][4 * g + 2] * rs * gn[2], o[d][4 * g + 3] * rs * gn[3]);
                    *(GAS u32x2*)(op + dv0) = w;
                }
        }
        __syncthreads();
    } else {
        bf16_t* op = T.o + orow * 1024 + (MODE == MLA ? 512 + U.head * 64 : U.head * 64);
#pragma unroll
        for (int d = 0; d < ND; ++d)
#pragma unroll
            for (int g = 0; g < 4; ++g) {
                const int dv0 = 32 * d + 8 * g + 4 * hi;
                u32x2 w; w.x = pk2(o[d][4 * g], o[d][4 * g + 1]); w.y = pk2(o[d][4 * g + 2], o[d][4 * g + 3]);
                *(GAS u32x2*)(op + dv0) = w;
            }
    }
}

template <int MODE, bool GUARDED>
__device__ __forceinline__ bool attn_unit_q(lptr lds, const Unit& U, const Tensors& T, int wv) {
    typedef Cfg<MODE> C;
    constexpr int KB = C::NKCH * 1024, VB = C::DV * 128, NKS = C::DQK / 16, ND = C::DV / 32;
    constexpr int NQK = 2 * NKS, NPV = 4 * ND;
    constexpr int EA = GUARDED ? 0 : ((MODE == MLA) ? 18 : 8);
    const int tid = opaque_tid(wv), lane = tid & 63, r32 = lane & 31, hi = lane >> 5; const int wid = __builtin_amdgcn_readfirstlane(tid >> 6);
    const int br = (MODE == DIFF) ? (wid >> 2) : 0;
    const int wq = (MODE == DIFF) ? (wid & 3) : wid;
    const int NT = U.nlat + 4;
#define TROW(j) ((j) < U.nlat ? U.lat_row0 + 64 * (j) : U.ctx_row0 + 64 * ((j) - U.nlat))
#define SBAR() __builtin_amdgcn_sched_barrier(0)
    issue_k<MODE>(lds, 0, TROW(0), T, U.head, wid, lane);
    issue_k<MODE>(lds, KB, TROW(1), T, U.head, wid, lane);
    issue_k<MODE>(lds, 2 * KB, TROW(2), T, U.head, wid, lane);
    issue_v<MODE>(lds, 3 * KB, TROW(0), T, U.head, wid, lane);
    bf16x8 qf[NKS];
    {
        const size_t qrow = (size_t)(U.qrow0 + wq * 32 + r32);
        const bf16_t* qp;
        if (MODE == MLA) qp = T.q + qrow * 768 + U.head * 96 + hi * 8;
        else qp = T.q + qrow * 3072 + U.head * 128 + br * 64 + hi * 8;
#pragma unroll
        for (int ks = 0; ks < NKS; ++ks) qf[ks] = *(const GAS bf16x8*)(qp + ks * 16);
    }
    f32x16 o[ND];
#pragma unroll
    for (int d = 0; d < ND; ++d) o[d] = f32x16{};
    float mref = 0.f, mtrue = -INFINITY, l = 0.f; bool general = false;
    constexpr float GUARD = 64.0f;
    const int x15 = r32 & 15, q4 = (lane & 15) >> 2;
    const int koff = (MODE == DIFF) ? (r32 * 256 + ((br ^ (x15 >> 3)) * 128) + ((hi ^ (x15 & 1)) * 16)) : (hi * 1024 + r32 * 16);
    const int kx = (x15 >> 1) & 3;
    const int voff = (MODE == DIFF) ? ((4 * hi + q4) * 256 + ((lane >> 4) & 1) * 32 + (lane & 3) * 8) : (((lane >> 4) & 1) * 32 + (lane & 3) * 8 + (4 * hi + q4) * 64);
    f32x16 sA0, sA1, sB0, sB1;
    u32x4 pA[4], pB[4];
    float alpha = 1.f, negmu = 0.f; bool need = false; float psa = 0.f, psb = 0.f;
#define KFRAG(KBUF, i) ((MODE == DIFF) ? *(const LAS bf16x8*)(lds + (KBUF) + koff + ((((i) >> 1) ^ kx) * 32) + ((i) & 1) * 8192) : *(const LAS bf16x8*)(lds + (KBUF) + koff + ((i) >> 1) * 2048 + ((i) & 1) * 512))
#define EXPS(E0, E1, sc0, sc1, pkn) do { _Pragma("unroll") for (int e = (E0); e < (E1); ++e) { float p_; if (e < 16) { p_ = __builtin_amdgcn_exp2f(sc0[e & 15]); sc0[e & 15] = p_; } else { p_ = __builtin_amdgcn_exp2f(sc1[e & 15]); sc1[e & 15] = p_; } \
            if (e & 1) { psb += p_; const float q_ = (e < 16) ? sc0[(e - 1) & 15] : sc1[(e - 1) & 15]; unsigned w_ = pk2(q_, p_); asm volatile("" : "+v"(w_), "+v"(psa), "+v"(psb));   pkn[e >> 3][(e >> 1) & 3] = w_; } else psa += p_; } } while (0)
#define BLOCK_A(KBUF, DOMAX, n0, n1, sc0, sc1, pkn, DOEXPA) do { \
        bf16x8 kf_[3]; kf_[0] = KFRAG(KBUF, 0); kf_[1] = KFRAG(KBUF, 1); SBAR(); \
        _Pragma("unroll") for (int i = 0; i < NQK; ++i) { \
            if (i + 2 < NQK) kf_[(i + 2) % 3] = KFRAG(KBUF, i + 2); \
            if ((i & 1) == 0) n0 = __builtin_amdgcn_mfma_f32_32x32x16_bf16(kf_[i % 3], qf[i >> 1], (i < 2) ? f32x16{} : n0, 0, 0, 0); \
            else              n1 = __builtin_amdgcn_mfma_f32_32x32x16_bf16(kf_[i % 3], qf[i >> 1], (i < 2) ? f32x16{} : n1, 0, 0, 0); \
            if (GUARDED && DOMAX) { _Pragma("unroll") for (int e = (i * 32) / NQK; e < ((i + 1) * 32) / NQK; ++e) { const float x_ = (e < 16) ? sc0[e & 15] : sc1[e & 15]; if (e & 1) mb = fmaxf(mb, x_); else ma = fmaxf(ma, x_); } } \
            if (DOEXPA && EA > 0) EXPS((i * EA) / NQK, ((i + 1) * EA) / NQK, sc0, sc1, pkn); \
            SBAR(); } \
        if (DOEXPA && EA > 0) { l += psa + psb; psa = 0.f; psb = 0.f; } } while (0)
#define DECIDE() do { if (!GUARDED) break; float mt_ = fmaxf(ma, mb); mt_ = fmaxf(mt_, xshfl<32>(mt_)); mtrue = fmaxf(mtrue, mt_); \
        need = __builtin_amdgcn_ballot_w64((mt_ - mref > GUARD) || (mtrue - mref < -GUARD)) != 0ull; alpha = 1.f; \
        if (need) { const float mn_ = (mtrue == -INFINITY) ? mref : mtrue; alpha = __builtin_amdgcn_exp2f(fminf(mref - mn_, 126.0f)); mref = mn_; l *= alpha; general = true; } \
        negmu = -mref; } while (0)
#define VFRAG(DST, VBUF, i) do { const lptr vp_ = (MODE == DIFF) ? (lds + (VBUF) + voff + ((((i) >> 2) ^ q4) * 64) + ((i) & 3) * 4096) : (lds + (VBUF) + voff + ((i) >> 2) * 4096 + ((i) & 3) * 1024);     const s16x4 lo_ = vtr(vp_), hh_ = vtr(vp_ + ((MODE == DIFF) ? 2048 : 512)); \
        DST = (bf16x8){lo_[0], lo_[1], lo_[2], lo_[3], hh_[0], hh_[1], hh_[2], hh_[3]}; } while (0)
#define BLOCK_B(VBUF, DOPV, DOEXP, sc0, sc1, pk, pkn, ELO) do { \
        if (GUARDED && DOEXP && general) { _Pragma("unroll") for (int e = 0; e < 16; ++e) { sc0[e] += negmu; sc1[e] += negmu; } }     \
        if (DOPV) { bf16x8 vf_[3]; VFRAG(vf_[0], VBUF, 0); VFRAG(vf_[1], VBUF, 1); SBAR(); \
            _Pragma("unroll") for (int i = 0; i < NPV; ++i) { \
                if (i + 2 < NPV) VFRAG(vf_[(i + 2) % 3], VBUF, i + 2); \
                o[i >> 2] = __builtin_amdgcn_mfma_f32_32x32x16_bf16(vf_[i % 3], __builtin_bit_cast(bf16x8, pk[i & 3]), o[i >> 2], 0, 0, 0); \
                if (DOEXP) EXPS((ELO) + (i * (32 - (ELO))) / NPV, (ELO) + ((i + 1) * (32 - (ELO))) / NPV, sc0, sc1, pkn); \
                SBAR(); } } \
        else if (DOEXP) EXPS((ELO), 32, sc0, sc1, pkn); \
        if (DOEXP) { l += psa + psb; psa = 0.f; psb = 0.f; } } while (0)
#define RESCALE_O() do { if (GUARDED && need) { _Pragma("unroll") for (int d = 0; d < ND; ++d) _Pragma("unroll") for (int r = 0; r < 16; ++r) o[d][r] *= alpha; } } while (0)
    constexpr int NDMA = (C::NKCH + 7) / 8 + C::DV / 64;
#define WAIT_BAR_KEEP() do { if (NDMA == 4) asm volatile("s_waitcnt vmcnt(4) lgkmcnt(0)\n\ts_barrier" ::: "memory"); else asm volatile("s_waitcnt vmcnt(3) lgkmcnt(0)\n\ts_barrier" ::: "memory"); } while (0)
#define WAIT_BAR_ALL() asm volatile("s_waitcnt vmcnt(0) lgkmcnt(0)\n\ts_barrier" ::: "memory")
    if (wid >= 4) __builtin_amdgcn_s_setprio(1);
    WAIT_BAR_ALL();
    { float ma = -INFINITY, mb = -INFINITY; (void)ma; (void)mb; BLOCK_A(0, false, sA0, sA1, sA0, sA1, pA, false); }
    WAIT_BAR_ALL();
    int kn = KB;
#define VSLOT(t) (3 * KB + (((t) & 3) * VB))
#define KNEXT() do { kn = (kn == 2 * KB) ? 0 : kn + KB; } while (0)
#define ISSUE(j_) do { const int kfree = (kn == 0) ? 2 * KB : kn - KB; if ((j_) + 3 < NT) issue_k<MODE>(lds, kfree, TROW((j_) + 3), T, U.head, wid, lane); \
        issue_v<MODE>(lds, VSLOT((j_) + 1), TROW((j_) + 1), T, U.head, wid, lane); } while (0)
#define ENDW(j_) do { if ((j_) + 3 < NT) WAIT_BAR_KEEP(); else WAIT_BAR_ALL(); } while (0)
    if (wid < 4) {
        {
            float ma = -INFINITY, mb = -INFINITY;
            BLOCK_A(kn, true, sB0, sB1, sA0, sA1, pA, true);
            issue_k<MODE>(lds, 0, TROW(3), T, U.head, wid, lane); issue_v<MODE>(lds, VSLOT(1), TROW(1), T, U.head, wid, lane);
            DECIDE();
            BLOCK_B(0, false, true, sA0, sA1, pB, pA, EA);
            WAIT_BAR_KEEP(); KNEXT();
        }
#define STEP1(j_, N0, N1, SC0, SC1, PK, PKN) do { float ma = -INFINITY, mb = -INFINITY; \
            BLOCK_A(kn, true, N0, N1, SC0, SC1, PKN, true); ISSUE(j_); DECIDE(); BLOCK_B(VSLOT((j_) - 1), true, true, SC0, SC1, PK, PKN, EA); RESCALE_O(); ENDW(j_); KNEXT(); } while (0)
        for (int j = 1; j + 1 < NT; j += 2) { STEP1(j, sA0, sA1, sB0, sB1, pA, pB); STEP1(j + 1, sB0, sB1, sA0, sA1, pB, pA); }
#undef STEP1
        {
            float ma = -INFINITY, mb = -INFINITY;
            if (GUARDED) {
#pragma unroll
                for (int e = 0; e < 16; ++e) { ma = fmaxf(ma, sB0[e]); mb = fmaxf(mb, sB1[e]); } }
            DECIDE();
            BLOCK_B(VSLOT(NT - 2), true, true, sB0, sB1, pA, pB, 0);
            RESCALE_O();
            BLOCK_B(VSLOT(NT - 1), true, false, sB0, sB1, pB, pA, 0);
        }
    } else {
        float mcar;
        {
            float ma = -INFINITY, mb = -INFINITY;
            issue_k<MODE>(lds, 0, TROW(3), T, U.head, wid, lane); issue_v<MODE>(lds, VSLOT(1), TROW(1), T, U.head, wid, lane);
            BLOCK_A(kn, true, sB0, sB1, sA0, sA1, pA, true);
            mcar = fmaxf(ma, mb);
            WAIT_BAR_KEEP(); KNEXT();
        }
#define STEP2(j_, SC0, SC1, PK, PKN, SM0, SM1, DOPV) do { float ma = mcar, mb = mcar; \
            ISSUE(j_); DECIDE(); BLOCK_B(VSLOT((j_) - 2), DOPV, true, SC0, SC1, PK, PKN, EA); RESCALE_O(); \
            ma = -INFINITY; mb = -INFINITY; BLOCK_A(kn, true, SC0, SC1, SM0, SM1, PK, true); mcar = fmaxf(ma, mb); ENDW(j_); KNEXT(); } while (0)
        STEP2(1, sA0, sA1, pB, pA, sB0, sB1, false);
        STEP2(2, sB0, sB1, pA, pB, sA0, sA1, true);
        for (int j = 3; j + 1 < NT; j += 2) { STEP2(j, sA0, sA1, pB, pA, sB0, sB1, true); STEP2(j + 1, sB0, sB1, pA, pB, sA0, sA1, true); }
#undef STEP2
        {
            float ma = mcar, mb = mcar;
            DECIDE();
            BLOCK_B(VSLOT(NT - 3), true, true, sA0, sA1, pB, pA, EA);
            RESCALE_O();
            ma = -INFINITY; mb = -INFINITY;
            if (GUARDED) {
#pragma unroll
                for (int e = 0; e < 16; ++e) { ma = fmaxf(ma, sB0[e]); mb = fmaxf(mb, sB1[e]); } }
            DECIDE();
            BLOCK_B(VSLOT(NT - 2), true, true, sB0, sB1, pA, pB, 0);
            RESCALE_O();
            BLOCK_B(VSLOT(NT - 1), true, false, sB0, sB1, pB, pA, 0);
        }
    }
#undef VSLOT
#undef KNEXT
#undef ISSUE
#undef ENDW
    __builtin_amdgcn_s_setprio(0);
    WAIT_BAR_ALL();
#undef WAIT_BAR_KEEP
#undef WAIT_BAR_ALL
#undef TROW
#undef SBAR
#undef KFRAG
#undef BLOCK_A
#undef DECIDE
#undef VFRAG
#undef EXPS
#undef BLOCK_B
#undef RESCALE_O
    l += xshfl<32>(l);
    if (!GUARDED) {
        float oa = 0.f;
#pragma unroll
        for (int d = 0; d < ND; ++d)
#pragma unroll
            for (int r = 0; r < 16; ++r) oa += __builtin_fabsf(o[d][r]);
        const bool badl = !(l > 0x1p-100f && l < 0x1p100f) || !(oa < 0x1p120f);
        LAS unsigned* flg = (LAS unsigned*)(lds + LDS_MISC + 4608);
        const bool wbad = __builtin_amdgcn_ballot_w64(badl) != 0ull;
        if (lane == 0) flg[wid] = wbad ? 1u : 0u;
        __syncthreads();
        unsigned anyb = 0u;
#pragma unroll
        for (int w = 0; w < 8; ++w) anyb |= flg[w];
        __syncthreads();
        if (__builtin_amdgcn_readfirstlane(anyb) != 0u) return true;
    }
    const float inv = 1.0f / l;
#pragma unroll
    for (int d = 0; d < ND; ++d)
#pragma unroll
        for (int r = 0; r < 16; ++r) o[d][r] *= inv;
    const size_t orow = (size_t)(U.qrow0 + wq * 32 + r32);
    if (MODE == DIFF) {
        LAS float* xch = (LAS float*)lds + (size_t)(wid & 3) * 4096 + lane;
        if (br == 1) {
#pragma unroll
            for (int d = 0; d < ND; ++d)
#pragma unroll
                for (int r = 0; r < 16; ++r) xch[(d * 16 + r) * 64] = o[d][r];
        }
        __syncthreads();
        if (br == 0) {
            float ss = 0.f;
#pragma unroll
            for (int d = 0; d < ND; ++d)
#pragma unroll
                for (int r = 0; r < 16; ++r) { const float v = o[d][r] - T.lam * xch[(d * 16 + r) * 64]; o[d][r] = v; ss += v * v; }
            ss += xshfl<32>(ss);
            const float rs = __builtin_amdgcn_rsqf(ss * (1.0f / 128.0f) + DIFF_EPS) * T.post;
            bf16_t* op = T.o + orow * 1024 + U.head * 128;
#pragma unroll
            for (int d = 0; d < ND; ++d)
#pragma unroll
                for (int g = 0; g < 4; g += 2) {
                    u32x2 wa, wb;
                    { const int dv0 = 32 * d + 8 * g + 4 * hi; const f32x4 gn = *(const GAS f32x4*)(T.subln + dv0);
                      wa.x = pk2(o[d][4 * g] * rs * gn[0], o[d][4 * g + 1] * rs * gn[1]); wa.y = pk2(o[d][4 * g + 2] * rs * gn[2], o[d][4 * g + 3] * rs * gn[3]); }
                    { const int dv1 = 32 * d + 8 * (g + 1) + 4 * hi; const f32x4 gn = *(const GAS f32x4*)(T.subln + dv1);
                      wb.x = pk2(o[d][4 * g + 4] * rs * gn[0], o[d][4 * g + 5] * rs * gn[1]); wb.y = pk2(o[d][4 * g + 6] * rs * gn[2], o[d][4 * g + 7] * rs * gn[3]); }
                    const auto rx = __builtin_amdgcn_permlane32_swap(wa.x, wb.x, false, false); const auto ry = __builtin_amdgcn_permlane32_swap(wa.y, wb.y, false, false);
                    *(GAS u32x4*)(op + 32 * d + 8 * g + 8 * hi) = (u32x4){rx[0], ry[0], rx[1], ry[1]};
                }
        }
        __syncthreads();
    } else {
        bf16_t* op = T.o + orow * 1024 + 512 + U.head * 64;
#pragma unroll
        for (int d = 0; d < ND; ++d)
#pragma unroll
            for (int g = 0; g < 4; g += 2) {
                u32x2 wa, wb; wa.x = pk2(o[d][4 * g], o[d][4 * g + 1]); wa.y = pk2(o[d][4 * g + 2], o[d][4 * g + 3]); wb.x = pk2(o[d][4 * g + 4], o[d][4 * g + 5]); wb.y = pk2(o[d][4 * g + 6], o[d][4 * g + 7]);
                const auto rx = __builtin_amdgcn_permlane32_swap(wa.x, wb.x, false, false); const auto ry = __builtin_amdgcn_permlane32_swap(wa.y, wb.y, false, false);
                *(GAS u32x4*)(op + 32 * d + 8 * g + 8 * hi) = (u32x4){rx[0], ry[0], rx[1], ry[1]};
            }
    }
    return false;
}
}

#define LDS_WAIT() asm volatile("s_waitcnt lgkmcnt(0)" ::: "memory")
template <class F> __device__ __forceinline__ void tr_generic_item(const F& f, int Kpad, bf16_t* WT, LAS float* scr, int kb, int nb, int lane) {
    const int k0 = 64 * kb, n0 = 32 * nb;
    float fv[32];
#pragma unroll
    for (int i = 0; i < 32; ++i) fv[i] = f(k0 + 2 * i + (lane >> 5), n0 + (lane & 31));
#pragma unroll
    for (int i = 0; i < 32; ++i) { const int kk = 2 * i + (lane >> 5); scr[kk * 33 + (lane & 31)] = fv[i]; }
    LDS_WAIT();
    const int c = lane & 7;
#pragma unroll
    for (int j = 0; j < 4; ++j) { const int n = (lane >> 3) + 8 * j; const LAS float* s = scr + (8 * c) * 33 + n;
        u32x4 o; o.x = pk2(s[0 * 33], s[1 * 33]); o.y = pk2(s[2 * 33], s[3 * 33]); o.z = pk2(s[4 * 33], s[5 * 33]); o.w = pk2(s[6 * 33], s[7 * 33]);
        *(GAS u32x4*)(WT + (size_t)(n0 + n) * Kpad + k0 + 8 * c) = o; }
    LDS_WAIT();
}
struct FWinEven { const float* W;
    __device__ __forceinline__ float operator()(int k, int n) const {
        int oc;
        if (n < 640) { const int blk = n >> 6, d = n & 63; oc = blk * 64 + (d & 1) * 32 + (d >> 1); }
        else if (n < 1152) oc = n;
        else if (n < 1184) { const int d = n - 1152; oc = 1152 + (d & 1) * 16 + (d >> 1); }
        else return 0.f;
        return W[(size_t)k * 1184 + oc];
    } };
struct FWuq { const float* W; const float* g;
    __device__ __forceinline__ float operator()(int k, int n) const {
        const int h = n / 96, d = n - h * 96; int oc;
        if (d < 64) oc = h * 96 + d; else { const int dd = d - 64; oc = h * 96 + 64 + (dd & 1) * 16 + (dd >> 1); }
        return W[(size_t)k * 768 + oc] * g[k];
    } };
struct FWukv { const float* W; const float* g;
    __device__ __forceinline__ float operator()(int k, int n) const { return k < 128 ? W[(size_t)k * 1024 + n] * g[k] : 0.f; } };
struct FPlain { const float* W; int N;
    __device__ __forceinline__ float operator()(int k, int n) const { return W[(size_t)k * N + n]; } };
struct FWinOdd { const float* W;
    __device__ __forceinline__ float operator()(int k, int n) const {
        int oc = n; if (n < 2048) { const int blk = n >> 6, d = n & 63; oc = blk * 64 + (d & 1) * 32 + (d >> 1); }
        return W[(size_t)k * 3072 + oc];
    } };
__device__ __forceinline__ void tr_expert_item(int item, LAS float* scr, int lane, const float* w1, const float* w3, const float* w2, bf16_t* W13, bf16_t* W2T) {
    const int q = lane & 15, kr = lane >> 4;
    bf16_t* dst; int Kd, k0, n0;
    if (item < 32768) {
        const int le = item >> 8, kb = (item >> 4) & 15, nb = item & 15; k0 = kb * 64; n0 = nb * 64; Kd = 1024;
        const float* src = ((q < 8) ? w1 : w3) + (size_t)le * 1024 * 512 + (n0 >> 1) + 4 * (q & 7);
        f32x4 v[16];
#pragma unroll
        for (int i = 0; i < 16; ++i) v[i] = *(const GAS f32x4*)(src + (size_t)(k0 + 4 * i + kr) * 512);
#pragma unroll
        for (int i = 0; i < 16; ++i) { const int kk = 4 * i + kr; LAS float* p = scr + kk * 65 + 8 * (q & 7) + (q >> 3); p[0] = v[i][0]; p[2] = v[i][1]; p[4] = v[i][2]; p[6] = v[i][3]; }
        dst = W13 + (size_t)le * 1024 * 1024;
    } else {
        const int it = item - 32768, le = it >> 7, kb = (it >> 4) & 7, nb = it & 15; k0 = kb * 64; n0 = nb * 64; Kd = 512;
        const float* src = w2 + (size_t)le * 512 * 1024 + n0 + 4 * q;
        f32x4 v[16];
#pragma unroll
        for (int i = 0; i < 16; ++i) v[i] = *(const GAS f32x4*)(src + (size_t)(k0 + 4 * i + kr) * 1024);
#pragma unroll
        for (int i = 0; i < 16; ++i) { const int kk = 4 * i + kr; LAS float* p = scr + kk * 65 + 4 * q; p[0] = v[i][0]; p[1] = v[i][1]; p[2] = v[i][2]; p[3] = v[i][3]; }
        dst = W2T + (size_t)le * 1024 * 512;
    }
    LDS_WAIT();
    const int c = lane & 7;
#pragma unroll
    for (int j = 0; j < 8; ++j) { const int n = (lane >> 3) + 8 * j; const LAS float* s = scr + (8 * c) * 65 + n;
        u32x4 o; o.x = pk2(s[0 * 65], s[1 * 65]); o.y = pk2(s[2 * 65], s[3 * 65]); o.z = pk2(s[4 * 65], s[5 * 65]); o.w = pk2(s[6 * 65], s[7 * 65]);
        *(GAS u32x4*)(dst + (size_t)(n0 + n) * Kd + k0 + 8 * c) = o; }
    LDS_WAIT();
}

__device__ __forceinline__ void prologue_a(lptr lds, int vcu, int G, int wv) {
    const int tid = opaque_tid(wv), lane = tid & 63, wave = __builtin_amdgcn_readfirstlane(tid >> 6);
    unsigned char* ws = parg(lds, 31);
    const int gw = vcu * NWAVES + wave, NGW = G * NWAVES;
    LAS float* scr = (LAS float*)(lds + wave * 16640);
    for (int it = gw; it < 49152; it += NGW) tr_expert_item(it, scr, lane, pin(lds, 26), pin(lds, 27), pin(lds, 28), (bf16_t*)(ws + WS_W13), (bf16_t*)(ws + WS_W2T));
    for (int it = gw; it < 6848; it += NGW) {
        const int j = it / 3424; int r = it - j * 3424;
        if (r < 640) { FWinEven f{pin(lds, 8) + (size_t)j * 1024 * 1184}; tr_generic_item(f, 1024, (bf16_t*)(ws + WS_WINE) + (size_t)j * 1280 * 1024, scr, r / 40, r % 40, lane); continue; } r -= 640;
        if (r < 96) { FWuq f{pin(lds, 10) + (size_t)j * 256 * 768, pin(lds, 9) + j * 256}; tr_generic_item(f, 256, (bf16_t*)(ws + WS_WUQ) + (size_t)j * 768 * 256, scr, r / 24, r % 24, lane); continue; } r -= 96;
        if (r < 128) { FWukv f{pin(lds, 12) + (size_t)j * 128 * 1024, pin(lds, 11) + j * 128}; tr_generic_item(f, 256, (bf16_t*)(ws + WS_WUKV) + (size_t)j * 1024 * 256, scr, r / 32, r % 32, lane); continue; } r -= 128;
        if (r < 512) { FPlain f{pin(lds, 14) + (size_t)j * 1024 * 1024, 1024}; tr_generic_item(f, 1024, (bf16_t*)(ws + WS_WOUTE) + (size_t)j * 1024 * 1024, scr, r / 32, r % 32, lane); continue; } r -= 512;
        if (r < 1536) { FWinOdd f{pin(lds, 15) + (size_t)j * 1024 * 3072}; tr_generic_item(f, 1024, (bf16_t*)(ws + WS_WINO) + (size_t)j * 3072 * 1024, scr, r / 96, r % 96, lane); continue; } r -= 1536;
        { FPlain f{pin(lds, 21) + (size_t)j * 1024 * 1024, 1024}; tr_generic_item(f, 1024, (bf16_t*)(ws + WS_WOUTO) + (size_t)j * 1024 * 1024, scr, r / 32, r % 32, lane); }
    }
    {
        const int gt = gw * 64 + lane;
        if (gt < 512) ((unsigned*)(ws + WS_H + (size_t)ZROW * DM * 2))[gt] = 0u;
    }
    {
        float* modp = (float*)(ws + WS_MODP);
        const float* adaw = pin(lds, 6); const float* cvec = pin(lds, 1); const float* cctx = pin(lds, 3);
        __syncthreads();
        LAS float* sil = (LAS float*)lds;
        for (int i = tid; i < 17 * 1024; i += NTHREADS) { const int r = i >> 10, k = i & 1023; const float cv = (r < 16) ? cvec[r * 1024 + k] : cctx[k]; sil[k * 17 + r] = cv / (1.f + __expf(-cv)); }
        __syncthreads();
        for (int it = gw; it < 1536; it += NGW) {
            const int kq = it / 384, rem = it - kq * 384, l = rem / 96, nb = rem - l * 96; const int n = nb * 64 + lane;
            const float* w = adaw + ((size_t)l * 1024 + kq * 256) * 6144 + n;
            float acc[17];
#pragma unroll
            for (int r = 0; r < 17; ++r) acc[r] = 0.f;
#pragma unroll 8
            for (int k = 0; k < 256; ++k) {
                const float wv = w[(size_t)k * 6144];
                const LAS float* sp = sil + (kq * 256 + k) * 17;
#pragma unroll
                for (int r = 0; r < 17; ++r) acc[r] += sp[r] * wv;
            }
#pragma unroll
            for (int r = 0; r < 17; ++r) modp[(((size_t)kq * DEPTH + l) * 17 + r) * 6144 + n] = acc[r];
        }
    }
}
__device__ __forceinline__ void prologue_b(lptr lds, int vcu, int G, int wv) {
    const int tid = opaque_tid(wv), lane = tid & 63, wave = __builtin_amdgcn_readfirstlane(tid >> 6);
    const int gt = (vcu * NWAVES + wave) * 64 + lane, NGT = G * NWAVES * 64;
    unsigned char* ws = parg(lds, 31); const float* adab = pin(lds, 7);
    const float* modp = (const float*)(ws + WS_MODP); float* mod = (float*)(ws + WS_MOD);
    for (int i = gt; i < (int)MOD_ELEMS; i += NGT) { const int l = i / (17 * 6144), n = i % 6144;
        mod[i] = ((modp[i] + modp[MOD_ELEMS + i]) + (modp[2 * MOD_ELEMS + i] + modp[3 * MOD_ELEMS + i])) + adab[l * 6144 + n]; }
}

__device__ __forceinline__ void phase_norm_mix(lptr lds, int l, int vcu, int G, int wv, bool dry = false) {
    const int tid = opaque_tid(wv), lane = tid & 63, wave = __builtin_amdgcn_readfirstlane(tid >> 6);
    unsigned char* ws = parg(lds, 31); float* outp = (float*)parg(lds, 30); const float* xin = pin(lds, 0); const float* cin = pin(lds, 2);
    const float* mod = (const float*)(ws + WS_MOD);
    const int* tokd = (const int*)(ws + WS_TOKD); const bf16_t* yb = (const bf16_t*)(ws + WS_BIG + BG_YB);
    bf16_t* H = (bf16_t*)(ws + WS_H);
    bf16_t* xb = (bf16_t*)(ws + WS_XB);
    const int nrows = (l == DEPTH) ? NLAT : MTOT;
    const float* gain = (l == DEPTH) ? pin(lds, 29) : pin(lds, 4) + l * DM;
    const int RPW = nrows / G, row_lo = vcu * RPW; const int r_lo = mod_r(row_lo), r_hi = mod_r(row_lo + RPW - 1);
    LAS float* tab = (LAS float*)lds;
    for (int i = tid; i < 2048; i += NTHREADS) { const int t = i >> 10, c = i & 1023; const int r = t ? r_hi : r_lo;
        if (l > 0) tab[t * 3072 + c] = mod[((size_t)(l - 1) * 17 + r) * 6144 + 5 * 1024 + c];
        if (l < DEPTH) { const float* sh = mod + ((size_t)l * 17 + r) * 6144; tab[t * 3072 + 1024 + c] = gain[c] * (1.0f + sh[1024 + c]); tab[t * 3072 + 2048 + c] = sh[c]; }
        else tab[t * 3072 + 1024 + c] = gain[c]; }
    __syncthreads();
    const bool docomb = (l > 0);
    for (int k = wave; k < RPW / 2; k += NWAVES) {
        f32x4 v[2][4]; int dd[2][2]; const LAS float* tb[2];
#pragma unroll
        for (int q = 0; q < 2; ++q) {
            const int row = row_lo + 2 * k + q;
            tb[q] = tab + ((mod_r(row) == r_lo) ? 0 : 3072) + 4 * lane;
            if (docomb) { dd[q][0] = tokd[row * 2]; dd[q][1] = tokd[row * 2 + 1]; }
            if (l == 0) {
                const float* xs = (row < NLAT ? xin + (size_t)row * DM : cin + (size_t)(row - NLAT) * DM);
#pragma unroll
                for (int j = 0; j < 4; ++j) v[q][j] = *(const GAS f32x4*)(xs + 256 * j + 4 * lane);
            } else {
                u32x2 t[4];
#pragma unroll
                for (int j = 0; j < 4; ++j) t[j] = *(const GAS u32x2*)(xb + (size_t)row * DM + 256 * j + 4 * lane);
#pragma unroll
                for (int j = 0; j < 4; ++j) v[q][j] = (f32x4){bflo(t[j].x), bfhi(t[j].x), bflo(t[j].y), bfhi(t[j].y)};
            }
        }
        if (docomb) {
            u32x2 ya[2][4], yb2[2][4];
#pragma unroll
            for (int q = 0; q < 2; ++q)
#pragma unroll
                for (int j = 0; j < 4; ++j) { ya[q][j] = *(const GAS u32x2*)(yb + (size_t)dd[q][0] * DM + 256 * j + 4 * lane); yb2[q][j] = *(const GAS u32x2*)(yb + (size_t)dd[q][1] * DM + 256 * j + 4 * lane); }
#pragma unroll
            for (int q = 0; q < 2; ++q) {
#pragma unroll
                for (int j = 0; j < 4; ++j) {
                    const u32x2 a = ya[q][j], b = yb2[q][j];
                    const f32x4 gg = *(const LAS f32x4*)(tb[q] + 256 * j);
                    v[q][j][0] += gg[0] * (bflo(a.x) + bflo(b.x)); v[q][j][1] += gg[1] * (bfhi(a.x) + bfhi(b.x));
                    v[q][j][2] += gg[2] * (bflo(a.y) + bflo(b.y)); v[q][j][3] += gg[3] * (bfhi(a.y) + bfhi(b.y));
                }
                if (l < DEPTH && !dry) {
#pragma unroll
                    for (int j = 0; j < 4; ++j) { u32x2 w; w.x = pk2(v[q][j][0], v[q][j][1]); w.y = pk2(v[q][j][2], v[q][j][3]); *(GAS u32x2*)(xb + (size_t)(row_lo + 2 * k + q) * DM + 256 * j + 4 * lane) = w; }
                }
            }
        }
#pragma unroll
        for (int q = 0; q < 2; ++q) {
            const int row = row_lo + 2 * k + q;
            float ss = 0.f;
#pragma unroll
            for (int j = 0; j < 4; ++j) ss += (v[q][j][0] * v[q][j][0] + v[q][j][1] * v[q][j][1]) + (v[q][j][2] * v[q][j][2] + v[q][j][3] * v[q][j][3]);
            const float rs = __builtin_amdgcn_rsqf(wave_sum(ss) * (1.0f / DM) + NORM_EPS);
            if (l == DEPTH) {
                if (!dry)
#pragma unroll
                for (int j = 0; j < 4; ++j) { const f32x4 g = *(const LAS f32x4*)(tb[q] + 1024 + 256 * j); *(GAS f32x4*)(outp + (size_t)row * DM + 256 * j + 4 * lane) = v[q][j] * rs * g; }
            } else {
#pragma unroll
                for (int j = 0; j < 4; ++j) { const int c = 256 * j + 4 * lane; const f32x4 A = *(const LAS f32x4*)(tb[q] + 1024 + 256 * j), B = *(const LAS f32x4*)(tb[q] + 2048 + 256 * j);
                    const f32x4 h = v[q][j] * rs * A + B;
                    u32x2 w; w.x = pk2(h[0], h[1]); w.y = pk2(h[2], h[3]); *(GAS u32x2*)(H + (size_t)row * DM + c) = w; }
            }
        }
    }
}

constexpr int RW_STRIDE = 1028;
__device__ __forceinline__ void phase_norm_ffn_router(int l, lptr lds, int vcu, int G, int wv, bool dry = false) {
    const int tid = opaque_tid(wv), lane = tid & 63, wave = __builtin_amdgcn_readfirstlane(tid >> 6);
    unsigned char* ws = parg(lds, 31); float* outp = (float*)parg(lds, 30);
    const float* gain = pin(lds, 5) + l * DM;
    const float* bgp = pin(lds, 23) + l * 4; const float* bep = pin(lds, 25) + l * 32;
    LAS float* wl = (LAS float*)lds;
    { const float* wg = pin(lds, 22) + (size_t)l * 1024 * 4; const float* we = pin(lds, 24) + (size_t)l * 1024 * 32;
      for (int i = tid; i < 1024 * 4; i += NTHREADS) wl[(i & 3) * RW_STRIDE + (i >> 2)] = wg[i];
      for (int i = tid; i < 1024 * 32; i += NTHREADS) wl[(4 + (i & 31)) * RW_STRIDE + (i >> 5)] = we[i]; }
    LAS unsigned* hist = (LAS unsigned*)(lds + LDS_MISC + 4608);
    if (tid < 32) hist[tid] = 0u;
    __syncthreads();
    const int gw = vcu * NWAVES + wave, NGW = G * NWAVES;
    const float* mod = (const float*)(ws + WS_MOD);
    bf16_t* H = dry ? (bf16_t*)(ws + WS_END) : (bf16_t*)(ws + WS_H);
    int* toke = (int*)(ws + WS_TOKE); float* tokg = (float*)(ws + WS_TOKG); int* tokp = (int*)(ws + WS_TOKP);
    unsigned* cnt = (unsigned*)(ws + WS_CTL) + CW_CNT + l * 32 * 16;
    const int nrows = (l == DEPTH - 1) ? NLAT : MTOT;
    for (int row = gw; row < nrows; row += NGW) {
        const int r = mod_r(row);
        const float* xp = xrow_ptr(outp, ws, row);
        f32x4 v[4];
#pragma unroll
        for (int j = 0; j < 4; ++j) v[j] = *(const GAS f32x4*)(xp + 256 * j + 4 * lane);
        float ss = 0.f;
#pragma unroll
        for (int j = 0; j < 4; ++j) ss += (v[j][0] * v[j][0] + v[j][1] * v[j][1]) + (v[j][2] * v[j][2] + v[j][3] * v[j][3]);
        const float rs = __builtin_amdgcn_rsqf(wave_sum(ss) * (1.0f / DM) + NORM_EPS);
        const float* sh = mod + ((size_t)l * 17 + r) * 6144 + 3 * 1024; const float* sc = sh + 1024;
#pragma unroll
        for (int j = 0; j < 4; ++j) { const int c = 256 * j + 4 * lane; const f32x4 g = *(const GAS f32x4*)(gain + c), s0 = *(const GAS f32x4*)(sh + c), s1 = *(const GAS f32x4*)(sc + c);
            v[j] = v[j] * rs * g * (s1 + 1.0f) + s0;
            u32x2 w; w.x = pk2(v[j][0], v[j][1]); w.y = pk2(v[j][2], v[j][3]); *(GAS u32x2*)(H + (size_t)row * DM + c) = w; }
        float a[36];
        int wo = 4 * lane; asm volatile("" : "+v"(wo));
        const LAS float* wlr = wl + wo;
#pragma unroll
        for (int c = 0; c < 36; ++c) {
            float s = 0.f;
#pragma unroll
            for (int j = 0; j < 4; ++j) { const f32x4 w = *(const LAS f32x4*)(wlr + c * RW_STRIDE + 256 * j); s += (v[j][0] * w[0] + v[j][1] * w[1]) + (v[j][2] * w[2] + v[j][3] * w[3]); }
            a[c] = s;
        }
#pragma unroll
        for (int c = 0; c < 4; ++c) a[c] = wave_sum(a[c]) + bgp[c];
#define HALVE(N, MASK) _Pragma("unroll") for (int i = 0; i < (N) / 2; ++i) { const bool up = (lane & (MASK)) != 0; const float send = up ? a[4 + i] : a[4 + i + (N) / 2]; \
            const float keep = up ? a[4 + i + (N) / 2] : a[4 + i]; a[4 + i] = keep + xshfl<(MASK)>(send); }
        HALVE(32, 32) HALVE(16, 16) HALVE(8, 8) HALVE(4, 4) HALVE(2, 2)
#undef HALVE
        float ev = a[4] + xshfl<1>(a[4]);
        ev += bep[lane >> 1];
        int grp = 0; float gm = a[0];
#pragma unroll
        for (int c = 1; c < 4; ++c) if (a[c] > gm) { gm = a[c]; grp = c; }
        float gs = 0.f;
#pragma unroll
        for (int c = 0; c < 4; ++c) gs += __expf(a[c] - gm);
        const float pgrp = 1.0f / gs;
        float el[8];
        const int grpu = __builtin_amdgcn_readfirstlane(grp);
#pragma unroll
        for (int i = 0; i < 8; ++i) el[i] = __builtin_bit_cast(float, __builtin_amdgcn_readlane(__builtin_bit_cast(int, ev), (grpu * 8 + i) * 2));
        int i1 = 0; float m1 = el[0];
#pragma unroll
        for (int i = 1; i < 8; ++i) if (el[i] > m1) { m1 = el[i]; i1 = i; }
        int i2 = -1; float m2 = -INFINITY;
#pragma unroll
        for (int i = 0; i < 8; ++i) if (i != i1 && el[i] > m2) { m2 = el[i]; i2 = i; }
        const float e2 = __expf(m2 - m1);
        const float g1 = pgrp / (1.0f + e2), g2 = pgrp * e2 / (1.0f + e2);
        if (lane == 0 && (!dry || g1 < -1.0f)) {
            const int ea = grp * 8 + i1, eb = grp * 8 + i2;
            const unsigned pa = __hip_atomic_fetch_add(hist + ea, 1u, __ATOMIC_RELAXED, __HIP_MEMORY_SCOPE_WORKGROUP), pb = __hip_atomic_fetch_add(hist + eb, 1u, __ATOMIC_RELAXED, __HIP_MEMORY_SCOPE_WORKGROUP);
            toke[row * 2] = ea; toke[row * 2 + 1] = eb; tokg[row * 2] = g1; tokg[row * 2 + 1] = g2; tokp[row * 2] = (int)pa; tokp[row * 2 + 1] = (int)pb;
        }
    }
    __syncthreads();
    if (tid < 32 && !dry) ((int*)(ws + WS_WGB))[vcu * 32 + tid] = (int)atomicAdd(cnt + tid * 16, hist[tid]);
}

constexpr int RW2_STRIDE = 2080, RW2_TAB = 48 * RW2_STRIDE, RW2_SCR = RW2_TAB + 16384;
__device__ __forceinline__ void phase_router_mfma(int l, lptr lds, int vcu, int G, int wv) {
    const int tid = opaque_tid(wv), lane = tid & 63, wave = __builtin_amdgcn_readfirstlane(tid >> 6);
    unsigned char* ws = parg(lds, 31); float* outp = (float*)parg(lds, 30);
    const float* gain = pin(lds, 5) + l * DM;
    const float* bgp = pin(lds, 23) + l * 4; const float* bep = pin(lds, 25) + l * 32;
    const float* mod = (const float*)(ws + WS_MOD);
    const int nrows = (l == DEPTH - 1) ? NLAT : MTOT;
    const int RPW = nrows / G;
    const int row_lo = vcu * RPW; const int r_lo = mod_r(row_lo), r_hi = mod_r(row_lo + RPW - 1);
    {
        const float* wg = pin(lds, 22) + (size_t)l * 1024 * 4; const float* we = pin(lds, 24) + (size_t)l * 1024 * 32;
        for (int i = tid; i < 1024 * 32; i += NTHREADS) *(LAS bf16_t*)(lds + (i & 31) * RW2_STRIDE + (i >> 5) * 2) = (bf16_t)f2bf(we[i]);
        for (int i = tid; i < 1024 * 4; i += NTHREADS) *(LAS bf16_t*)(lds + (32 + (i & 3)) * RW2_STRIDE + (i >> 2) * 2) = (bf16_t)f2bf(wg[i]);
        for (int i = tid; i < 12 * 512; i += NTHREADS) *(LAS unsigned*)(lds + (36 + i / 512) * RW2_STRIDE + (i % 512) * 4) = 0u;
        LAS float* tab = (LAS float*)(lds + RW2_TAB);
        for (int i = tid; i < 2048; i += NTHREADS) { const int t = i >> 10, c = i & 1023; const int r = t ? r_hi : r_lo;
            const float* sh = mod + ((size_t)l * 17 + r) * 6144 + 3 * 1024;
            tab[t * 2048 + c] = gain[c] * (1.0f + sh[1024 + c]); tab[t * 2048 + 1024 + c] = sh[c]; }
        if (tid < 32) ((LAS unsigned*)(lds + LDS_MISC + 4608))[tid] = 0u;
    }
    __syncthreads();
    LAS unsigned* hist = (LAS unsigned*)(lds + LDS_MISC + 4608);
    bf16_t* H = (bf16_t*)(ws + WS_H);
    const float* rs16 = (const float*)(ws + WS_RS16);
    int* toke = (int*)(ws + WS_TOKE); float* tokg = (float*)(ws + WS_TOKG); int* tokp = (int*)(ws + WS_TOKP);
    const int rl = lane & 15, kq = lane >> 4;
    LAS float* scr = (LAS float*)(lds + RW2_SCR + wave * 3136);
    for (int b = wave; b < RPW / 16; b += NWAVES) {
        const int row0 = row_lo + 16 * b, row = row0 + rl;
        const int t = (mod_r(row0) == r_lo) ? 0 : 1;
        const LAS float* tA = (const LAS float*)(lds + RW2_TAB) + t * 2048 + 8 * kq; const LAS float* tB = tA + 1024;
        float rs;
        { const f32x4 p0 = *(const GAS f32x4*)(rs16 + (size_t)row * 16), p1 = *(const GAS f32x4*)(rs16 + (size_t)row * 16 + 4), p2 = *(const GAS f32x4*)(rs16 + (size_t)row * 16 + 8), p3 = *(const GAS f32x4*)(rs16 + (size_t)row * 16 + 12);
          const f32x4 q = (p0 + p1) + (p2 + p3); rs = __builtin_amdgcn_rsqf(((q[0] + q[1]) + (q[2] + q[3])) * (1.0f / DM) + NORM_EPS); }
        const bf16_t* xp = (const bf16_t*)(ws + WS_XB) + (size_t)row * DM + 8 * kq;
        bf16_t* hp = H + (size_t)row * DM + 8 * kq;
        const LAS unsigned char* wp = lds + rl * RW2_STRIDE + 16 * kq;
        f32x4 acc0 = {0.f, 0.f, 0.f, 0.f}, acc1 = acc0, acc2 = acc0;
#pragma unroll 8
        for (int s = 0; s < 32; ++s) {
            const u32x4 xw = *(const GAS u32x4*)(xp + 32 * s);
            const f32x4 x0 = {bflo(xw.x), bfhi(xw.x), bflo(xw.y), bfhi(xw.y)}, x1 = {bflo(xw.z), bfhi(xw.z), bflo(xw.w), bfhi(xw.w)};
            const f32x4 a0 = *(const LAS f32x4*)(tA + 32 * s), a1 = *(const LAS f32x4*)(tA + 32 * s + 4), b0 = *(const LAS f32x4*)(tB + 32 * s), b1 = *(const LAS f32x4*)(tB + 32 * s + 4);
            const f32x4 h0 = x0 * rs * a0 + b0, h1 = x1 * rs * a1 + b1;
            const u32x4 hw = pack8(h0, h1);
            *(GAS u32x4*)(hp + 32 * s) = hw;
            const bf16x8 af = __builtin_bit_cast(bf16x8, hw);
            const bf16x8 w0 = *(const LAS bf16x8*)(wp + 64 * s), w1 = *(const LAS bf16x8*)(wp + 16 * RW2_STRIDE + 64 * s), w2 = *(const LAS bf16x8*)(wp + 32 * RW2_STRIDE + 64 * s);
            acc0 = __builtin_amdgcn_mfma_f32_16x16x32_bf16(af, w0, acc0, 0, 0, 0);
            acc1 = __builtin_amdgcn_mfma_f32_16x16x32_bf16(af, w1, acc1, 0, 0, 0);
            acc2 = __builtin_amdgcn_mfma_f32_16x16x32_bf16(af, w2, acc2, 0, 0, 0);
        }
#pragma unroll
        for (int j = 0; j < 4; ++j) { scr[(4 * kq + j) * 49 + rl] = acc0[j]; scr[(4 * kq + j) * 49 + 16 + rl] = acc1[j]; scr[(4 * kq + j) * 49 + 32 + rl] = acc2[j]; }
        LDS_WAIT();
        if (lane < 16) {
            const LAS float* lg = scr + lane * 49;
            float g[4];
#pragma unroll
            for (int c = 0; c < 4; ++c) g[c] = lg[32 + c] + bgp[c];
            int grp = 0; float gm = g[0];
#pragma unroll
            for (int c = 1; c < 4; ++c) if (g[c] > gm) { gm = g[c]; grp = c; }
            float gs = 0.f;
#pragma unroll
            for (int c = 0; c < 4; ++c) gs += __expf(g[c] - gm);
            const float pgrp = 1.0f / gs;
            float el[8];
#pragma unroll
            for (int i = 0; i < 8; ++i) el[i] = lg[grp * 8 + i] + bep[grp * 8 + i];
            int i1 = 0; float m1 = el[0];
#pragma unroll
            for (int i = 1; i < 8; ++i) if (el[i] > m1) { m1 = el[i]; i1 = i; }
            int i2 = -1; float m2 = -INFINITY;
#pragma unroll
            for (int i = 0; i < 8; ++i) if (i != i1 && el[i] > m2) { m2 = el[i]; i2 = i; }
            const float e2 = __expf(m2 - m1);
            const float g1 = pgrp / (1.0f + e2), g2 = pgrp * e2 / (1.0f + e2);
            const int ea = grp * 8 + i1, eb = grp * 8 + i2;
            const unsigned pa = __hip_atomic_fetch_add(hist + ea, 1u, __ATOMIC_RELAXED, __HIP_MEMORY_SCOPE_WORKGROUP), pb = __hip_atomic_fetch_add(hist + eb, 1u, __ATOMIC_RELAXED, __HIP_MEMORY_SCOPE_WORKGROUP);
            const int rr = row0 + lane;
            toke[rr * 2] = ea; toke[rr * 2 + 1] = eb; tokg[rr * 2] = g1; tokg[rr * 2 + 1] = g2; tokp[rr * 2] = (int)pa; tokp[rr * 2 + 1] = (int)pb;
        }
        LDS_WAIT();
    }
    __syncthreads();
    unsigned* cnt = (unsigned*)(ws + WS_CTL) + CW_CNT + l * 32 * 16;
    if (tid < 32) ((int*)(ws + WS_WGB))[vcu * 32 + tid] = (int)atomicAdd(cnt + tid * 16, hist[tid]);
}

__device__ __forceinline__ void phase_moe_scan(int l, lptr lds, int vcu, int G, int wv) {
    const int tid = opaque_tid(wv);
    unsigned char* ws = parg(lds, 31);
    LAS int* tile_exp = (LAS int*)(lds + LDS_MISC); LAS int* ntl = (LAS int*)(lds + LDS_MISC + 4096); LAS int* pad_start = (LAS int*)(lds + LDS_MISC + 4224); LAS int* cntl = (LAS int*)(lds + LDS_MISC + 4352);
    const unsigned* cnt = (const unsigned*)(ws + WS_CTL) + CW_CNT + l * 32 * 16;
    if (tid < 32) cntl[tid] = (int)__hip_atomic_load(cnt + tid * 16, __ATOMIC_RELAXED, __HIP_MEMORY_SCOPE_AGENT);
    __syncthreads();
    if (tid == 0) { int t = 0; for (int e = 0; e < 32; ++e) { pad_start[e] = t * 256; const int nt = (cntl[e] + 255) >> 8; for (int i = 0; i < nt; ++i) tile_exp[t + i] = e; t += nt; } ntl[0] = t; }
    __syncthreads();
    const int gt = vcu * NTHREADS + tid, NGT = G * NTHREADS;
    const int ntok = (l == DEPTH - 1) ? NLAT : MTOT;
    const int* toke = (const int*)(ws + WS_TOKE); const float* tokg = (const float*)(ws + WS_TOKG); const int* tokp = (const int*)(ws + WS_TOKP);
    int* tokd = (int*)(ws + WS_TOKD); int* slott = (int*)(ws + WS_SLOTT); float* slotg = (float*)(ws + WS_SLOTG);
    const int* wgb = (const int*)(ws + WS_WGB);
    for (int a = gt; a < 2 * ntok; a += NGT) { const int e = toke[a]; const int wgv = (a >> 1) / (ntok / G);
        const int dest = pad_start[e] + wgb[wgv * 32 + e] + tokp[a]; slott[dest] = a >> 1; slotg[dest] = tokg[a]; tokd[a] = dest; }
    for (int i = gt; i < 32 * 256; i += NGT) { const int e = i >> 8, off = i & 255; const int s = pad_start[e] + cntl[e] + off; const int end = pad_start[e] + (((cntl[e] + 255) >> 8) << 8);
        if (s < end) { slott[s] = ZROW; slotg[s] = 0.f; } }
}

struct Params { const float* in[30]; float* out; unsigned char* ws; };

__device__ __forceinline__ void moe_gemms(lptr lds, int l, int tid, int G, int bx) {
}

template <int L> __device__ __forceinline__ void layer_body(lptr lds, int wv) {
    constexpr int jj = L / 2, par = L % 2, l = L; constexpr bool last = (L == DEPTH - 1);
#define GRID_BAR() do { XcdBarrier b_; b_.bar = (unsigned*)(parg(lds, 31) + WS_CTL) + CW_BAR; b_.x = xb_xcc_id(); b_.st = (volatile LAS unsigned*)(lds + LDS_BYTES - 64); xcd_barrier(b_, wv); } while (0)
#define G   (opaque_s((int)gridDim.x))
#define bx  (opaque_s((int)blockIdx.x))
#define vcu (opaque_s((int)((blockIdx.x % 8) * (gridDim.x / 8) + blockIdx.x / 8)))
    const int tid = opaque_tid(wv);
            if (REP_ROW > 1 && l > 0) { phase_norm_mix(lds, l, vcu, G, wv, true); GRID_BAR(); }
            phase_norm_mix(lds, l, vcu, G, wv);
            GRID_BAR();
            if constexpr (par == 0) {
                for (int rep_ = 0; rep_ < REP_WIN; ++rep_)
                {
                    unsigned char* ws = parg(lds, 31);
                    pg8::GemmPlain g{(const char*)(ws + WS_H), (const char*)(ws + WS_WINE) + (size_t)jj * 1280 * 1024 * 2, 1024, 1024};
                    pg8::StaticOrder S; S.init(MTOT / 256, 5, G, bx);
                    EpiWinEven E{ws + WS_BIG, (float*)(ws + WS_RSQ), (const float*)(ws + WS_ROPE64), (const float*)(ws + WS_ROPE32), (REP_NOST && rep_ > 0)};
                    pg8::gemm_phase(lds, g, S, E, wv);
                }
                GRID_BAR();
                {
                    unsigned char* ws = parg(lds, 31);
                    pg8::GemmPlain g{(const char*)(ws + WS_BIG + BG_CQ), (const char*)(ws + WS_WUQ) + (size_t)jj * 768 * 256 * 2, 256, 256};
                    pg8::StaticOrder S; S.init(MTOT / 256, 3, G, bx);
                    EpiUq E{(bf16_t*)(ws + WS_BIG + BG_QM), (const float*)(ws + WS_RSQ), (const float*)(ws + WS_ROPE32)};
                    pg8::gemm_phase(lds, g, S, E, wv);
                }
                {
                    unsigned char* ws = parg(lds, 31);
                    pg8::GemmPlain g2{(const char*)(ws + WS_BIG + BG_CKVR), (const char*)(ws + WS_WUKV) + (size_t)jj * 1024 * 256 * 2, 256, 256};
                    pg8::StaticOrder S2; S2.init(MTOT / 256, 4, G, G - 1 - bx);
                    EpiUkv E2{(bf16_t*)(ws + WS_BIG + BG_KVM), (const float*)(ws + WS_RSQ)};
                    pg8::gemm_phase(lds, g2, S2, E2, wv);
                }
                GRID_BAR();
                for (int rep_ = 0; rep_ < REP_ATT; ++rep_) {
                {
                    unsigned char* big = parg(lds, 31) + WS_BIG; bf16_t* Hb = (bf16_t*)(parg(lds, 31) + WS_H);
                    att::Tensors Tm{(const bf16_t*)(big + BG_QM), (const bf16_t*)(big + BG_KVM), (const bf16_t*)(big + BG_CKVR), (const bf16_t*)(big + BG_KVM), Hb, nullptr, 0.f, nullptr, 0.f, 0.10206207261596575f * LOG2E};
                    LAS unsigned* redo = (LAS unsigned*)(lds + LDS_MISC + 4608 + 64);
#pragma unroll 1
                    for (int pass = 0; pass < 2; ++pass) {
#pragma unroll 1
                    for (int i = 0; i < 9; ++i) {
                        att::Unit U;
                        if (i < 8) { const int u = vcu + 256 * i, bh = u >> 4, qb = u & 15, b = bh >> 3, h = bh & 7; U = att::Unit{b * SEQ + qb * 256, b * SEQ, 64, NLAT + b * CTXL, h, 0, 0}; }
                        else { if (vcu >= 128) break; const int b = vcu >> 3, h = vcu & 7; U = att::Unit{NLAT + b * CTXL, 0, 0, NLAT + b * CTXL, h, 0, 0}; }
                        if (pass == 0) { const bool bad = att::attn_unit_q<att::MLA, false>(lds, U, Tm, wv); if (opaque_tid(wv) == 0) redo[i] = bad ? 1u : 0u; }
                        else { __syncthreads(); if (__builtin_amdgcn_readfirstlane(redo[i]) != 0u) (void)att::attn_unit_q<att::MLA, true>(lds, U, Tm, wv); }
                    }
                    }
                }
                {
                    unsigned char* big = parg(lds, 31) + WS_BIG; bf16_t* Hb = (bf16_t*)(parg(lds, 31) + WS_H);
                    att::Tensors Ts{(const bf16_t*)(big + BG_AQ), (const bf16_t*)(big + BG_AKV), nullptr, (const bf16_t*)(big + BG_AKV), Hb, pin(lds, 13) + jj * 8, 0.f, nullptr, 0.f, 1.0f};
                    LAS unsigned* redo = (LAS unsigned*)(lds + LDS_MISC + 4608 + 64);
#pragma unroll 1
                    for (int pass = 0; pass < 2; ++pass) {
#pragma unroll 1
                    for (int i = 0; i < 9; ++i) {
                        att::Unit U;
                        if (i < 8) { const int u = vcu + 256 * i, bh = u >> 4, qb = u & 15, b = bh >> 3, h = bh & 7;
                            const int q0 = qb * 256, t0 = (q0 == 0) ? 0 : (q0 / 64 - 2), t1 = (q0 / 64 + 5 > 63) ? 63 : (q0 / 64 + 5);
                            U = att::Unit{b * SEQ + q0, b * SEQ + 64 * t0, t1 - t0 + 1, NLAT + b * CTXL, h, q0, 64 * t0}; }
                        else { if (vcu < 128) break; const int u = vcu - 128, b = u >> 3, h = u & 7; U = att::Unit{NLAT + b * CTXL, 0, 0, NLAT + b * CTXL, h, 0, 0}; }
                        if (pass == 0) { const bool bad = att::attn_unit<att::SWA, false>(lds, U, Ts, wv); if (opaque_tid(wv) == 0) redo[i] = bad ? 1u : 0u; }
                        else { __syncthreads(); if (__builtin_amdgcn_readfirstlane(redo[i]) != 0u) (void)att::attn_unit<att::SWA, true>(lds, U, Ts, wv); }
                    }
                    }
                }
                }
                GRID_BAR();
                {
                    unsigned char* ws = parg(lds, 31); float* outp = (float*)parg(lds, 30); float* xctx = (float*)(ws + WS_XCTX);
                    pg8::GemmPlain g{(const char*)(ws + WS_H), (const char*)(ws + WS_WOUTE) + (size_t)jj * 1024 * 1024 * 2, 1024, 1024};
                    pg8::StaticOrder S; S.init(MTOT / 256, 4, G, bx);
                    EpiResid<(L == 0)> E{pin(lds, 0), pin(lds, 2), (bf16_t*)(ws + WS_XB), (const float*)(ws + WS_MOD) + (size_t)l * 17 * 6144, 2 * 1024, (float*)(ws + WS_RS16)};
                    pg8::gemm_phase(lds, g, S, E, wv);
                }
            } else {
                for (int rep_ = 0; rep_ < REP_WIN; ++rep_)
                {
                    unsigned char* ws = parg(lds, 31);
                    pg8::GemmPlain g{(const char*)(ws + WS_H), (const char*)(ws + WS_WINO) + (size_t)jj * 3072 * 1024 * 2, 1024, 1024};
                    pg8::StaticOrder S; S.init(MTOT / 256, 12, G, bx);
                    EpiWinOdd E{(bf16_t*)(ws + WS_BIG), (const float*)(ws + WS_ROPE64), (REP_NOST && rep_ > 0)};
                    pg8::gemm_phase(lds, g, S, E, wv);
                }
                GRID_BAR();
                for (int rep_ = 0; rep_ < REP_ATT; ++rep_)
                {
                    unsigned char* big = parg(lds, 31) + WS_BIG; bf16_t* Hb = (bf16_t*)(parg(lds, 31) + WS_H);
                    float d1 = 0.f, d2 = 0.f;
                    { const float* lq1 = pin(lds, 16) + jj * 64; const float* lk1 = pin(lds, 17) + jj * 64; const float* lq2 = pin(lds, 18) + jj * 64; const float* lk2 = pin(lds, 19) + jj * 64;
                      for (int i = 0; i < 64; ++i) { d1 += lq1[i] * lk1[i]; d2 += lq2[i] * lk2[i]; } }
                    const float lam_init = 0.8f - 0.6f * expf(-0.3f * (float)l);
                    const float lam = expf(d1) - expf(d2) + lam_init;
                    att::Tensors Td{(const bf16_t*)big, (const bf16_t*)big, nullptr, (const bf16_t*)big, Hb, nullptr, lam, pin(lds, 20) + jj * 128, 1.0f - lam_init, 0.125f * LOG2E};
                    LAS unsigned* redo = (LAS unsigned*)(lds + LDS_MISC + 4608 + 64);
#pragma unroll 1
                    for (int pass = 0; pass < 2; ++pass) {
#pragma unroll 1
                    for (int i = 0; i < 17; ++i) {
                        att::Unit U;
                        if (i < 16) { const int u = vcu + 256 * i, bh = u >> 5, qb = u & 31, b = bh >> 3, h = bh & 7; U = att::Unit{b * SEQ + qb * 128, b * SEQ, 64, NLAT + b * CTXL, h, 0, 0}; }
                        else { if (last) break; const int bh = vcu >> 1, half = vcu & 1, b = bh >> 3, h = bh & 7; U = att::Unit{NLAT + b * CTXL + half * 128, 0, 0, NLAT + b * CTXL, h, 0, 0}; }
                        if (pass == 0) { const bool bad = att::attn_unit_q<att::DIFF, false>(lds, U, Td, wv); if (opaque_tid(wv) == 0) redo[i] = bad ? 1u : 0u; }
                        else { __syncthreads(); if (__builtin_amdgcn_readfirstlane(redo[i]) != 0u) (void)att::attn_unit_q<att::DIFF, true>(lds, U, Td, wv); }
                    }
                    }
                }
                GRID_BAR();
                {
                    unsigned char* ws = parg(lds, 31); float* outp = (float*)parg(lds, 30); float* xctx = (float*)(ws + WS_XCTX);
                    pg8::GemmPlain g{(const char*)(ws + WS_H), (const char*)(ws + WS_WOUTO) + (size_t)jj * 1024 * 1024 * 2, 1024, 1024};
                    pg8::StaticOrder S; S.init((last ? NLAT : MTOT) / 256, 4, G, bx);
                    EpiResid<false> E{pin(lds, 0), pin(lds, 2), (bf16_t*)(ws + WS_XB), (const float*)(ws + WS_MOD) + (size_t)l * 17 * 6144, 2 * 1024, (float*)(ws + WS_RS16)};
                    pg8::gemm_phase(lds, g, S, E, wv);
                }
            }
            GRID_BAR();
            phase_router_mfma(l, lds, vcu, G, wv);
            GRID_BAR();
            phase_moe_scan(l, lds, vcu, G, wv);
            GRID_BAR();
            for (int rep_ = 0; rep_ < REP_MOE; ++rep_)
            {
                unsigned char* ws = parg(lds, 31);
                LAS int* tile_exp = (LAS int*)(lds + LDS_MISC); LAS int* idx = (LAS int*)(lds + 131072); const int nt = *(LAS int*)(lds + LDS_MISC + 4096); const int* slott = (const int*)(ws + WS_SLOTT);
                const int cu_ = vcu;
                { const int t_ = opaque_tid(wv); for (int i = 0; i * G + cu_ < nt * 4; ++i) { const int pm = (i * G + cu_) >> 2; if (t_ < 256) idx[i * 256 + t_] = slott[pm * 256 + t_]; } }
                __syncthreads();
                GemmMoe1 g{(const char*)(ws + WS_H), (const char*)(ws + WS_W13) + (size_t)l * NEXP * 1024 * 1024 * 2, idx, tile_exp, 1024};
                MoeSched S{tile_exp, nt, G, cu_};
                EpiSwiglu E{(bf16_t*)(ws + WS_BIG + BG_ACT)};
                pg8::gemm_phase(lds, g, S, E, wv);
            }
            GRID_BAR();
            for (int rep_ = 0; rep_ < REP_MOE; ++rep_)
            {
                unsigned char* ws = parg(lds, 31);
                LAS int* tile_exp = (LAS int*)(lds + LDS_MISC); const int nt = *(LAS int*)(lds + LDS_MISC + 4096);
                LAS float* gl = (LAS float*)(lds + 131072); const float* slotg = (const float*)(ws + WS_SLOTG); const int cu_ = vcu;
                { const int t_ = opaque_tid(wv); for (int i = 0; i * G + cu_ < nt * 4; ++i) { const int pm = (i * G + cu_) >> 2; if (t_ < 256) gl[i * 256 + t_] = slotg[pm * 256 + t_]; } }
                __syncthreads();
                GemmMoe2 g{(const char*)(ws + WS_BIG + BG_ACT), (const char*)(ws + WS_W2T) + (size_t)l * NEXP * 1024 * 512 * 2, tile_exp, 512};
                MoeSched S{tile_exp, nt, G, cu_};
                EpiMoe2 E{(bf16_t*)(ws + WS_BIG + BG_YB), gl};
                pg8::gemm_phase(lds, g, S, E, wv);
            }
            GRID_BAR();
}
#undef GRID_BAR
#undef G
#undef bx
#undef vcu
__global__ void __launch_bounds__(NTHREADS, 2) fwd_kernel(Params P) {
    extern __shared__ __attribute__((aligned(16))) unsigned char lds_raw[];
    const lptr lds = (lptr)lds_raw;
    const int tid = threadIdx.x;
    const int wv = __builtin_amdgcn_readfirstlane(tid >> 6);
#define PAD_STR2(n) #n
#define PAD_STR(n) PAD_STR2(n)
    if (CODE_PAD > 0) asm volatile(".rept " PAD_STR(CODE_PAD) "\n\ts_nop 0\n\t.endr" ::: "memory");
#define G   (opaque_s((int)gridDim.x))
#define bx  (opaque_s((int)blockIdx.x))
#define vcu (opaque_s((int)((blockIdx.x % 8) * (gridDim.x / 8) + blockIdx.x / 8)))
    volatile LAS unsigned* bst = (volatile LAS unsigned*)(lds + LDS_BYTES - 64);
    if (tid < 16) bst[tid] = 0u;
    if (tid < 32) {
        const unsigned long long* ka = (const unsigned long long*)__builtin_amdgcn_kernarg_segment_ptr();
        ((LAS unsigned long long*)(lds + LDS_PB))[tid] = ka[tid];
    }
    __syncthreads();
    (void)xcd_barrier_post((unsigned*)(parg(lds, 31) + WS_CTL) + CW_BAR, bst, wv);
#define GRID_BAR() do { XcdBarrier b_; b_.bar = (unsigned*)(parg(lds, 31) + WS_CTL) + CW_BAR; b_.x = xb_xcc_id(); b_.st = (volatile LAS unsigned*)(lds + LDS_BYTES - 64); xcd_barrier(b_, wv); } while (0)

    for (int rep_ = 0; rep_ < REP_PRO; ++rep_) prologue_a(lds, vcu, G, wv);
    GRID_BAR();
    prologue_b(lds, vcu, G, wv);
    GRID_BAR();

    layer_body<0>(lds, wv);
    layer_body<1>(lds, wv);
    layer_body<2>(lds, wv);
    layer_body<3>(lds, wv);
    phase_norm_mix(lds, DEPTH, vcu, G, wv);
#undef G
#undef bx
#undef vcu
}

extern "C" void kernel_launch(void* const* d_in, const int* in_sizes, int n_in, void* d_out, int out_size, void* d_ws, size_t ws_size, hipStream_t stream) {
    static int grid = 0;
    if (grid == 0) {
        if (n_in != 30 || out_size != NLAT * DM || ws_size < WS_END) { fprintf(stderr, "kernel_launch: unexpected shapes (n_in %d out %d ws %zu need %zu)\n", n_in, out_size, ws_size, (size_t)WS_END); grid = -1; return; }
        int dev = 0, cus = 0, per_cu = 0;
        if (hipGetDevice(&dev) != hipSuccess || hipDeviceGetAttribute(&cus, hipDeviceAttributeMultiprocessorCount, dev) != hipSuccess) { grid = -1; return; }
        if (hipFuncSetAttribute((const void*)fwd_kernel, hipFuncAttributeMaxDynamicSharedMemorySize, LDS_BYTES) != hipSuccess) { fprintf(stderr, "kernel_launch: hipFuncSetAttribute failed\n"); grid = -1; return; }
        if (hipOccupancyMaxActiveBlocksPerMultiprocessor(&per_cu, (const void*)fwd_kernel, NTHREADS, LDS_BYTES) != hipSuccess || per_cu < 1) { fprintf(stderr, "kernel_launch: occupancy query says %d\n", per_cu); }
        (void)hipGetLastError();
        grid = cus;
        if (grid % 8 != 0 || grid < 8) { fprintf(stderr, "kernel_launch: unexpected CU count %d\n", cus); grid = -1; return; }
    }
    if (grid < 0) return;
    (void)hipMemsetAsync((char*)d_ws + WS_CTL, 0, CTL_ZERO, stream);
    Params p{};
    for (int i = 0; i < 30; ++i) p.in[i] = (const float*)d_in[i];
    p.out = (float*)d_out; p.ws = (unsigned char*)d_ws;
    hipLaunchKernelGGL(fwd_kernel, dim3(grid), dim3(NTHREADS), LDS_BYTES, stream, p);
}
```

```cpp
#include <hip/hip_runtime.h>
#include <cstdio>
#include <cstdint>

#define GAS __attribute__((address_space(1)))
#ifndef NT_EPI
#define NT_EPI 0
#endif
#if NT_EPI
#define NTST(p, v) __builtin_nontemporal_store((v), (p))
#else
#define NTST(p, v) (*(p) = (v))
#endif
#define LAS __attribute__((address_space(3)))
#define GAS __attribute__((address_space(1)))
typedef unsigned short bf16_t;
typedef short bf16x8 __attribute__((ext_vector_type(8)));
typedef short s16x4 __attribute__((ext_vector_type(4)));
typedef float f32x4 __attribute__((ext_vector_type(4)));
typedef float f32x16 __attribute__((ext_vector_type(16)));
typedef unsigned u32x4 __attribute__((ext_vector_type(4)));
typedef unsigned u32x2 __attribute__((ext_vector_type(2)));
typedef LAS unsigned char* lptr;

#ifndef REP_ATT
#define REP_ATT 1
#endif
#ifndef REP_PRO
#define REP_PRO 1
#endif
#ifndef REP_MOE
#define REP_MOE 1
#endif
#ifndef REP_WIN
#define REP_WIN 1
#endif
#ifndef REP_NOST
#define REP_NOST 0
#endif
#ifndef DPH_TICKS
#define DPH_TICKS 0
#endif
#ifndef CODE_PAD
#define CODE_PAD 32
#endif
#ifndef REP_ROW
#define REP_ROW 1
#endif
constexpr int DM = 1024, NB = 16, SEQ = 4096, CTXL = 256, DEPTH = 4;
constexpr int NLAT = NB * SEQ, NCTX = NB * CTXL, MTOT = NLAT + NCTX;
constexpr int NEXP = 32, EFF = 512;
constexpr int MAXSLOTS = 147456;
constexpr int MAXTILES = MAXSLOTS / 256;
constexpr int ZROW = MTOT;
constexpr int NWAVES = 8, NTHREADS = 512;
constexpr float NORM_EPS = 1e-6f, DIFF_EPS = 1e-5f;
constexpr float LOG2E = 1.4426950408889634f;

constexpr size_t al256(size_t x) { return (x + 255) & ~(size_t)255; }
constexpr size_t WS_CTL = 0, CTL_BYTES = 1u << 20, CTL_ZERO = 131072;
constexpr size_t WS_MODP = WS_CTL + CTL_BYTES;
constexpr size_t MOD_ELEMS = (size_t)DEPTH * 17 * 6144;
constexpr size_t WS_MOD = WS_MODP + al256(4 * MOD_ELEMS * 4);
constexpr size_t WS_ROPE64 = WS_MOD + al256(MOD_ELEMS * 4);
constexpr size_t WS_ROPE32 = WS_ROPE64 + (size_t)2 * SEQ * 32 * 4;
constexpr size_t WS_WINE = WS_ROPE32 + (size_t)2 * SEQ * 16 * 4;
constexpr size_t WS_WUQ = WS_WINE + (size_t)2 * 1280 * 1024 * 2;
constexpr size_t WS_WUKV = WS_WUQ + (size_t)2 * 768 * 256 * 2;
constexpr size_t WS_WOUTE = WS_WUKV + (size_t)2 * 1024 * 256 * 2;
constexpr size_t WS_WINO = WS_WOUTE + (size_t)2 * 1024 * 1024 * 2;
constexpr size_t WS_WOUTO = WS_WINO + (size_t)2 * 3072 * 1024 * 2;
constexpr size_t WS_W13 = WS_WOUTO + (size_t)2 * 1024 * 1024 * 2;
constexpr size_t WS_W2T = WS_W13 + (size_t)DEPTH * NEXP * 1024 * 1024 * 2;
constexpr size_t WS_XCTX = WS_W2T + (size_t)DEPTH * NEXP * 1024 * 512 * 2;
constexpr size_t WS_H = WS_XCTX + (size_t)NCTX * DM * 4;
constexpr size_t WS_BIG = WS_H + al256((size_t)(MTOT + 1) * DM * 2);
constexpr size_t BIG_BYTES = (size_t)MAXSLOTS * (512 + 1024) * 2;
constexpr size_t BG_AQ = 0;
constexpr size_t BG_AKV = BG_AQ + (size_t)MTOT * 512 * 2;
constexpr size_t BG_CQ = BG_AKV + (size_t)MTOT * 256 * 2;
constexpr size_t BG_CKVR = BG_CQ + (size_t)MTOT * 256 * 2;
constexpr size_t BG_QM = BG_CKVR + (size_t)MTOT * 256 * 2;
constexpr size_t BG_KVM = BG_QM + (size_t)MTOT * 768 * 2;
static_assert(BG_KVM + (size_t)MTOT * 1024 * 2 <= BIG_BYTES, "even view fits");
static_assert((size_t)MTOT * 3072 * 2 <= BIG_BYTES, "odd view fits");
constexpr size_t BG_ACT = 0;
constexpr size_t BG_YB = (size_t)MAXSLOTS * 512 * 2;
constexpr size_t WS_RSQ = WS_BIG + BIG_BYTES;
constexpr size_t WS_TOKE = WS_RSQ + (size_t)MTOT * 8 * 4;
constexpr size_t WS_TOKG = WS_TOKE + (size_t)MTOT * 2 * 4;
constexpr size_t WS_TOKP = WS_TOKG + (size_t)MTOT * 2 * 4;
constexpr size_t WS_TOKD = WS_TOKP + (size_t)MTOT * 2 * 4;
constexpr size_t WS_SLOTT = WS_TOKD + (size_t)MTOT * 2 * 4;
constexpr size_t WS_SLOTG = WS_SLOTT + (size_t)MAXSLOTS * 4;
constexpr size_t WS_WGB = WS_SLOTG + (size_t)MAXSLOTS * 4;
constexpr size_t WS_RS16 = WS_WGB + (size_t)256 * 32 * 4;
constexpr size_t WS_XB = WS_RS16 + (size_t)MTOT * 16 * 4;
constexpr size_t WS_END = WS_XB + (size_t)MTOT * DM * 2;
constexpr int CW_BAR = 4096;
constexpr int CW_CNT = 16384;
static_assert((CW_BAR + 3456) * 4 <= 131072 && (CW_CNT + DEPTH * 32 * 16) * 4 <= 131072, "control words inside the per-call memset");

constexpr int LDS_MISC = 147456;
constexpr int LDS_BYTES = 155648;
constexpr int LDS_PB = LDS_BYTES - 1024;

__device__ __forceinline__ unsigned f2bf(float f) { unsigned u = __builtin_bit_cast(unsigned, f); return (u + 0x7fffu + ((u >> 16) & 1u)) >> 16; }
typedef float f32x2_t __attribute__((ext_vector_type(2))); typedef __bf16 bf16x2_t __attribute__((ext_vector_type(2)));
__device__ __forceinline__ unsigned pk2(float lo, float hi) { const f32x2_t v = {lo, hi}; const bf16x2_t b = __builtin_convertvector(v, bf16x2_t); return __builtin_bit_cast(unsigned, b); }
__device__ __forceinline__ float bf2f(unsigned short b) { return __builtin_bit_cast(float, ((unsigned)b) << 16); }
__device__ __forceinline__ float bflo(unsigned w) { return __builtin_bit_cast(float, w << 16); }
__device__ __forceinline__ float bfhi(unsigned w) { return __builtin_bit_cast(float, w & 0xffff0000u); }
template <int MASK> __device__ __forceinline__ float xshfl(float v) {
    if (MASK == 32) { const auto rr = __builtin_amdgcn_permlane32_swap(__builtin_bit_cast(unsigned, v), __builtin_bit_cast(unsigned, v), false, false);
        const unsigned a = rr[0], b = rr[1]; const unsigned own = __builtin_bit_cast(unsigned, v); return __builtin_bit_cast(float, a ^ b ^ own); }
    else return __builtin_bit_cast(float, __builtin_amdgcn_ds_swizzle(__builtin_bit_cast(int, v), (MASK << 10) | 0x1f));
}
__device__ __forceinline__ float wave_sum(float v) {
    v += xshfl<1>(v); v += xshfl<2>(v); v += xshfl<4>(v); v += xshfl<8>(v); v += xshfl<16>(v); v += xshfl<32>(v);
    return v;
}
__device__ __forceinline__ int opaque_tid(int wv) { int t; asm volatile("v_mbcnt_lo_u32_b32 %0, -1, 0\n\tv_mbcnt_hi_u32_b32 %0, -1, %0" : "=v"(t)); return t | (wv << 6); }
__device__ __forceinline__ int opaque_s(int x) { asm volatile("" : "+s"(x)); return x; }
__device__ __forceinline__ int crow(int r, int hi) { return (r & 3) + 8 * (r >> 2) + 4 * hi; }
__device__ __forceinline__ unsigned char* parg(lptr lds, int i) {
    int pbo = LDS_PB; asm volatile("" : "+v"(pbo));
    const LAS unsigned* p = (const LAS unsigned*)(lds + pbo) + 2 * i;
    const unsigned lo = __builtin_amdgcn_readfirstlane(p[0]), hi = __builtin_amdgcn_readfirstlane(p[1]);
    return (unsigned char*)(((unsigned long long)hi << 32) | lo);
}
__device__ __forceinline__ const float* pin(lptr lds, int i) { return (const float*)parg(lds, i); }

#define XB_TMO      128
#define XB_XCNT(j)  (256  + 64 * (j))
#define XB_XSUB(j)  (1280 + 64 * (j))
#define XB_XGEN(j)  (2304 + 64 * (j))
#define XB_TOP      3328
#define XB_TOPGEN   3392
#define XCD_BAR_WORDS 3456
#define XB_SPIN_CAP (1u << 22)
__device__ __forceinline__ unsigned xb_ld(unsigned* p)              { return __hip_atomic_load(p, __ATOMIC_RELAXED, __HIP_MEMORY_SCOPE_AGENT); }
__device__ __forceinline__ unsigned xb_add(unsigned* p, unsigned v) { return __hip_atomic_fetch_add(p, v, __ATOMIC_RELAXED, __HIP_MEMORY_SCOPE_AGENT); }
__device__ __forceinline__ unsigned xb_xcc_id() { return (unsigned)__builtin_amdgcn_s_getreg((3 << 11) | 20) & 0xFu; }
#define XB_SPIN(cond, bar) do { unsigned _sp = 0; while (cond) { __builtin_amdgcn_s_sleep(1); \
    if ((++_sp & 255u) == 0u) { if (xb_ld(&(bar)[XB_TMO])) break; if (_sp > XB_SPIN_CAP) { atomicAdd(&(bar)[XB_TMO], 1u); break; } } } } while (0)
struct XcdBarrier { unsigned* bar; unsigned x; volatile LAS unsigned* st; };
__device__ __forceinline__ XcdBarrier xcd_barrier_post(unsigned* bar, volatile LAS unsigned* st, int wv) {
    XcdBarrier b; b.bar = bar; b.x = xb_xcc_id(); b.st = st;
    if (opaque_tid(wv) == 0) (void)xb_add(&bar[XB_XCNT(b.x)], 1u);
    return b;
}
__device__ __forceinline__ void xcd_barrier_complete(unsigned* bar, unsigned x, unsigned& nloc, unsigned& nx) {
    const unsigned G = gridDim.x * gridDim.y * gridDim.z;
    unsigned sum, cnt, mine, sp = 0u;
    for (;;) {
        sum = 0u; cnt = 0u; mine = 0u;
#pragma unroll
        for (unsigned j = 0; j < 16; ++j) { const unsigned c = xb_ld(&bar[XB_XCNT(j)]); sum += c; cnt += (c > 0u) ? 1u : 0u; mine = (j == x) ? c : mine; }
        if (sum == G) break;
        __builtin_amdgcn_s_sleep(1);
        if ((++sp & 255u) == 0u) { if (xb_ld(&bar[XB_TMO])) break; if (sp > XB_SPIN_CAP) { atomicAdd(&bar[XB_TMO], 1u); break; } }
    }
    nloc = mine > 0u ? mine : 1u; nx = cnt > 0u ? cnt : 1u;
}
__device__ __forceinline__ void xcd_barrier(const XcdBarrier& b, int wv) {
    asm volatile("s_waitcnt vmcnt(0)" ::: "memory");
    __syncthreads();
    if (opaque_tid(wv) == 0) {
        unsigned* bar = b.bar;
        __builtin_amdgcn_s_waitcnt(0);
        unsigned nloc = b.st[0], nx = b.st[1];
        if (nloc == 0u) { xcd_barrier_complete(bar, b.x, nloc, nx); b.st[0] = nloc; b.st[1] = nx; }
        const unsigned old = xb_add(&bar[XB_XSUB(b.x)], 1u);
        const unsigned gen = old / nloc;
        if (old + 1u == (gen + 1u) * nloc) {
            __builtin_amdgcn_fence(__ATOMIC_RELEASE, "agent");
            asm volatile("s_waitcnt vmcnt(0)" ::: "memory");
            const unsigned og = xb_add(&bar[XB_TOP], 1u);
            const unsigned tg = og / nx;
            if (og + 1u == (tg + 1u) * nx) xb_add(&bar[XB_TOPGEN], 1u);
            else XB_SPIN(xb_ld(&bar[XB_TOPGEN]) == tg, bar);
            __builtin_amdgcn_fence(__ATOMIC_ACQUIRE, "agent");
            xb_add(&bar[XB_XGEN(b.x)], 1u);
            asm volatile("s_waitcnt vmcnt(0)" ::: "memory");
        } else {
            XB_SPIN(xb_ld(&bar[XB_XGEN(b.x)]) == gen, bar);
            __builtin_amdgcn_fence(__ATOMIC_ACQUIRE, "agent");
            asm volatile("s_waitcnt vmcnt(0)" ::: "memory");
        }
    }
    __syncthreads();
}

struct Ctx {
    lptr lds;
    int tid, lane, wave, vcu, G;
    const float* const* in;
    float* out; unsigned char* ws;
};
__device__ __forceinline__ float* xrow_ptr(float* out, unsigned char* ws, int row) {
    return row < NLAT ? out + (size_t)row * DM : (float*)(ws + WS_XCTX) + (size_t)(row - NLAT) * DM;
}
__device__ __forceinline__ int mod_r(int row) { return row < NLAT ? (row >> 12) : 16; }

namespace pg8 {
constexpr int BM = 256, BK = 64, HALF = 128, HTB = HALF * BK * 2, STAGE_BYTES = 8 * HTB;
__device__ __forceinline__ int lds_byte(int r, int c) { const int st = (r >> 4) * 2 + (c >> 5), rr = r & 15, cc = c & 31, ob = rr * 64 + cc * 2; return st * 1024 + (ob ^ (((ob >> 9) & 1) << 5)); }
__device__ __forceinline__ void stage_rc(int b, int& R, int& C) { const int st = b / 1024, sb = b % 1024, swz = sb ^ (((sb >> 9) & 1) << 5); R = (st >> 1) * 16 + swz / 64; C = (st & 1) * 32 + (swz % 64) / 2; }
__device__ __forceinline__ int perm32(int rho) { const int n = rho >> 4, i = rho & 15; return 8 * (i >> 2) + 4 * n + (i & 3); }
struct Unit { int pm, pn, aux; };
template <class GD, class Sched, class Epi>
__device__ __forceinline__ void gemm_phase(lptr lds, const GD& G, const Sched& S, const Epi& E, int wv) {
    const int tid = opaque_tid(wv), wid = __builtin_amdgcn_readfirstlane(tid >> 6), lane = tid & 63, wr = wid >> 2, wc = wid & 3, fr = lane & 15, fq = lane >> 4;
    const int K = G.K, nt = K / BK;
    unsigned voffB[2];
#pragma unroll
    for (int i = 0; i < 2; ++i) { int R, C; stage_rc(tid * 16 + i * 8192, R, C); const int Rb = Epi::PERM ? ((R & ~31) + perm32(R & 31)) : R; voffB[i] = (unsigned)(Rb * K + C) * 2u; }
#define PG8_AOFFS(u, o00, o01, o10, o11) do { int R0_, C0_, R1_, C1_; stage_rc(tid * 16, R0_, C0_); stage_rc(tid * 16 + 8192, R1_, C1_); \
        o00 = G.a_off(u, R0_) + C0_ * 2; o01 = G.a_off(u, R1_) + C1_ * 2; o10 = G.a_off(u, HALF + R0_) + C0_ * 2; o11 = G.a_off(u, HALF + R1_) + C1_ * 2; } while (0)
    const size_t kstep = (size_t)(BK * 2);
    const size_t hstep = (size_t)HALF * K * 2;
    const unsigned ldsw = (unsigned)wid * 1024u;
    const int aoff = lds_byte(wr * 64 + fr, fq * 8), boff = lds_byte(wc * 32 + fr, fq * 8);
    const char* const Ab = G.a_base();
#define PG8_SA(b, h) (((b) * 2 + (h)) * HTB)
#define PG8_SB(b, h) ((4 + (b) * 2 + (h)) * HTB)
#define PG8_STAGE_B(bufoff, gbase) do { _Pragma("unroll") for (int _i = 0; _i < 2; ++_i) \
        __builtin_amdgcn_global_load_lds((const unsigned*)((const char*)(gbase) + voffB[_i]), (LAS unsigned*)(lds + (bufoff) + ldsw + _i * 8192), 16, 0, 0); } while (0)
#define PG8_STAGE_A(bufoff, o0, o1, kb) do { const char* ub_ = Ab + (size_t)(kb);     \
        __builtin_amdgcn_global_load_lds((const unsigned*)(ub_ + (o0)), (LAS unsigned*)(lds + (bufoff) + ldsw), 16, 0, 0); \
        __builtin_amdgcn_global_load_lds((const unsigned*)(ub_ + (o1)), (LAS unsigned*)(lds + (bufoff) + ldsw + 8192), 16, 0, 0); } while (0)
#define PG8_LDA(dst, b, h) do { _Pragma("unroll") for (int m = 0; m < 4; ++m) _Pragma("unroll") for (int k = 0; k < 2; ++k) dst[m][k] = *(const LAS bf16x8*)(lds + PG8_SA(b, h) + aoff + m * 2048 + k * 1024); } while (0)
#define PG8_LDB(dst, b, h) do { _Pragma("unroll") for (int n = 0; n < 2; ++n) _Pragma("unroll") for (int k = 0; k < 2; ++k) dst[n][k] = *(const LAS bf16x8*)(lds + PG8_SB(b, h) + boff + n * 2048 + k * 1024); } while (0)
#define PG8_MMA(ai, bj, At, Bt) do { __builtin_amdgcn_s_setprio(1); _Pragma("unroll") for (int m = 0; m < 4; ++m) _Pragma("unroll") for (int n = 0; n < 2; ++n) _Pragma("unroll") for (int k = 0; k < 2; ++k) \
        acc[ai][bj][m][n] = __builtin_amdgcn_mfma_f32_16x16x32_bf16(Bt[n][k], At[m][k], acc[ai][bj][m][n], 0, 0, 0); __builtin_amdgcn_s_setprio(0); } while (0)
#define PG8_WAIT_V(n) asm volatile("s_waitcnt vmcnt(" #n ")" ::: "memory")
#define PG8_WAIT_L(n) asm volatile("s_waitcnt lgkmcnt(" #n ")" ::: "memory")
#define PG8_BAR __builtin_amdgcn_s_barrier()
#define PG8_SCHED __builtin_amdgcn_sched_barrier(0)
    Unit cur, nxt; int ui = 0;
    if (!S.next(0, cur)) return;
    if (DPH_TICKS > 0) {
        const unsigned dly = ((blockIdx.x >> 3) & 7u) * (unsigned)DPH_TICKS;
        const unsigned long long t0 = __builtin_amdgcn_s_memrealtime();
        while ((unsigned)(__builtin_amdgcn_s_memrealtime() - t0) < dly) __builtin_amdgcn_s_sleep(4);
    }
    f32x4 acc[2][2][4][2];
    float zf = 0.f; asm volatile("" : "+v"(zf));
#pragma unroll
    for (int a = 0; a < 2; ++a)
#pragma unroll
        for (int b = 0; b < 2; ++b)
#pragma unroll
            for (int m = 0; m < 4; ++m)
#pragma unroll
                for (int n = 0; n < 2; ++n) acc[a][b][m][n] = (f32x4){zf, zf, zf, zf};
    bf16x8 At[4][2], B0[2][2], B1[2][2];
    unsigned c00, c01, c10, c11; PG8_AOFFS(cur, c00, c01, c10, c11);
    const char* cB = G.b_base(cur);
    PG8_STAGE_B(PG8_SB(0, 0), cB); PG8_STAGE_A(PG8_SA(0, 0), c00, c01, 0); PG8_STAGE_B(PG8_SB(0, 1), cB + hstep); PG8_STAGE_A(PG8_SA(0, 1), c10, c11, 0);
    if (wr == 1) PG8_BAR;
    PG8_WAIT_V(4); PG8_BAR;
    PG8_STAGE_B(PG8_SB(1, 0), cB + kstep); PG8_STAGE_A(PG8_SA(1, 0), c00, c01, kstep); PG8_STAGE_B(PG8_SB(1, 1), cB + hstep + kstep);
    PG8_WAIT_V(6); PG8_BAR;
    for (;;) {
        const bool has_next = S.next(ui + 1, nxt);
        const char* nB = has_next ? G.b_base(nxt) : cB;
        for (int t = 0; t < nt; t += 2) {
            const bool last = (t == nt - 2);
            const size_t k1 = (size_t)(t + 1) * kstep;
            const size_t k2 = last ? 0 : (size_t)(t + 2) * kstep, k3 = k2 + kstep;
            unsigned a00 = c00, a01 = c01, a10 = c10, a11 = c11;
            if (last && has_next) PG8_AOFFS(nxt, a00, a01, a10, a11);
            const char* b2 = last ? nB : cB + (size_t)(t + 2) * kstep; const char* b3 = b2 + kstep;
            PG8_LDB(B0, 0, 0); PG8_SCHED; PG8_LDA(At, 0, 0); PG8_STAGE_A(PG8_SA(1, 1), c10, c11, k1);
            PG8_WAIT_L(8); PG8_BAR; PG8_WAIT_L(0); PG8_MMA(0, 0, At, B0); PG8_BAR; PG8_SCHED;
            PG8_LDB(B1, 0, 1); PG8_STAGE_B(PG8_SB(0, 0), b2);
            PG8_BAR; PG8_WAIT_L(0); PG8_MMA(0, 1, At, B1); PG8_BAR;
            PG8_LDA(At, 0, 1); PG8_STAGE_A(PG8_SA(0, 0), a00, a01, k2);
            PG8_BAR; PG8_WAIT_L(0); PG8_MMA(1, 0, At, B0); PG8_BAR; PG8_SCHED;
            PG8_STAGE_B(PG8_SB(0, 1), b2 + hstep);
            PG8_WAIT_V(6); PG8_BAR; PG8_MMA(1, 1, At, B1); PG8_BAR;
            PG8_LDB(B0, 1, 0); PG8_SCHED; PG8_LDA(At, 1, 0); PG8_STAGE_A(PG8_SA(0, 1), a10, a11, k2);
            PG8_WAIT_L(8); PG8_BAR; PG8_WAIT_L(0); PG8_MMA(0, 0, At, B0); PG8_BAR; PG8_SCHED;
            PG8_LDB(B1, 1, 1); PG8_STAGE_B(PG8_SB(1, 0), b3);
            PG8_BAR; PG8_WAIT_L(0); PG8_MMA(0, 1, At, B1); PG8_BAR;
            PG8_LDA(At, 1, 1); PG8_STAGE_A(PG8_SA(1, 0), a00, a01, k3);
            PG8_BAR; PG8_WAIT_L(0); PG8_MMA(1, 0, At, B0); PG8_BAR; PG8_SCHED;
            PG8_STAGE_B(PG8_SB(1, 1), b3 + hstep);
            PG8_WAIT_V(6); PG8_BAR; PG8_MMA(1, 1, At, B1); PG8_BAR;
        }
        { int fr_ = fr, fq_ = fq; asm volatile("" : "+v"(fr_), "+v"(fq_));
          E(acc, cur, wr, wc, fr_, fq_); }
        if (!has_next) break;
#pragma unroll
        for (int a = 0; a < 2; ++a)
#pragma unroll
            for (int b = 0; b < 2; ++b)
#pragma unroll
                for (int m = 0; m < 4; ++m)
#pragma unroll
                    for (int n = 0; n < 2; ++n) acc[a][b][m][n] = (f32x4){zf, zf, zf, zf};
        cur = nxt; cB = nB; PG8_AOFFS(cur, c00, c01, c10, c11); ++ui;
    }
    PG8_WAIT_V(0);
    if (wr == 0) PG8_BAR;
    PG8_BAR;
#undef PG8_AOFFS
#undef PG8_SA
#undef PG8_SB
#undef PG8_STAGE_A
#undef PG8_STAGE_B
#undef PG8_LDA
#undef PG8_LDB
#undef PG8_MMA
#undef PG8_WAIT_V
#undef PG8_WAIT_L
#undef PG8_BAR
#undef PG8_SCHED
}

struct GemmPlain {
    const char* A; const char* Bt; int K; int lda;
    __device__ __forceinline__ const char* a_base() const { return A; }
    __device__ __forceinline__ unsigned a_off(const Unit& u, int r) const { return (unsigned)(((size_t)(u.pm * 256 + r) * lda) * 2); }
    __device__ __forceinline__ const char* b_base(const Unit& u) const { return Bt + (size_t)u.pn * 256 * K * 2; }
};
struct StaticOrder {
    int nM, nN, nwg, G, c;
    __device__ __forceinline__ void init(int nM_, int nN_, int G_, int c_) { nM = nM_; nN = nN_; nwg = nM * nN; G = G_; c = c_; }
    __device__ __forceinline__ bool next(int i, Unit& u) const {
        const long L = (long)i * G + c; if (L >= nwg) return false;
        int wgid = (int)L; { const int q = nwg / 8, r = nwg % 8, xcd = wgid % 8, off = wgid / 8; wgid = (xcd < r ? xcd * (q + 1) : r * (q + 1) + (xcd - r) * q) + off; }
        const int nig = 8 * nN, gid = wgid / nig, fm = gid * 8, gsz = (nM - fm) < 8 ? (nM - fm) : 8;
        u.pm = fm + ((wgid % nig) % gsz); u.pn = (wgid % nig) / gsz; u.aux = 0; return true;
    }
};
}

__device__ __forceinline__ void rope4(f32x4& v0, f32x4& v1, const float* cs, const float* sn) {
    const f32x4 c = *(const f32x4*)cs, s = *(const f32x4*)sn;
    const float a0 = v0[0] * c[0] - v0[1] * s[0], b0 = v0[1] * c[0] + v0[0] * s[0];
    const float a1 = v0[2] * c[1] - v0[3] * s[1], b1 = v0[3] * c[1] + v0[2] * s[1];
    const float a2 = v1[0] * c[2] - v1[1] * s[2], b2 = v1[1] * c[2] + v1[0] * s[2];
    const float a3 = v1[2] * c[3] - v1[3] * s[3], b3 = v1[3] * c[3] + v1[2] * s[3];
    v0 = (f32x4){a0, b0, a1, b1}; v1 = (f32x4){a2, b2, a3, b3};
}
__device__ __forceinline__ void rope_cs(float pos, const f32x4& rv, f32x4& c, f32x4& s) {
#pragma unroll
    for (int e = 0; e < 4; ++e) { const float r = __builtin_amdgcn_fractf(pos * rv[e]); c[e] = __builtin_amdgcn_cosf(r); s[e] = __builtin_amdgcn_sinf(r); }
}
__device__ __forceinline__ f32x4 rope_rv(int j0, float inv_nf) {
    f32x4 rv;
#pragma unroll
    for (int e = 0; e < 4; ++e) rv[e] = __builtin_amdgcn_exp2f(-(float)(j0 + e) * inv_nf * 13.287712379549449f) * 0.15915494309189535f;
    return rv;
}
__device__ __forceinline__ void rope4v(f32x4& v0, f32x4& v1, const f32x4& c, const f32x4& s) {
    const float a0 = v0[0] * c[0] - v0[1] * s[0], b0 = v0[1] * c[0] + v0[0] * s[0];
    const float a1 = v0[2] * c[1] - v0[3] * s[1], b1 = v0[3] * c[1] + v0[2] * s[1];
    const float a2 = v1[0] * c[2] - v1[1] * s[2], b2 = v1[1] * c[2] + v1[0] * s[2];
    const float a3 = v1[2] * c[3] - v1[3] * s[3], b3 = v1[3] * c[3] + v1[2] * s[3];
    v0 = (f32x4){a0, b0, a1, b1}; v1 = (f32x4){a2, b2, a3, b3};
}
typedef float f32x2 __attribute__((ext_vector_type(2)));
template <int SEL> __device__ __forceinline__ f32x2 rope_pair(f32x2 xy, f32x2 cc, f32x2 ss) {
    f32x2 t, o;
    if constexpr (SEL == 0) {
        asm("v_pk_mul_f32 %0, %1, %2 op_sel_hi:[1,0]" : "=v"(t) : "v"(xy), "v"(cc));
        asm("v_pk_fma_f32 %0, %1, %2, %3 op_sel:[1,0,0] op_sel_hi:[0,0,1] neg_lo:[0,1,0]" : "=v"(o) : "v"(xy), "v"(ss), "v"(t));
    } else {
        asm("v_pk_mul_f32 %0, %1, %2 op_sel:[0,1] op_sel_hi:[1,1]" : "=v"(t) : "v"(xy), "v"(cc));
        asm("v_pk_fma_f32 %0, %1, %2, %3 op_sel:[1,1,0] op_sel_hi:[0,1,1] neg_lo:[0,1,0]" : "=v"(o) : "v"(xy), "v"(ss), "v"(t));
    }
    return o;
}
__device__ __forceinline__ u32x4 rope8_pack(const f32x4& v0, const f32x4& v1, const f32x4& c, const f32x4& s) {
    const f32x2 c01 = {c[0], c[1]}, c23 = {c[2], c[3]}, s01 = {s[0], s[1]}, s23 = {s[2], s[3]};
    const f32x2 o0 = rope_pair<0>((f32x2){v0[0], v0[1]}, c01, s01), o1 = rope_pair<1>((f32x2){v0[2], v0[3]}, c01, s01);
    const f32x2 o2 = rope_pair<0>((f32x2){v1[0], v1[1]}, c23, s23), o3 = rope_pair<1>((f32x2){v1[2], v1[3]}, c23, s23);
    u32x4 w; w.x = pk2(o0[0], o0[1]); w.y = pk2(o1[0], o1[1]); w.z = pk2(o2[0], o2[1]); w.w = pk2(o3[0], o3[1]); return w;
}
__device__ __forceinline__ u32x4 pack8(const f32x4& v0, const f32x4& v1) { u32x4 w; w.x = pk2(v0[0], v0[1]); w.y = pk2(v0[2], v0[3]); w.z = pk2(v1[0], v1[1]); w.w = pk2(v1[2], v1[3]); return w; }
__device__ __forceinline__ float sumsq8(const f32x4& v0, const f32x4& v1) { return (v0[0] * v0[0] + v0[1] * v0[1]) + (v0[2] * v0[2] + v0[3] * v0[3]) + (v1[0] * v1[0] + v1[1] * v1[1]) + (v1[2] * v1[2] + v1[3] * v1[3]); }

struct EpiWinEven {
    static constexpr bool PERM = true;
    unsigned char* big; float* rsq; const float* rope64; const float* rope32; bool nost;
    __device__ __forceinline__ void operator()(const f32x4 (&acc)[2][2][4][2], const pg8::Unit& u, int wr, int wc, int fr, int fq) const {
        const int row0 = u.pm * 256 + wr * 64 + fr;
        const bool lat = (u.pm * 256) < NLAT;
        bf16_t* dst; int ldc;
        if (u.pn < 2) { dst = (bf16_t*)(big + BG_AQ) + u.pn * 256; ldc = 512; }
        else if (u.pn == 2) { dst = (bf16_t*)(big + BG_AKV); ldc = 256; }
        else if (u.pn == 3) { dst = (bf16_t*)(big + BG_CQ); ldc = 256; }
        else { dst = (bf16_t*)(big + BG_CKVR); ldc = 256; }
        const bool r64 = lat && (u.pn <= 2), r32 = lat && (u.pn == 4) && (wc == 0);
        const int i0 = r64 ? (((wc & 1) * 32 + 8 * fq) >> 1) : 4 * fq;
        const int nfa = r64 ? 16 : 8;
        const f32x4 rv = rope_rv(i0 & (nfa - 1), r64 ? (1.0f / 16.0f) : (1.0f / 8.0f));
#pragma unroll
        for (int ai = 0; ai < 2; ++ai) {
            f32x4 cs[4], sn[4];
#pragma unroll
            for (int mh = 0; mh < 2; ++mh) {
            if (r64 || r32) {
#pragma unroll
                for (int m = 2 * mh; m < 2 * mh + 2; ++m) { const int sp = (row0 + ai * 128 + m * 16) & (SEQ - 1); rope_cs((float)((i0 < nfa) ? (sp >> 6) : (sp & 63)), rv, cs[m], sn[m]); }
            }
#pragma unroll
            for (int m = 2 * mh; m < 2 * mh + 2; ++m) {
                const int row = row0 + ai * 128 + m * 16;
                float ssq = 0.f;
#pragma unroll
                for (int bj = 0; bj < 2; ++bj) {
                    const int cl = bj * 128 + wc * 32 + 8 * fq;
                    f32x4 v0 = acc[ai][bj][m][0], v1 = acc[ai][bj][m][1];
                    if (u.pn < 2 || (u.pn == 2 && bj == 0)) { if (r64) rope4v(v0, v1, cs[m], sn[m]); if (u.pn < 2) { v0 = v0 * (0.125f * LOG2E); v1 = v1 * (0.125f * LOG2E); } }
                    else if (u.pn == 3) { ssq += sumsq8(v0, v1); }
                    else if (u.pn == 4) { if (bj == 0) ssq += sumsq8(v0, v1); else if (r32) rope4v(v0, v1, cs[m], sn[m]); }
                    { const u32x4 w_ = pack8(v0, v1); if (!nost) NTST((GAS u32x4*)(dst + (size_t)row * ldc + cl), w_); else asm volatile("" :: "v"(w_)); }
                }
                if (u.pn >= 3) { ssq += xshfl<16>(ssq); ssq += xshfl<32>(ssq); if (fq == 0) { if (!nost) *(GAS float*)(rsq + (size_t)row * 8 + (u.pn - 3) * 4 + wc) = ssq; else asm volatile("" :: "v"(ssq)); } }
            }
            }
        }
    }
};
struct EpiUq {
    static constexpr bool PERM = true;
    bf16_t* qm; const float* rsq; const float* rope32;
    __device__ __forceinline__ void operator()(const f32x4 (&acc)[2][2][4][2], const pg8::Unit& u, int wr, int wc, int fr, int fq) const {
        const int row0 = u.pm * 256 + wr * 64 + fr; const bool lat = (u.pm * 256) < NLAT;
        const int colb0 = u.pn * 256 + wc * 32 + 8 * fq, colb1 = colb0 + 128;
        const int d0 = colb0 % 96, d1 = colb1 % 96;
        const bool rp0 = lat && d0 >= 64, rp1 = lat && d1 >= 64;
        const int i00 = rp0 ? ((d0 - 64) >> 1) : 0, i01 = rp1 ? ((d1 - 64) >> 1) : 0;
        const f32x4 rv0 = rope_rv(i00 & 7, 1.0f / 8.0f), rv1 = rope_rv(i01 & 7, 1.0f / 8.0f);
#pragma unroll
        for (int ai = 0; ai < 2; ++ai) {
            f32x4 pq[4], c0[4], s0[4], c1[4], s1[4];
#pragma unroll
            for (int m = 0; m < 4; ++m) { const int row = row0 + ai * 128 + m * 16; const int sp = row & (SEQ - 1);
                pq[m] = *(const GAS f32x4*)(rsq + (size_t)row * 8);
                if (rp0) rope_cs((float)((i00 < 8) ? (sp >> 6) : (sp & 63)), rv0, c0[m], s0[m]);
                if (rp1) rope_cs((float)((i01 < 8) ? (sp >> 6) : (sp & 63)), rv1, c1[m], s1[m]); }
#pragma unroll
            for (int m = 0; m < 4; ++m) {
                const int row = row0 + ai * 128 + m * 16;
                const float rs = __builtin_amdgcn_rsqf(((pq[m][0] + pq[m][1]) + (pq[m][2] + pq[m][3])) * (1.0f / 256.0f) + NORM_EPS) * (0.10206207261596575f * LOG2E);
                { f32x4 v0 = acc[ai][0][m][0] * rs, v1 = acc[ai][0][m][1] * rs; if (rp0) rope4v(v0, v1, c0[m], s0[m]); NTST((GAS u32x4*)(qm + (size_t)row * 768 + colb0), pack8(v0, v1)); }
                { f32x4 v0 = acc[ai][1][m][0] * rs, v1 = acc[ai][1][m][1] * rs; if (rp1) rope4v(v0, v1, c1[m], s1[m]); NTST((GAS u32x4*)(qm + (size_t)row * 768 + colb1), pack8(v0, v1)); }
            }
        }
    }
};
struct EpiUkv {
    static constexpr bool PERM = true;
    bf16_t* kvm; const float* rsq;
    __device__ __forceinline__ void operator()(const f32x4 (&acc)[2][2][4][2], const pg8::Unit& u, int wr, int wc, int fr, int fq) const {
        const int row0 = u.pm * 256 + wr * 64 + fr;
        f32x4 pq[2][4];
#pragma unroll
        for (int ai = 0; ai < 2; ++ai)
#pragma unroll
            for (int m = 0; m < 4; ++m) pq[ai][m] = *(const GAS f32x4*)(rsq + (size_t)(row0 + ai * 128 + m * 16) * 8 + 4);
#pragma unroll
        for (int ai = 0; ai < 2; ++ai)
#pragma unroll
            for (int m = 0; m < 4; ++m) {
                const int row = row0 + ai * 128 + m * 16; const f32x4 p = pq[ai][m];
                const float rs = __builtin_amdgcn_rsqf(((p[0] + p[1]) + (p[2] + p[3])) * (1.0f / 128.0f) + NORM_EPS);
#pragma unroll
                for (int bj = 0; bj < 2; ++bj) {
                    const int col = u.pn * 256 + bj * 128 + wc * 32 + 8 * fq;
                    const f32x4 v0 = acc[ai][bj][m][0] * rs, v1 = acc[ai][bj][m][1] * rs;
                    NTST((GAS u32x4*)(kvm + (size_t)row * 1024 + col), pack8(v0, v1));
                }
            }
    }
};
struct EpiWinOdd {
    static constexpr bool PERM = true;
    bf16_t* qkv; const float* rope64; bool nost;
    template <bool ROWAX>
    __device__ __forceinline__ void body(const f32x4 (&acc)[2][2][4][2], const pg8::Unit& u, int wr, int wc, int fr, int fq) const {
        const int row0 = u.pm * 256 + wr * 64 + fr; const bool lat = (u.pm * 256) < NLAT;
        GAS bf16_t* const p0 = (GAS bf16_t*)qkv + (size_t)row0 * 3072 + (u.pn * 256 + wc * 32 + 8 * fq);
        if (u.pn >= 8) {
#pragma unroll
            for (int ai = 0; ai < 2; ++ai)
#pragma unroll
                for (int m = 0; m < 4; ++m)
#pragma unroll
                    for (int bj = 0; bj < 2; ++bj) { const u32x4 w_ = pack8(acc[ai][bj][m][0], acc[ai][bj][m][1]); if (!nost) NTST((GAS u32x4*)(p0 + (size_t)(ai * 128 + m * 16) * 3072 + bj * 128), w_); else asm volatile("" :: "v"(w_)); }
            return;
        }
        const float kf = (u.pn < 4) ? (0.125f * LOG2E) : 1.0f;
        const f32x4 rv = rope_rv(4 * fq, 1.0f / 16.0f);
        f32x4 cs[4], sn[4];
#pragma unroll
        for (int ai = 0; ai < 2; ++ai) {
            if (!lat) {
#pragma unroll
                for (int m = 0; m < 4; ++m) { cs[m] = (f32x4){kf, kf, kf, kf}; sn[m] = (f32x4){0.f, 0.f, 0.f, 0.f}; }
            } else if (ROWAX) {
                f32x4 c, sv; rope_cs((float)((u.pm * 4 + wr + 2 * ai) & 63), rv, c, sv); c = c * kf; sv = sv * kf;
#pragma unroll
                for (int m = 0; m < 4; ++m) { cs[m] = c; sn[m] = sv; }
            } else if (ai == 0) {
#pragma unroll
                for (int m = 0; m < 4; ++m) { rope_cs((float)(m * 16 + fr), rv, cs[m], sn[m]); cs[m] = cs[m] * kf; sn[m] = sn[m] * kf; }
            }
#pragma unroll
            for (int m = 0; m < 4; ++m)
#pragma unroll
                for (int bj = 0; bj < 2; ++bj) {
                    const u32x4 w_ = rope8_pack(acc[ai][bj][m][0], acc[ai][bj][m][1], cs[m], sn[m]);
                    if (!nost) NTST((GAS u32x4*)(p0 + (size_t)(ai * 128 + m * 16) * 3072 + bj * 128), w_); else asm volatile("" :: "v"(w_));
                }
        }
    }
    __device__ __forceinline__ void operator()(const f32x4 (&acc)[2][2][4][2], const pg8::Unit& u, int wr, int wc, int fr, int fq) const {
        if ((wc & 1) == 0) body<true>(acc, u, wr, wc, fr, fq); else body<false>(acc, u, wr, wc, fr, fq);
    }
};
template <bool SRC_F32>
struct EpiResid {
    static constexpr bool PERM = true;
    const float* src_lat; const float* src_ctx; bf16_t* xb; const float* mod; int gate_off;
    float* rs16;
    __device__ __forceinline__ void operator()(const f32x4 (&acc)[2][2][4][2], const pg8::Unit& u, int wr, int wc, int fr, int fq) const {
        const int rowt = u.pm * 256; const bool lat = rowt < NLAT;
        const float* sp = lat ? src_lat + (size_t)rowt * DM : src_ctx + (size_t)(rowt - NLAT) * DM;
        const float* g = mod + (size_t)(lat ? (rowt >> 12) : 16) * 6144 + gate_off;
        const int r0 = wr * 64 + fr, col0 = u.pn * 256 + wc * 32 + 8 * fq;
        GAS bf16_t* const xp = (GAS bf16_t*)xb + (size_t)(rowt + r0) * DM + col0;
        f32x4 gv[2][2];
#pragma unroll
        for (int bj = 0; bj < 2; ++bj)
#pragma unroll
            for (int n = 0; n < 2; ++n) gv[bj][n] = *(const GAS f32x4*)(g + col0 + bj * 128 + n * 4);
#pragma unroll
        for (int ai = 0; ai < 2; ++ai) {
            f32x4 xv[4][2][2];
            if constexpr (SRC_F32) {
#pragma unroll
                for (int m = 0; m < 4; ++m) { const size_t ro = (size_t)(r0 + ai * 128 + m * 16) * DM + col0;
#pragma unroll
                    for (int bj = 0; bj < 2; ++bj)
#pragma unroll
                        for (int n = 0; n < 2; ++n) xv[m][bj][n] = *(const GAS f32x4*)(sp + ro + bj * 128 + n * 4); }
            } else {
                u32x4 xw[4][2];
#pragma unroll
                for (int m = 0; m < 4; ++m)
#pragma unroll
                    for (int bj = 0; bj < 2; ++bj) xw[m][bj] = *(const GAS u32x4*)(xp + (size_t)(ai * 128 + m * 16) * DM + bj * 128);
#pragma unroll
                for (int m = 0; m < 4; ++m)
#pragma unroll
                    for (int bj = 0; bj < 2; ++bj) { const u32x4 t = xw[m][bj]; xv[m][bj][0] = (f32x4){bflo(t.x), bfhi(t.x), bflo(t.y), bfhi(t.y)}; xv[m][bj][1] = (f32x4){bflo(t.z), bfhi(t.z), bflo(t.w), bfhi(t.w)}; }
            }
#pragma unroll
            for (int m = 0; m < 4; ++m) { float ss = 0.f;
#pragma unroll
                for (int bj = 0; bj < 2; ++bj) {
                    const f32x4 y0 = xv[m][bj][0] + gv[bj][0] * acc[ai][bj][m][0], y1 = xv[m][bj][1] + gv[bj][1] * acc[ai][bj][m][1];
                    *(GAS u32x4*)(xp + (size_t)(ai * 128 + m * 16) * DM + bj * 128) = pack8(y0, y1); ss += sumsq8(y0, y1); }
                ss += xshfl<16>(ss); ss += xshfl<32>(ss);
                if (fq == 0) *(GAS float*)(rs16 + (size_t)(rowt + r0 + ai * 128 + m * 16) * 16 + u.pn * 4 + wc) = ss; }
        }
    }
};
struct EpiSwiglu {
    static constexpr bool PERM = true;
    bf16_t* act;
    __device__ __forceinline__ void operator()(const f32x4 (&acc)[2][2][4][2], const pg8::Unit& u, int wr, int wc, int fr, int fq) const {
        const int row0 = u.pm * 256 + wr * 64 + fr;
#pragma unroll
        for (int ai = 0; ai < 2; ++ai)
#pragma unroll
            for (int m = 0; m < 4; ++m) {
                const int row = row0 + ai * 128 + m * 16;
#pragma unroll
                for (int bj = 0; bj < 2; ++bj) {
                    const int col = u.pn * 256 + bj * 128 + wc * 32 + 8 * fq;
                    const f32x4 v0 = acc[ai][bj][m][0], v1 = acc[ai][bj][m][1];
                    float o[4];
                    { const float a = v0[0], b = v0[1]; o[0] = a * __builtin_amdgcn_rcpf(1.f + __builtin_amdgcn_exp2f(-LOG2E * a)) * b; }
                    { const float a = v0[2], b = v0[3]; o[1] = a * __builtin_amdgcn_rcpf(1.f + __builtin_amdgcn_exp2f(-LOG2E * a)) * b; }
                    { const float a = v1[0], b = v1[1]; o[2] = a * __builtin_amdgcn_rcpf(1.f + __builtin_amdgcn_exp2f(-LOG2E * a)) * b; }
                    { const float a = v1[2], b = v1[3]; o[3] = a * __builtin_amdgcn_rcpf(1.f + __builtin_amdgcn_exp2f(-LOG2E * a)) * b; }
                    u32x2 w; w.x = pk2(o[0], o[1]); w.y = pk2(o[2], o[3]);
                    NTST((GAS u32x2*)(act + (size_t)row * EFF + (col >> 1)), w);
                }
            }
    }
};
struct EpiMoe2 {
    static constexpr bool PERM = true;
    bf16_t* yb; const LAS float* gl;
    __device__ __forceinline__ void operator()(const f32x4 (&acc)[2][2][4][2], const pg8::Unit& u, int wr, int wc, int fr, int fq) const {
        const int row0 = u.pm * 256 + wr * 64 + fr;
        float gt[2][4];
#pragma unroll
        for (int ai = 0; ai < 2; ++ai)
#pragma unroll
            for (int m = 0; m < 4; ++m) gt[ai][m] = gl[u.aux * 256 + wr * 64 + fr + ai * 128 + m * 16];
#pragma unroll
        for (int ai = 0; ai < 2; ++ai)
#pragma unroll
            for (int m = 0; m < 4; ++m) {
                const int row = row0 + ai * 128 + m * 16; const float g = gt[ai][m];
#pragma unroll
                for (int bj = 0; bj < 2; ++bj) {
                    const int col = u.pn * 256 + bj * 128 + wc * 32 + 8 * fq;
                    const f32x4 v0 = acc[ai][bj][m][0] * g, v1 = acc[ai][bj][m][1] * g;
                    NTST((GAS u32x4*)(yb + (size_t)row * DM + col), pack8(v0, v1));
                }
            }
    }
};
struct MoeSched {
    const LAS int* tile_exp; int ntiles; int G, c;
    __device__ __forceinline__ bool next(int i, pg8::Unit& u) const {
        const int L = i * G + c; if (L >= ntiles * 4) return false;
        u.pm = L >> 2; u.pn = L & 3; u.aux = i; return true;
    }
};
struct GemmMoe1 {
    const char* H; const char* W13l; const LAS int* idx; const LAS int* tile_exp; int K;
    __device__ __forceinline__ const char* a_base() const { return H; }
    __device__ __forceinline__ unsigned a_off(const pg8::Unit& u, int r) const { return (unsigned)idx[u.aux * 256 + r] * (unsigned)(DM * 2); }
    __device__ __forceinline__ const char* b_base(const pg8::Unit& u) const { return W13l + ((size_t)tile_exp[u.pm] * 1024 + (size_t)u.pn * 256) * 1024 * 2; }
};
struct GemmMoe2 {
    const char* ACT; const char* W2l; const LAS int* tile_exp; int K;
    __device__ __forceinline__ const char* a_base() const { return ACT; }
    __device__ __forceinline__ unsigned a_off(const pg8::Unit& u, int r) const { return (unsigned)(u.pm * 256 + r) * (unsigned)(EFF * 2); }
    __device__ __forceinline__ const char* b_base(const pg8::Unit& u) const { return W2l + ((size_t)tile_exp[u.pm] * 1024 + (size_t)u.pn * 256) * 512 * 2; }
};

namespace att {
enum { MLA = 0, SWA = 1, DIFF = 2 };
template <int MODE> struct Cfg;
template <> struct Cfg<MLA>  { static constexpr int DQK = 96, DV = 64,  NKCH = 12, QB = 256; };
template <> struct Cfg<SWA>  { static constexpr int DQK = 64, DV = 64,  NKCH = 8,  QB = 256; };
template <> struct Cfg<DIFF> { static constexpr int DQK = 64, DV = 128, NKCH = 16, QB = 128; };
struct Unit {
    int qrow0;
    int lat_row0;
    int nlat;
    int ctx_row0;
    int head;
    int qpos0;
    int kpos0;
};
struct Tensors {
    const bf16_t* q; const bf16_t* k; const bf16_t* k2; const bf16_t* v; bf16_t* o;
    const float* sink; float lam; const float* subln; float post;
    float c2;
};
__device__ __forceinline__ s16x4 vtr(const LAS unsigned char* p) {
    typedef short v4i16_t __attribute__((ext_vector_type(4)));
    return __builtin_bit_cast(s16x4, __builtin_amdgcn_ds_read_tr16_b64_v4i16((LAS v4i16_t*)p));
}
template <int MODE>
__device__ __forceinline__ void issue_tile(lptr lds, int buf, int row0, const Tensors& T, int head, int wid, int lane) {
    typedef Cfg<MODE> C;
    constexpr int KB = C::NKCH * 1024, VB = C::DV * 128;
    for (int p = wid; p < C::NKCH; p += 8) {
        const bf16_t* src;
        const size_t row = (size_t)(row0 + lane);
        if (MODE == MLA) src = (p < 8) ? T.k + row * 1024 + head * 128 + p * 8 : T.k2 + row * 256 + 128 + (p - 8) * 8;
        else if (MODE == SWA) src = T.k + row * 256 + (head >> 2) * 64 + p * 8;
        else src = T.k + row * 3072 + 1024 + head * 128 + p * 8;
        __builtin_amdgcn_global_load_lds((const unsigned*)src, (LAS unsigned*)(lds + buf * KB + p * 1024), 16, 0, 0);
    }
    for (int p = wid; p < C::DV / 8; p += 8) {
        const size_t row = (size_t)(row0 + 16 * (p & 3) + (lane >> 2)); const int col = (p >> 2) * 32 + (lane & 3) * 8;
        const bf16_t* src;
        if (MODE == MLA) src = T.v + row * 1024 + head * 128 + 64 + col;
        else if (MODE == SWA) src = T.v + row * 256 + 128 + (head >> 2) * 64 + col;
        else src = T.v + row * 3072 + 2048 + head * 128 + col;
        __builtin_amdgcn_global_load_lds((const unsigned*)src, (LAS unsigned*)(lds + 2 * KB + buf * VB + p * 1024), 16, 0, 0);
    }
}
template <int MODE, bool GUARDED>
__device__ __forceinline__ bool attn_unit(lptr lds, const Unit& U, const Tensors& T, int wv) {
    typedef Cfg<MODE> C;
    constexpr int KB = C::NKCH * 1024, VB = C::DV * 128, NKS = C::DQK / 16, ND = C::DV / 32;
    const int tid = opaque_tid(wv), lane = tid & 63, r32 = lane & 31, hi = lane >> 5; const int wid = __builtin_amdgcn_readfirstlane(tid >> 6);
    const int br = (MODE == DIFF) ? (wid >> 2) : 0;
    const int wq = (MODE == DIFF) ? (wid & 3) : wid;
    const int NT = U.nlat + 4;
    issue_tile<MODE>(lds, 0, U.nlat > 0 ? U.lat_row0 : U.ctx_row0, T, U.head, wid, lane);
    bf16x8 qf[NKS];
    {
        const size_t qrow = (size_t)(U.qrow0 + wq * 32 + r32);
        const bf16_t* qp;
        if (MODE == MLA) qp = T.q + qrow * 768 + U.head * 96 + hi * 8;
        else if (MODE == SWA) qp = T.q + qrow * 512 + U.head * 64 + hi * 8;
        else qp = T.q + qrow * 3072 + U.head * 128 + br * 64 + hi * 8;
#pragma unroll
        for (int ks = 0; ks < NKS; ++ks) qf[ks] = *(const GAS bf16x8*)(qp + ks * 16);
    }
    f32x16 o[ND];
#pragma unroll
    for (int d = 0; d < ND; ++d) o[d] = f32x16{};
    float m = GUARDED ? -INFINITY : 0.f, l = 0.f;
    const float c2 = T.c2;
    const int qpos = U.qpos0 + wq * 32 + r32, qa = U.qpos0 + wq * 32;
    const int koff = (MODE == DIFF ? br * 8192 : 0) + hi * 1024 + r32 * 16;
    const int voff = ((lane >> 4) & 1) * 32 + (lane & 3) * 8 + (4 * hi + ((lane & 15) >> 2)) * 64;
    asm volatile("s_waitcnt vmcnt(0)" ::: "memory");
    __syncthreads();
    for (int j = 0; j < NT; ++j) {
        const int buf = j & 1;
        if (j + 1 < NT) { const int jn = j + 1; issue_tile<MODE>(lds, buf ^ 1, jn < U.nlat ? U.lat_row0 + 64 * jn : U.ctx_row0 + 64 * (jn - U.nlat), T, U.head, wid, lane); }
        bool active = true; const bool latt = j < U.nlat; const int kt = U.kpos0 + 64 * j;
        if (MODE == SWA && latt) active = (kt <= qa + 31 + 128) && (kt + 63 >= qa - 128);
        if (active) {
            const lptr kb = lds + buf * KB + koff;
            f32x16 s0 = f32x16{}, s1 = f32x16{};
#pragma unroll
            for (int ks = 0; ks < NKS; ++ks) {
                const bf16x8 k0 = *(const LAS bf16x8*)(kb + ks * 2048), k1 = *(const LAS bf16x8*)(kb + ks * 2048 + 512);
                s0 = __builtin_amdgcn_mfma_f32_32x32x16_bf16(k0, qf[ks], s0, 0, 0, 0);
                s1 = __builtin_amdgcn_mfma_f32_32x32x16_bf16(k1, qf[ks], s1, 0, 0, 0);
            }
            if (MODE == SWA && latt) {
#pragma unroll
                for (int r = 0; r < 16; ++r) { const int kp = kt + crow(r, hi); int d0 = qpos - kp; d0 = d0 < 0 ? -d0 : d0; int d1 = qpos - kp - 32; d1 = d1 < 0 ? -d1 : d1;
                    if (d0 > 128) s0[r] = -INFINITY; if (d1 > 128) s1[r] = -INFINITY; }
            }
            float ps = 0.f;
            if (GUARDED) {
                float mt = fmaxf(s0[0], s1[0]);
#pragma unroll
                for (int r = 1; r < 16; ++r) mt = fmaxf(mt, fmaxf(s0[r], s1[r]));
                mt = fmaxf(mt, xshfl<32>(mt)) * c2;
                const float mn = fmaxf(m, mt);
                const float mu = (mn == -INFINITY) ? 0.f : mn;
                const float alpha = __builtin_amdgcn_exp2f(m - mu);
                m = mn;
#pragma unroll
                for (int r = 0; r < 16; ++r) { s0[r] = __builtin_amdgcn_exp2f(s0[r] * c2 - mu); s1[r] = __builtin_amdgcn_exp2f(s1[r] * c2 - mu); ps += s0[r] + s1[r]; }
                l = l * alpha + ps;
#pragma unroll
                for (int d = 0; d < ND; ++d)
#pragma unroll
                    for (int r = 0; r < 16; ++r) o[d][r] *= alpha;
            } else {
#pragma unroll
                for (int r = 0; r < 16; ++r) { s0[r] = __builtin_amdgcn_exp2f(s0[r]); s1[r] = __builtin_amdgcn_exp2f(s1[r]); ps += s0[r] + s1[r]; }
                l += ps;
            }
            bf16x8 pw[4];
            { u32x4 w;
              w.x = pk2(s0[0], s0[1]); w.y = pk2(s0[2], s0[3]); w.z = pk2(s0[4], s0[5]); w.w = pk2(s0[6], s0[7]); pw[0] = __builtin_bit_cast(bf16x8, w);
              w.x = pk2(s0[8], s0[9]); w.y = pk2(s0[10], s0[11]); w.z = pk2(s0[12], s0[13]); w.w = pk2(s0[14], s0[15]); pw[1] = __builtin_bit_cast(bf16x8, w);
              w.x = pk2(s1[0], s1[1]); w.y = pk2(s1[2], s1[3]); w.z = pk2(s1[4], s1[5]); w.w = pk2(s1[6], s1[7]); pw[2] = __builtin_bit_cast(bf16x8, w);
              w.x = pk2(s1[8], s1[9]); w.y = pk2(s1[10], s1[11]); w.z = pk2(s1[12], s1[13]); w.w = pk2(s1[14], s1[15]); pw[3] = __builtin_bit_cast(bf16x8, w); }
            const lptr vb = lds + 2 * KB + buf * VB + voff;
#pragma unroll
            for (int d = 0; d < ND; ++d)
#pragma unroll
                for (int kk = 0; kk < 4; ++kk) {
                    const s16x4 lo = vtr(vb + d * 4096 + kk * 1024), hh = vtr(vb + d * 4096 + kk * 1024 + 512);
                    const bf16x8 vf = (bf16x8){lo[0], lo[1], lo[2], lo[3], hh[0], hh[1], hh[2], hh[3]};
                    o[d] = __builtin_amdgcn_mfma_f32_32x32x16_bf16(vf, pw[kk], o[d], 0, 0, 0);
                }
        }
        asm volatile("s_waitcnt vmcnt(0)" ::: "memory");
        __syncthreads();
    }
    l += xshfl<32>(l);
    if (MODE == SWA) l += __builtin_amdgcn_exp2f(T.sink[U.head] * LOG2E - m);
    if (!GUARDED) {
        float oa = 0.f;
#pragma unroll
        for (int d = 0; d < ND; ++d)
#pragma unroll
            for (int r = 0; r < 16; ++r) oa += __builtin_fabsf(o[d][r]);
        const bool badl = !(l > 0x1p-100f && l < 0x1p100f) || !(oa < 0x1p120f);
        LAS unsigned* flg = (LAS unsigned*)(lds + LDS_MISC + 4608);
        const bool wbad = __builtin_amdgcn_ballot_w64(badl) != 0ull;
        if (lane == 0) flg[wid] = wbad ? 1u : 0u;
        __syncthreads();
        unsigned anyb = 0u;
#pragma unroll
        for (int w = 0; w < 8; ++w) anyb |= flg[w];
        __syncthreads();
        if (__builtin_amdgcn_readfirstlane(anyb) != 0u) return true;
    }
    const float inv = 1.0f / l;
#pragma unroll
    for (int d = 0; d < ND; ++d)
#pragma unroll
        for (int r = 0; r < 16; ++r) o[d][r] *= inv;
    const size_t orow = (size_t)(U.qrow0 + wq * 32 + r32);
    if (MODE == DIFF) {
        LAS float* xch = (LAS float*)lds + (size_t)(wid & 3) * 4096 + lane;
        if (br == 1) {
#pragma unroll
            for (int d = 0; d < ND; ++d)
#pragma unroll
                for (int r = 0; r < 16; ++r) xch[(d * 16 + r) * 64] = o[d][r];
        }
        __syncthreads();
        if (br == 0) {
            float ss = 0.f;
#pragma unroll
            for (int d = 0; d < ND; ++d)
#pragma unroll
                for (int r = 0; r < 16; ++r) { const float v = o[d][r] - T.lam * xch[(d * 16 + r) * 64]; o[d][r] = v; ss += v * v; }
            ss += xshfl<32>(ss);
            const float rs = __builtin_amdgcn_rsqf(ss * (1.0f / 128.0f) + DIFF_EPS) * T.post;
            bf16_t* op = T.o + orow * 1024 + U.head * 128;
#pragma unroll
            for (int d = 0; d < ND; ++d)
#pragma unroll
                for (int g = 0; g < 4; ++g) {
                    const int dv0 = 32 * d + 8 * g + 4 * hi; const f32x4 gn = *(const GAS f32x4*)(T.subln + dv0);
                    u32x2 w; w.x = pk2(o[d][4 * g] * rs * gn[0], o[d][4 * g + 1] * rs * gn[1]); w.y = pk2(o[d][4 * g + 2] * rs * gn[2], o[d][4 * g + 3] * rs * gn[3]);
                    *(GAS u32x2*)(op + dv0) = w;
                }
        }
        __syncthreads();
    } else {
        bf16_t* op = T.o + orow * 1024 + (MODE == MLA ? 512 + U.head * 64 : U.head * 64);
#pragma unroll
        for (int d = 0; d < ND; ++d)
#pragma unroll
            for (int g = 0; g < 4; ++g) {
                const int dv0 = 32 * d + 8 * g + 4 * hi;
                u32x2 w; w.x = pk2(o[d][4 * g], o[d][4 * g + 1]); w.y = pk2(o[d][4 * g + 2], o[d][4 * g + 3]);
                *(GAS u32x2*)(op + dv0) = w;
            }
    }
    return false;
}
__device__ __forceinline__ void glds16(const void* gsrc, unsigned lds_dst) { unsigned keep;
    asm volatile("s_mov_b32 %0, m0\n\ts_mov_b32 m0, %2\n\ts_nop 0\n\tglobal_load_lds_dwordx4 %1, off\n\ts_mov_b32 m0, %0" : "=&s"(keep) : "v"(gsrc), "s"(lds_dst) : "memory"); }
template <int MODE>
__device__ __forceinline__ void issue_k(lptr lds, int kbyte, int row0, const Tensors& T, int head, int wid, int lane) {
    typedef Cfg<MODE> C;
#pragma unroll
    for (int q = 0; q < (C::NKCH + 7) / 8; ++q) {
        int p = wid + 8 * q; if (p >= C::NKCH) p -= 8;
        const bf16_t* src; const size_t row = (size_t)(row0 + lane);
        if (MODE == MLA) src = (p < 8) ? T.k + row * 1024 + head * 128 + p * 8 : T.k2 + row * 256 + 128 + (p - 8) * 8;
        else if (MODE == SWA) src = T.k + row * 256 + (head >> 2) * 64 + p * 8;
        else {
            const int r = 4 * p + (lane >> 4), sl = lane & 15;
            src = T.k + (size_t)(row0 + r) * 3072 + 1024 + head * 128 + ((sl ^ (r & 15)) * 8);
        }
        glds16(src, (unsigned)__builtin_amdgcn_readfirstlane((int)(unsigned)(size_t)(lds + kbyte + p * 1024)));
    }
}
template <int MODE>
__device__ __forceinline__ void issue_v(lptr lds, int vbyte, int row0, const Tensors& T, int head, int wid, int lane) {
    typedef Cfg<MODE> C;
#pragma unroll
    for (int q = 0; q < C::DV / 64; ++q) {
        const int p = wid + 8 * q;
        const size_t row = (size_t)(row0 + 16 * (p & 3) + (lane >> 2)); const int col = (p >> 2) * 32 + (lane & 3) * 8;
        const bf16_t* src;
        if (MODE == MLA) src = T.v + row * 1024 + head * 128 + 64 + col;
        else if (MODE == SWA) src = T.v + row * 256 + 128 + (head >> 2) * 64 + col;
        else {
            const int r = 4 * p + (lane >> 4), sl = lane & 15;
            src = T.v + (size_t)(row0 + r) * 3072 + 2048 + head * 128 + ((((sl >> 2) ^ (r & 3)) * 4 + (sl & 3)) * 8);
        }
        glds16(src, (unsigned)__builtin_amdgcn_readfirstlane((int)(unsigned)(size_t)(lds + vbyte + p * 1024)));
    }
}
template <int MODE>
__device__ __forceinline__ void attn_unit_p(lptr lds, const Unit& U, const Tensors& T, int wv) {
    typedef Cfg<MODE> C;
    constexpr int KB = C::NKCH * 1024, VB = C::DV * 128, NKS = C::DQK / 16, ND = C::DV / 32;
    constexpr float THR = 8.0f;
    const int tid = opaque_tid(wv), lane = tid & 63, r32 = lane & 31, hi = lane >> 5; const int wid = __builtin_amdgcn_readfirstlane(tid >> 6);
    const int br = (MODE == DIFF) ? (wid >> 2) : 0;
    const int wq = (MODE == DIFF) ? (wid & 3) : wid;
    const int NT = U.nlat + 4;
#define TROW(j) ((j) < U.nlat ? U.lat_row0 + 64 * (j) : U.ctx_row0 + 64 * ((j) - U.nlat))
    issue_k<MODE>(lds, 0, TROW(0), T, U.head, wid, lane);
    issue_v<MODE>(lds, 2 * KB, TROW(0), T, U.head, wid, lane);
    issue_k<MODE>(lds, KB, TROW(1), T, U.head, wid, lane);
    bf16x8 qf[NKS];
    {
        const size_t qrow = (size_t)(U.qrow0 + wq * 32 + r32);
        const bf16_t* qp;
        if (MODE == MLA) qp = T.q + qrow * 768 + U.head * 96 + hi * 8;
        else if (MODE == SWA) qp = T.q + qrow * 512 + U.head * 64 + hi * 8;
        else qp = T.q + qrow * 3072 + U.head * 128 + br * 64 + hi * 8;
#pragma unroll
        for (int ks = 0; ks < NKS; ++ks) qf[ks] = *(const GAS bf16x8*)(qp + ks * 16);
    }
    f32x16 o[ND];
#pragma unroll
    for (int d = 0; d < ND; ++d) o[d] = f32x16{};
    float mref = -INFINITY, l = 0.f;
    const float c2 = T.c2;
    const int koff = (MODE == DIFF ? br * 8192 : 0) + hi * 1024 + r32 * 16;
    const int voff = ((lane >> 4) & 1) * 32 + (lane & 3) * 8 + (4 * hi + ((lane & 15) >> 2)) * 64;
#define QKT(D0, D1, KBUF) do { const lptr kb_ = lds + (KBUF) * KB + koff; D0 = f32x16{}; D1 = f32x16{}; \
        _Pragma("unroll") for (int ks = 0; ks < NKS; ++ks) { const bf16x8 k0_ = *(const LAS bf16x8*)(kb_ + ks * 2048), k1_ = *(const LAS bf16x8*)(kb_ + ks * 2048 + 512); \
            D0 = __builtin_amdgcn_mfma_f32_32x32x16_bf16(k0_, qf[ks], D0, 0, 0, 0); D1 = __builtin_amdgcn_mfma_f32_32x32x16_bf16(k1_, qf[ks], D1, 0, 0, 0); } } while (0)
#define SOFTMAX_PV(VBUF) do { \
        float mt_ = fmaxf(s0[0], s1[0]); \
        _Pragma("unroll") for (int r = 1; r < 16; ++r) mt_ = fmaxf(mt_, fmaxf(s0[r], s1[r])); \
        mt_ = fmaxf(mt_, xshfl<32>(mt_)) * c2; \
        if (__builtin_amdgcn_ballot_w64(mt_ > mref + THR) != 0ull) { \
            const float mn_ = fmaxf(mref, mt_); const float mu_ = (mn_ == -INFINITY) ? 0.f : mn_; const float alpha_ = __builtin_amdgcn_exp2f(mref - mu_); \
            mref = mn_; l *= alpha_; \
            _Pragma("unroll") for (int d = 0; d < ND; ++d) _Pragma("unroll") for (int r = 0; r < 16; ++r) o[d][r] *= alpha_; } \
        const float mu2_ = (mref == -INFINITY) ? 0.f : mref; float ps_ = 0.f; \
        _Pragma("unroll") for (int r = 0; r < 16; ++r) { s0[r] = __builtin_amdgcn_exp2f(s0[r] * c2 - mu2_); s1[r] = __builtin_amdgcn_exp2f(s1[r] * c2 - mu2_); ps_ += s0[r] + s1[r]; } \
        l += ps_; \
        bf16x8 pw_[4]; { u32x4 w_; \
          w_.x = pk2(s0[0], s0[1]); w_.y = pk2(s0[2], s0[3]); w_.z = pk2(s0[4], s0[5]); w_.w = pk2(s0[6], s0[7]); pw_[0] = __builtin_bit_cast(bf16x8, w_); \
          w_.x = pk2(s0[8], s0[9]); w_.y = pk2(s0[10], s0[11]); w_.z = pk2(s0[12], s0[13]); w_.w = pk2(s0[14], s0[15]); pw_[1] = __builtin_bit_cast(bf16x8, w_); \
          w_.x = pk2(s1[0], s1[1]); w_.y = pk2(s1[2], s1[3]); w_.z = pk2(s1[4], s1[5]); w_.w = pk2(s1[6], s1[7]); pw_[2] = __builtin_bit_cast(bf16x8, w_); \
          w_.x = pk2(s1[8], s1[9]); w_.y = pk2(s1[10], s1[11]); w_.z = pk2(s1[12], s1[13]); w_.w = pk2(s1[14], s1[15]); pw_[3] = __builtin_bit_cast(bf16x8, w_); } \
        const lptr vb_ = lds + 2 * KB + (VBUF) * VB + voff; \
        _Pragma("unroll") for (int d = 0; d < ND; ++d) _Pragma("unroll") for (int kk = 0; kk < 4; ++kk) { \
            const s16x4 lo_ = vtr(vb_ + d * 4096 + kk * 1024), hh_ = vtr(vb_ + d * 4096 + kk * 1024 + 512); \
            const bf16x8 vf_ = (bf16x8){lo_[0], lo_[1], lo_[2], lo_[3], hh_[0], hh_[1], hh_[2], hh_[3]}; \
            o[d] = __builtin_amdgcn_mfma_f32_32x32x16_bf16(vf_, pw_[kk], o[d], 0, 0, 0); } } while (0)
    asm volatile("s_waitcnt vmcnt(0)" ::: "memory");
    __syncthreads();
    f32x16 s0, s1;
    QKT(s0, s1, 0);
    __syncthreads();
    for (int j = 0; j + 1 < NT; ++j) {
        if (j + 2 < NT) issue_k<MODE>(lds, (j & 1) * KB, TROW(j + 2), T, U.head, wid, lane);
        issue_v<MODE>(lds, 2 * KB + ((j + 1) & 1) * VB, TROW(j + 1), T, U.head, wid, lane);
        f32x16 n0, n1;
        QKT(n0, n1, (j + 1) & 1);
        SOFTMAX_PV(j & 1);
        s0 = n0; s1 = n1;
        asm volatile("s_waitcnt vmcnt(0)" ::: "memory");
        __syncthreads();
    }
    SOFTMAX_PV((NT - 1) & 1);
    __syncthreads();
#undef TROW
#undef QKT
#undef SOFTMAX_PV
    l += xshfl<32>(l);
    const float inv = 1.0f / l;
#pragma unroll
    for (int d = 0; d < ND; ++d)
#pragma unroll
        for (int r = 0; r < 16; ++r) o[d][r] *= inv;
    const size_t orow = (size_t)(U.qrow0 + wq * 32 + r32);
    if (MODE == DIFF) {
        LAS float* xch = (LAS float*)lds + (size_t)(wid & 3) * 4096 + lane;
        if (br == 1) {
#pragma unroll
            for (int d = 0; d < ND; ++d)
#pragma unroll
                for (int r = 0; r < 16; ++r) xch[(d * 16 + r) * 64] = o[d][r];
        }
        __syncthreads();
        if (br == 0) {
            float ss = 0.f;
#pragma unroll
            for (int d = 0; d < ND; ++d)
#pragma unroll
                for (int r = 0; r < 16; ++r) { const float v = o[d][r] - T.lam * xch[(d * 16 + r) * 64]; o[d][r] = v; ss += v * v; }
            ss += xshfl<32>(ss);
            const float rs = __builtin_amdgcn_rsqf(ss * (1.0f / 128.0f) + DIFF_EPS) * T.post;
            bf16_t* op = T.o + orow * 1024 + U.head * 128;
#pragma unroll
            for (int d = 0; d < ND; ++d)
#pragma unroll
                for (int g = 0; g < 4; ++g) {
                    const int dv0 = 32 * d + 8 * g + 4 * hi; const f32x4 gn = *(const GAS f32x4*)(T.subln + dv0);
                    u32x2 w; w.x = pk2(o[d][4 * g] * rs * gn[0], o[d][4 * g + 1] * rs * gn[1]); w.y = pk2(o[d][4 * g + 2] * rs * gn[2], o[d][4 * g + 3] * rs * gn[3]);
                    *(GAS u32x2*)(op + dv0) = w;
                }
        }
        __syncthreads();
    } else {
        bf16_t* op = T.o + orow * 1024 + (MODE == MLA ? 512 + U.head * 64 : U.head * 64);
#pragma unroll
        for (int d = 0; d < ND; ++d)
#pragma unroll
            for (int g = 0; g < 4; ++g) {
                const int dv0 = 32 * d + 8 * g + 4 * hi;
                u32x2 w; w.x = pk2(o[d][4 * g], o[d][4 * g + 1]); w.y = pk2(o[d][4 * g + 2], o[d][4 * g + 3]);
                *(GAS u32x2*)(op + dv0) = w;
            }
    }
}

template <int MODE, bool GUARDED>
__device__ __forceinline__ bool attn_unit_q(lptr lds, const Unit& U, const Tensors& T, int wv) {
    typedef Cfg<MODE> C;
    constexpr int KB = C::NKCH * 1024, VB = C::DV * 128, NKS = C::DQK / 16, ND = C::DV / 32;
    constexpr int NQK = 2 * NKS, NPV = 4 * ND;
    constexpr int EA = GUARDED ? 0 : ((MODE == MLA) ? 18 : 8);
    const int tid = opaque_tid(wv), lane = tid & 63, r32 = lane & 31, hi = lane >> 5; const int wid = __builtin_amdgcn_readfirstlane(tid >> 6);
    const int br = (MODE == DIFF) ? (wid >> 2) : 0;
    const int wq = (MODE == DIFF) ? (wid & 3) : wid;
    const int NT = U.nlat + 4;
#define TROW(j) ((j) < U.nlat ? U.lat_row0 + 64 * (j) : U.ctx_row0 + 64 * ((j) - U.nlat))
#define SBAR() __builtin_amdgcn_sched_barrier(0)
    issue_k<MODE>(lds, 0, TROW(0), T, U.head, wid, lane);
    issue_k<MODE>(lds, KB, TROW(1), T, U.head, wid, lane);
    issue_k<MODE>(lds, 2 * KB, TROW(2), T, U.head, wid, lane);
    issue_v<MODE>(lds, 3 * KB, TROW(0), T, U.head, wid, lane);
    bf16x8 qf[NKS];
    {
        const size_t qrow = (size_t)(U.qrow0 + wq * 32 + r32);
        const bf16_t* qp;
        if (MODE == MLA) qp = T.q + qrow * 768 + U.head * 96 + hi * 8;
        else qp = T.q + qrow * 3072 + U.head * 128 + br * 64 + hi * 8;
#pragma unroll
        for (int ks = 0; ks < NKS; ++ks) qf[ks] = *(const GAS bf16x8*)(qp + ks * 16);
    }
    f32x16 o[ND];
#pragma unroll
    for (int d = 0; d < ND; ++d) o[d] = f32x16{};
    float mref = 0.f, mtrue = -INFINITY, l = 0.f; bool general = false;
    constexpr float GUARD = 64.0f;
    const int x15 = r32 & 15, q4 = (lane & 15) >> 2;
    const int koff = (MODE == DIFF) ? (r32 * 256 + ((br ^ (x15 >> 3)) * 128) + ((hi ^ (x15 & 1)) * 16)) : (hi * 1024 + r32 * 16);
    const int kx = (x15 >> 1) & 3;
    const int voff = (MODE == DIFF) ? ((4 * hi + q4) * 256 + ((lane >> 4) & 1) * 32 + (lane & 3) * 8) : (((lane >> 4) & 1) * 32 + (lane & 3) * 8 + (4 * hi + q4) * 64);
    f32x16 sA0, sA1, sB0, sB1;
    u32x4 pA[4], pB[4];
    float alpha = 1.f, negmu = 0.f; bool need = false; float psa = 0.f, psb = 0.f;
#define KFRAG(KBUF, i) ((MODE == DIFF) ? *(const LAS bf16x8*)(lds + (KBUF) + koff + ((((i) >> 1) ^ kx) * 32) + ((i) & 1) * 8192) : *(const LAS bf16x8*)(lds + (KBUF) + koff + ((i) >> 1) * 2048 + ((i) & 1) * 512))
#define EXPS(E0, E1, sc0, sc1, pkn) do { _Pragma("unroll") for (int e = (E0); e < (E1); ++e) { float p_; if (e < 16) { p_ = __builtin_amdgcn_exp2f(sc0[e & 15]); sc0[e & 15] = p_; } else { p_ = __builtin_amdgcn_exp2f(sc1[e & 15]); sc1[e & 15] = p_; } \
            if (e & 1) { psb += p_; const float q_ = (e < 16) ? sc0[(e - 1) & 15] : sc1[(e - 1) & 15]; unsigned w_ = pk2(q_, p_); asm volatile("" : "+v"(w_), "+v"(psa), "+v"(psb));   pkn[e >> 3][(e >> 1) & 3] = w_; } else psa += p_; } } while (0)
#define BLOCK_A(KBUF, DOMAX, n0, n1, sc0, sc1, pkn, DOEXPA) do { \
        bf16x8 kf_[3]; kf_[0] = KFRAG(KBUF, 0); kf_[1] = KFRAG(KBUF, 1); SBAR(); \
        _Pragma("unroll") for (int i = 0; i < NQK; ++i) { \
            if (i + 2 < NQK) kf_[(i + 2) % 3] = KFRAG(KBUF, i + 2); \
            if ((i & 1) == 0) n0 = __builtin_amdgcn_mfma_f32_32x32x16_bf16(kf_[i % 3], qf[i >> 1], (i < 2) ? f32x16{} : n0, 0, 0, 0); \
            else              n1 = __builtin_amdgcn_mfma_f32_32x32x16_bf16(kf_[i % 3], qf[i >> 1], (i < 2) ? f32x16{} : n1, 0, 0, 0); \
            if (GUARDED && DOMAX) { _Pragma("unroll") for (int e = (i * 32) / NQK; e < ((i + 1) * 32) / NQK; ++e) { const float x_ = (e < 16) ? sc0[e & 15] : sc1[e & 15]; if (e & 1) mb = fmaxf(mb, x_); else ma = fmaxf(ma, x_); } } \
            if (DOEXPA && EA > 0) EXPS((i * EA) / NQK, ((i + 1) * EA) / NQK, sc0, sc1, pkn); \
            SBAR(); } \
        if (DOEXPA && EA > 0) { l += psa + psb; psa = 0.f; psb = 0.f; } } while (0)
#define DECIDE() do { if (!GUARDED) break; float mt_ = fmaxf(ma, mb); mt_ = fmaxf(mt_, xshfl<32>(mt_)); mtrue = fmaxf(mtrue, mt_); \
        need = __builtin_amdgcn_ballot_w64((mt_ - mref > GUARD) || (mtrue - mref < -GUARD)) != 0ull; alpha = 1.f; \
        if (need) { const float mn_ = (mtrue == -INFINITY) ? mref : mtrue; alpha = __builtin_amdgcn_exp2f(fminf(mref - mn_, 126.0f)); mref = mn_; l *= alpha; general = true; } \
        negmu = -mref; } while (0)
#define VFRAG(DST, VBUF, i) do { const lptr vp_ = (MODE == DIFF) ? (lds + (VBUF) + voff + ((((i) >> 2) ^ q4) * 64) + ((i) & 3) * 4096) : (lds + (VBUF) + voff + ((i) >> 2) * 4096 + ((i) & 3) * 1024);     const s16x4 lo_ = vtr(vp_), hh_ = vtr(vp_ + ((MODE == DIFF) ? 2048 : 512)); \
        DST = (bf16x8){lo_[0], lo_[1], lo_[2], lo_[3], hh_[0], hh_[1], hh_[2], hh_[3]}; } while (0)
#define BLOCK_B(VBUF, DOPV, DOEXP, sc0, sc1, pk, pkn, ELO) do { \
        if (GUARDED && DOEXP && general) { _Pragma("unroll") for (int e = 0; e < 16; ++e) { sc0[e] += negmu; sc1[e] += negmu; } }     \
        if (DOPV) { bf16x8 vf_[3]; VFRAG(vf_[0], VBUF, 0); VFRAG(vf_[1], VBUF, 1); SBAR(); \
            _Pragma("unroll") for (int i = 0; i < NPV; ++i) { \
                if (i + 2 < NPV) VFRAG(vf_[(i + 2) % 3], VBUF, i + 2); \
                o[i >> 2] = __builtin_amdgcn_mfma_f32_32x32x16_bf16(vf_[i % 3], __builtin_bit_cast(bf16x8, pk[i & 3]), o[i >> 2], 0, 0, 0); \
                if (DOEXP) EXPS((ELO) + (i * (32 - (ELO))) / NPV, (ELO) + ((i + 1) * (32 - (ELO))) / NPV, sc0, sc1, pkn); \
                SBAR(); } } \
        else if (DOEXP) EXPS((ELO), 32, sc0, sc1, pkn); \
        if (DOEXP) { l += psa + psb; psa = 0.f; psb = 0.f; } } while (0)
#define RESCALE_O() do { if (GUARDED && need) { _Pragma("unroll") for (int d = 0; d < ND; ++d) _Pragma("unroll") for (int r = 0; r < 16; ++r) o[d][r] *= alpha; } } while (0)
    constexpr int NDMA = (C::NKCH + 7) / 8 + C::DV / 64;
#define WAIT_BAR_KEEP() do { if (NDMA == 4) asm volatile("s_waitcnt vmcnt(4) lgkmcnt(0)\n\ts_barrier" ::: "memory"); else asm volatile("s_waitcnt vmcnt(3) lgkmcnt(0)\n\ts_barrier" ::: "memory"); } while (0)
#define WAIT_BAR_ALL() asm volatile("s_waitcnt vmcnt(0) lgkmcnt(0)\n\ts_barrier" ::: "memory")
    if (wid >= 4) __builtin_amdgcn_s_setprio(1);
    WAIT_BAR_ALL();
    { float ma = -INFINITY, mb = -INFINITY; (void)ma; (void)mb; BLOCK_A(0, false, sA0, sA1, sA0, sA1, pA, false); }
    WAIT_BAR_ALL();
    int kn = KB;
#define VSLOT(t) (3 * KB + (((t) & 3) * VB))
#define KNEXT() do { kn = (kn == 2 * KB) ? 0 : kn + KB; } while (0)
#define ISSUE(j_) do { const int kfree = (kn == 0) ? 2 * KB : kn - KB; if ((j_) + 3 < NT) issue_k<MODE>(lds, kfree, TROW((j_) + 3), T, U.head, wid, lane); \
        issue_v<MODE>(lds, VSLOT((j_) + 1), TROW((j_) + 1), T, U.head, wid, lane); } while (0)
#define ENDW(j_) do { if ((j_) + 3 < NT) WAIT_BAR_KEEP(); else WAIT_BAR_ALL(); } while (0)
    if (wid < 4) {
        {
            float ma = -INFINITY, mb = -INFINITY;
            BLOCK_A(kn, true, sB0, sB1, sA0, sA1, pA, true);
            issue_k<MODE>(lds, 0, TROW(3), T, U.head, wid, lane); issue_v<MODE>(lds, VSLOT(1), TROW(1), T, U.head, wid, lane);
            DECIDE();
            BLOCK_B(0, false, true, sA0, sA1, pB, pA, EA);
            WAIT_BAR_KEEP(); KNEXT();
        }
#define STEP1(j_, N0, N1, SC0, SC1, PK, PKN) do { float ma = -INFINITY, mb = -INFINITY; \
            BLOCK_A(kn, true, N0, N1, SC0, SC1, PKN, true); ISSUE(j_); DECIDE(); BLOCK_B(VSLOT((j_) - 1), true, true, SC0, SC1, PK, PKN, EA); RESCALE_O(); ENDW(j_); KNEXT(); } while (0)
        for (int j = 1; j + 1 < NT; j += 2) { STEP1(j, sA0, sA1, sB0, sB1, pA, pB); STEP1(j + 1, sB0, sB1, sA0, sA1, pB, pA); }
#undef STEP1
        {
            float ma = -INFINITY, mb = -INFINITY;
            if (GUARDED) {
#pragma unroll
                for (int e = 0; e < 16; ++e) { ma = fmaxf(ma, sB0[e]); mb = fmaxf(mb, sB1[e]); } }
            DECIDE();
            BLOCK_B(VSLOT(NT - 2), true, true, sB0, sB1, pA, pB, 0);
            RESCALE_O();
            BLOCK_B(VSLOT(NT - 1), true, false, sB0, sB1, pB, pA, 0);
        }
    } else {
        float mcar;
        {
            float ma = -INFINITY, mb = -INFINITY;
            issue_k<MODE>(lds, 0, TROW(3), T, U.head, wid, lane); issue_v<MODE>(lds, VSLOT(1), TROW(1), T, U.head, wid, lane);
            BLOCK_A(kn, true, sB0, sB1, sA0, sA1, pA, true);
            mcar = fmaxf(ma, mb);
            WAIT_BAR_KEEP(); KNEXT();
        }
#define STEP2(j_, SC0, SC1, PK, PKN, SM0, SM1, DOPV) do { float ma = mcar, mb = mcar; \
            ISSUE(j_); DECIDE(); BLOCK_B(VSLOT((j_) - 2), DOPV, true, SC0, SC1, PK, PKN, EA); RESCALE_O(); \
            ma = -INFINITY; mb = -INFINITY; BLOCK_A(kn, true, SC0, SC1, SM0, SM1, PK, true); mcar = fmaxf(ma, mb); ENDW(j_); KNEXT(); } while (0)
        STEP2(1, sA0, sA1, pB, pA, sB0, sB1, false);
        STEP2(2, sB0, sB1, pA, pB, sA0, sA1, true);
        for (int j = 3; j + 1 < NT; j += 2) { STEP2(j, sA0, sA1, pB, pA, sB0, sB1, true); STEP2(j + 1, sB0, sB1, pA, pB, sA0, sA1, true); }
#undef STEP2
        {
            float ma = mcar, mb = mcar;
            DECIDE();
            BLOCK_B(VSLOT(NT - 3), true, true, sA0, sA1, pB, pA, EA);
            RESCALE_O();
            ma = -INFINITY; mb = -INFINITY;
            if (GUARDED) {
#pragma unroll
                for (int e = 0; e < 16; ++e) { ma = fmaxf(ma, sB0[e]); mb = fmaxf(mb, sB1[e]); } }
            DECIDE();
            BLOCK_B(VSLOT(NT - 2), true, true, sB0, sB1, pA, pB, 0);
            RESCALE_O();
            BLOCK_B(VSLOT(NT - 1), true, false, sB0, sB1, pB, pA, 0);
        }
    }
#undef VSLOT
#undef KNEXT
#undef ISSUE
#undef ENDW
    __builtin_amdgcn_s_setprio(0);
    WAIT_BAR_ALL();
#undef WAIT_BAR_KEEP
#undef WAIT_BAR_ALL
#undef TROW
#undef SBAR
#undef KFRAG
#undef BLOCK_A
#undef DECIDE
#undef VFRAG
#undef EXPS
#undef BLOCK_B
#undef RESCALE_O
    l += xshfl<32>(l);
    if (!GUARDED) {
        float oa = 0.f;
#pragma unroll
        for (int d = 0; d < ND; ++d)
#pragma unroll
            for (int r = 0; r < 16; ++r) oa += __builtin_fabsf(o[d][r]);
        const bool badl = !(l > 0x1p-100f && l < 0x1p100f) || !(oa < 0x1p120f);
        LAS unsigned* flg = (LAS unsigned*)(lds + LDS_MISC + 4608);
        const bool wbad = __builtin_amdgcn_ballot_w64(badl) != 0ull;
        if (lane == 0) flg[wid] = wbad ? 1u : 0u;
        __syncthreads();
        unsigned anyb = 0u;
#pragma unroll
        for (int w = 0; w < 8; ++w) anyb |= flg[w];
        __syncthreads();
        if (__builtin_amdgcn_readfirstlane(anyb) != 0u) return true;
    }
    const float inv = 1.0f / l;
#pragma unroll
    for (int d = 0; d < ND; ++d)
#pragma unroll
        for (int r = 0; r < 16; ++r) o[d][r] *= inv;
    const size_t orow = (size_t)(U.qrow0 + wq * 32 + r32);
    if (MODE == DIFF) {
        LAS float* xch = (LAS float*)lds + (size_t)(wid & 3) * 4096 + lane;
        if (br == 1) {
#pragma unroll
            for (int d = 0; d < ND; ++d)
#pragma unroll
                for (int r = 0; r < 16; ++r) xch[(d * 16 + r) * 64] = o[d][r];
        }
        __syncthreads();
        if (br == 0) {
            float ss = 0.f;
#pragma unroll
            for (int d = 0; d < ND; ++d)
#pragma unroll
                for (int r = 0; r < 16; ++r) { const float v = o[d][r] - T.lam * xch[(d * 16 + r) * 64]; o[d][r] = v; ss += v * v; }
            ss += xshfl<32>(ss);
            const float rs = __builtin_amdgcn_rsqf(ss * (1.0f / 128.0f) + DIFF_EPS) * T.post;
            bf16_t* op = T.o + orow * 1024 + U.head * 128;
#pragma unroll
            for (int d = 0; d < ND; ++d)
#pragma unroll
                for (int g = 0; g < 4; g += 2) {
                    u32x2 wa, wb;
                    { const int dv0 = 32 * d + 8 * g + 4 * hi; const f32x4 gn = *(const GAS f32x4*)(T.subln + dv0);
                      wa.x = pk2(o[d][4 * g] * rs * gn[0], o[d][4 * g + 1] * rs * gn[1]); wa.y = pk2(o[d][4 * g + 2] * rs * gn[2], o[d][4 * g + 3] * rs * gn[3]); }
                    { const int dv1 = 32 * d + 8 * (g + 1) + 4 * hi; const f32x4 gn = *(const GAS f32x4*)(T.subln + dv1);
                      wb.x = pk2(o[d][4 * g + 4] * rs * gn[0], o[d][4 * g + 5] * rs * gn[1]); wb.y = pk2(o[d][4 * g + 6] * rs * gn[2], o[d][4 * g + 7] * rs * gn[3]); }
                    const auto rx = __builtin_amdgcn_permlane32_swap(wa.x, wb.x, false, false); const auto ry = __builtin_amdgcn_permlane32_swap(wa.y, wb.y, false, false);
                    *(GAS u32x4*)(op + 32 * d + 8 * g + 8 * hi) = (u32x4){rx[0], ry[0], rx[1], ry[1]};
                }
        }
        __syncthreads();
    } else {
        bf16_t* op = T.o + orow * 1024 + 512 + U.head * 64;
#pragma unroll
        for (int d = 0; d < ND; ++d)
#pragma unroll
            for (int g = 0; g < 4; g += 2) {
                u32x2 wa, wb; wa.x = pk2(o[d][4 * g], o[d][4 * g + 1]); wa.y = pk2(o[d][4 * g + 2], o[d][4 * g + 3]); wb.x = pk2(o[d][4 * g + 4], o[d][4 * g + 5]); wb.y = pk2(o[d][4 * g + 6], o[d][4 * g + 7]);
                const auto rx = __builtin_amdgcn_permlane32_swap(wa.x, wb.x, false, false); const auto ry = __builtin_amdgcn_permlane32_swap(wa.y, wb.y, false, false);
                *(GAS u32x4*)(op + 32 * d + 8 * g + 8 * hi) = (u32x4){rx[0], ry[0], rx[1], ry[1]};
            }
    }
    return false;
}
}

#define LDS_WAIT() asm volatile("s_waitcnt lgkmcnt(0)" ::: "memory")
template <class F> __device__ __forceinline__ void tr_generic_item(const F& f, int Kpad, bf16_t* WT, LAS float* scr, int kb, int nb, int lane) {
    const int k0 = 64 * kb, n0 = 32 * nb;
    float fv[32];
#pragma unroll
    for (int i = 0; i < 32; ++i) fv[i] = f(k0 + 2 * i + (lane >> 5), n0 + (lane & 31));
#pragma unroll
    for (int i = 0; i < 32; ++i) { const int kk = 2 * i + (lane >> 5); scr[kk * 33 + (lane & 31)] = fv[i]; }
    LDS_WAIT();
    const int c = lane & 7;
#pragma unroll
    for (int j = 0; j < 4; ++j) { const int n = (lane >> 3) + 8 * j; const LAS float* s = scr + (8 * c) * 33 + n;
        u32x4 o; o.x = pk2(s[0 * 33], s[1 * 33]); o.y = pk2(s[2 * 33], s[3 * 33]); o.z = pk2(s[4 * 33], s[5 * 33]); o.w = pk2(s[6 * 33], s[7 * 33]);
        *(GAS u32x4*)(WT + (size_t)(n0 + n) * Kpad + k0 + 8 * c) = o; }
    LDS_WAIT();
}
struct FWinEven { const float* W;
    __device__ __forceinline__ float operator()(int k, int n) const {
        int oc;
        if (n < 640) { const int blk = n >> 6, d = n & 63; oc = blk * 64 + (d & 1) * 32 + (d >> 1); }
        else if (n < 1152) oc = n;
        else if (n < 1184) { const int d = n - 1152; oc = 1152 + (d & 1) * 16 + (d >> 1); }
        else return 0.f;
        return W[(size_t)k * 1184 + oc];
    } };
struct FWuq { const float* W; const float* g;
    __device__ __forceinline__ float operator()(int k, int n) const {
        const int h = n / 96, d = n - h * 96; int oc;
        if (d < 64) oc = h * 96 + d; else { const int dd = d - 64; oc = h * 96 + 64 + (dd & 1) * 16 + (dd >> 1); }
        return W[(size_t)k * 768 + oc] * g[k];
    } };
struct FWukv { const float* W; const float* g;
    __device__ __forceinline__ float operator()(int k, int n) const { return k < 128 ? W[(size_t)k * 1024 + n] * g[k] : 0.f; } };
struct FPlain { const float* W; int N;
    __device__ __forceinline__ float operator()(int k, int n) const { return W[(size_t)k * N + n]; } };
struct FWinOdd { const float* W;
    __device__ __forceinline__ float operator()(int k, int n) const {
        int oc = n; if (n < 2048) { const int blk = n >> 6, d = n & 63; oc = blk * 64 + (d & 1) * 32 + (d >> 1); }
        return W[(size_t)k * 3072 + oc];
    } };
__device__ __forceinline__ void tr_expert_item(int item, LAS float* scr, int lane, const float* w1, const float* w3, const float* w2, bf16_t* W13, bf16_t* W2T) {
    const int q = lane & 15, kr = lane >> 4;
    bf16_t* dst; int Kd, k0, n0;
    if (item < 32768) {
        const int le = item >> 8, kb = (item >> 4) & 15, nb = item & 15; k0 = kb * 64; n0 = nb * 64; Kd = 1024;
        const float* src = ((q < 8) ? w1 : w3) + (size_t)le * 1024 * 512 + (n0 >> 1) + 4 * (q & 7);
        f32x4 v[16];
#pragma unroll
        for (int i = 0; i < 16; ++i) v[i] = *(const GAS f32x4*)(src + (size_t)(k0 + 4 * i + kr) * 512);
#pragma unroll
        for (int i = 0; i < 16; ++i) { const int kk = 4 * i + kr; LAS float* p = scr + kk * 65 + 8 * (q & 7) + (q >> 3); p[0] = v[i][0]; p[2] = v[i][1]; p[4] = v[i][2]; p[6] = v[i][3]; }
        dst = W13 + (size_t)le * 1024 * 1024;
    } else {
        const int it = item - 32768, le = it >> 7, kb = (it >> 4) & 7, nb = it & 15; k0 = kb * 64; n0 = nb * 64; Kd = 512;
        const float* src = w2 + (size_t)le * 512 * 1024 + n0 + 4 * q;
        f32x4 v[16];
#pragma unroll
        for (int i = 0; i < 16; ++i) v[i] = *(const GAS f32x4*)(src + (size_t)(k0 + 4 * i + kr) * 1024);
#pragma unroll
        for (int i = 0; i < 16; ++i) { const int kk = 4 * i + kr; LAS float* p = scr + kk * 65 + 4 * q; p[0] = v[i][0]; p[1] = v[i][1]; p[2] = v[i][2]; p[3] = v[i][3]; }
        dst = W2T + (size_t)le * 1024 * 512;
    }
    LDS_WAIT();
    const int c = lane & 7;
#pragma unroll
    for (int j = 0; j < 8; ++j) { const int n = (lane >> 3) + 8 * j; const LAS float* s = scr + (8 * c) * 65 + n;
        u32x4 o; o.x = pk2(s[0 * 65], s[1 * 65]); o.y = pk2(s[2 * 65], s[3 * 65]); o.z = pk2(s[4 * 65], s[5 * 65]); o.w = pk2(s[6 * 65], s[7 * 65]);
        *(GAS u32x4*)(dst + (size_t)(n0 + n) * Kd + k0 + 8 * c) = o; }
    LDS_WAIT();
}

__device__ __forceinline__ void prologue_a(lptr lds, int vcu, int G, int wv) {
    const int tid = opaque_tid(wv), lane = tid & 63, wave = __builtin_amdgcn_readfirstlane(tid >> 6);
    unsigned char* ws = parg(lds, 31);
    const int gw = vcu * NWAVES + wave, NGW = G * NWAVES;
    LAS float* scr = (LAS float*)(lds + wave * 16640);
    for (int it = gw; it < 49152; it += NGW) tr_expert_item(it, scr, lane, pin(lds, 26), pin(lds, 27), pin(lds, 28), (bf16_t*)(ws + WS_W13), (bf16_t*)(ws + WS_W2T));
    for (int it = gw; it < 6848; it += NGW) {
        const int j = it / 3424; int r = it - j * 3424;
        if (r < 640) { FWinEven f{pin(lds, 8) + (size_t)j * 1024 * 1184}; tr_generic_item(f, 1024, (bf16_t*)(ws + WS_WINE) + (size_t)j * 1280 * 1024, scr, r / 40, r % 40, lane); continue; } r -= 640;
        if (r < 96) { FWuq f{pin(lds, 10) + (size_t)j * 256 * 768, pin(lds, 9) + j * 256}; tr_generic_item(f, 256, (bf16_t*)(ws + WS_WUQ) + (size_t)j * 768 * 256, scr, r / 24, r % 24, lane); continue; } r -= 96;
        if (r < 128) { FWukv f{pin(lds, 12) + (size_t)j * 128 * 1024, pin(lds, 11) + j * 128}; tr_generic_item(f, 256, (bf16_t*)(ws + WS_WUKV) + (size_t)j * 1024 * 256, scr, r / 32, r % 32, lane); continue; } r -= 128;
        if (r < 512) { FPlain f{pin(lds, 14) + (size_t)j * 1024 * 1024, 1024}; tr_generic_item(f, 1024, (bf16_t*)(ws + WS_WOUTE) + (size_t)j * 1024 * 1024, scr, r / 32, r % 32, lane); continue; } r -= 512;
        if (r < 1536) { FWinOdd f{pin(lds, 15) + (size_t)j * 1024 * 3072}; tr_generic_item(f, 1024, (bf16_t*)(ws + WS_WINO) + (size_t)j * 3072 * 1024, scr, r / 96, r % 96, lane); continue; } r -= 1536;
        { FPlain f{pin(lds, 21) + (size_t)j * 1024 * 1024, 1024}; tr_generic_item(f, 1024, (bf16_t*)(ws + WS_WOUTO) + (size_t)j * 1024 * 1024, scr, r / 32, r % 32, lane); }
    }
    {
        const int gt = gw * 64 + lane;
        if (gt < 512) ((unsigned*)(ws + WS_H + (size_t)ZROW * DM * 2))[gt] = 0u;
    }
    {
        float* modp = (float*)(ws + WS_MODP);
        const float* adaw = pin(lds, 6); const float* cvec = pin(lds, 1); const float* cctx = pin(lds, 3);
        __syncthreads();
        LAS float* sil = (LAS float*)lds;
        for (int i = tid; i < 17 * 1024; i += NTHREADS) { const int r = i >> 10, k = i & 1023; const float cv = (r < 16) ? cvec[r * 1024 + k] : cctx[k]; sil[k * 17 + r] = cv / (1.f + __expf(-cv)); }
        __syncthreads();
        for (int it = gw; it < 1536; it += NGW) {
            const int kq = it / 384, rem = it - kq * 384, l = rem / 96, nb = rem - l * 96; const int n = nb * 64 + lane;
            const float* w = adaw + ((size_t)l * 1024 + kq * 256) * 6144 + n;
            float acc[17];
#pragma unroll
            for (int r = 0; r < 17; ++r) acc[r] = 0.f;
#pragma unroll 8
            for (int k = 0; k < 256; ++k) {
                const float wv = w[(size_t)k * 6144];
                const LAS float* sp = sil + (kq * 256 + k) * 17;
#pragma unroll
                for (int r = 0; r < 17; ++r) acc[r] += sp[r] * wv;
            }
#pragma unroll
            for (int r = 0; r < 17; ++r) modp[(((size_t)kq * DEPTH + l) * 17 + r) * 6144 + n] = acc[r];
        }
    }
}
__device__ __forceinline__ void prologue_b(lptr lds, int vcu, int G, int wv) {
    const int tid = opaque_tid(wv), lane = tid & 63, wave = __builtin_amdgcn_readfirstlane(tid >> 6);
    const int gt = (vcu * NWAVES + wave) * 64 + lane, NGT = G * NWAVES * 64;
    unsigned char* ws = parg(lds, 31); const float* adab = pin(lds, 7);
    const float* modp = (const float*)(ws + WS_MODP); float* mod = (float*)(ws + WS_MOD);
    for (int i = gt; i < (int)MOD_ELEMS; i += NGT) { const int l = i / (17 * 6144), n = i % 6144;
        mod[i] = ((modp[i] + modp[MOD_ELEMS + i]) + (modp[2 * MOD_ELEMS + i] + modp[3 * MOD_ELEMS + i])) + adab[l * 6144 + n]; }
}

__device__ __forceinline__ void phase_norm_mix(lptr lds, int l, int vcu, int G, int wv, bool dry = false) {
    const int tid = opaque_tid(wv), lane = tid & 63, wave = __builtin_amdgcn_readfirstlane(tid >> 6);
    unsigned char* ws = parg(lds, 31); float* outp = (float*)parg(lds, 30); const float* xin = pin(lds, 0); const float* cin = pin(lds, 2);
    const float* mod = (const float*)(ws + WS_MOD);
    const int* tokd = (const int*)(ws + WS_TOKD); const bf16_t* yb = (const bf16_t*)(ws + WS_BIG + BG_YB);
    bf16_t* H = (bf16_t*)(ws + WS_H);
    bf16_t* xb = (bf16_t*)(ws + WS_XB);
    const int nrows = (l == DEPTH) ? NLAT : MTOT;
    const float* gain = (l == DEPTH) ? pin(lds, 29) : pin(lds, 4) + l * DM;
    const int RPW = nrows / G, row_lo = vcu * RPW; const int r_lo = mod_r(row_lo), r_hi = mod_r(row_lo + RPW - 1);
    LAS float* tab = (LAS float*)lds;
    for (int i = tid; i < 2048; i += NTHREADS) { const int t = i >> 10, c = i & 1023; const int r = t ? r_hi : r_lo;
        if (l > 0) tab[t * 3072 + c] = mod[((size_t)(l - 1) * 17 + r) * 6144 + 5 * 1024 + c];
        if (l < DEPTH) { const float* sh = mod + ((size_t)l * 17 + r) * 6144; tab[t * 3072 + 1024 + c] = gain[c] * (1.0f + sh[1024 + c]); tab[t * 3072 + 2048 + c] = sh[c]; }
        else tab[t * 3072 + 1024 + c] = gain[c]; }
    __syncthreads();
    const bool docomb = (l > 0);
    for (int k = wave; k < RPW / 2; k += NWAVES) {
        f32x4 v[2][4]; int dd[2][2]; const LAS float* tb[2];
#pragma unroll
        for (int q = 0; q < 2; ++q) {
            const int row = row_lo + 2 * k + q;
            tb[q] = tab + ((mod_r(row) == r_lo) ? 0 : 3072) + 4 * lane;
            if (docomb) { dd[q][0] = tokd[row * 2]; dd[q][1] = tokd[row * 2 + 1]; }
            if (l == 0) {
                const float* xs = (row < NLAT ? xin + (size_t)row * DM : cin + (size_t)(row - NLAT) * DM);
#pragma unroll
                for (int j = 0; j < 4; ++j) v[q][j] = *(const GAS f32x4*)(xs + 256 * j + 4 * lane);
            } else {
                u32x2 t[4];
#pragma unroll
                for (int j = 0; j < 4; ++j) t[j] = *(const GAS u32x2*)(xb + (size_t)row * DM + 256 * j + 4 * lane);
#pragma unroll
                for (int j = 0; j < 4; ++j) v[q][j] = (f32x4){bflo(t[j].x), bfhi(t[j].x), bflo(t[j].y), bfhi(t[j].y)};
            }
        }
        if (docomb) {
            u32x2 ya[2][4], yb2[2][4];
#pragma unroll
            for (int q = 0; q < 2; ++q)
#pragma unroll
                for (int j = 0; j < 4; ++j) { ya[q][j] = *(const GAS u32x2*)(yb + (size_t)dd[q][0] * DM + 256 * j + 4 * lane); yb2[q][j] = *(const GAS u32x2*)(yb + (size_t)dd[q][1] * DM + 256 * j + 4 * lane); }
#pragma unroll
            for (int q = 0; q < 2; ++q) {
#pragma unroll
                for (int j = 0; j < 4; ++j) {
                    const u32x2 a = ya[q][j], b = yb2[q][j];
                    const f32x4 gg = *(const LAS f32x4*)(tb[q] + 256 * j);
                    v[q][j][0] += gg[0] * (bflo(a.x) + bflo(b.x)); v[q][j][1] += gg[1] * (bfhi(a.x) + bfhi(b.x));
                    v[q][j][2] += gg[2] * (bflo(a.y) + bflo(b.y)); v[q][j][3] += gg[3] * (bfhi(a.y) + bfhi(b.y));
                }
                if (l < DEPTH && !dry) {
#pragma unroll
                    for (int j = 0; j < 4; ++j) { u32x2 w; w.x = pk2(v[q][j][0], v[q][j][1]); w.y = pk2(v[q][j][2], v[q][j][3]); *(GAS u32x2*)(xb + (size_t)(row_lo + 2 * k + q) * DM + 256 * j + 4 * lane) = w; }
                }
            }
        }
#pragma unroll
        for (int q = 0; q < 2; ++q) {
            const int row = row_lo + 2 * k + q;
            float ss = 0.f;
#pragma unroll
            for (int j = 0; j < 4; ++j) ss += (v[q][j][0] * v[q][j][0] + v[q][j][1] * v[q][j][1]) + (v[q][j][2] * v[q][j][2] + v[q][j][3] * v[q][j][3]);
            const float rs = __builtin_amdgcn_rsqf(wave_sum(ss) * (1.0f / DM) + NORM_EPS);
            if (l == DEPTH) {
                if (!dry)
#pragma unroll
                for (int j = 0; j < 4; ++j) { const f32x4 g = *(const LAS f32x4*)(tb[q] + 1024 + 256 * j); *(GAS f32x4*)(outp + (size_t)row * DM + 256 * j + 4 * lane) = v[q][j] * rs * g; }
            } else {
#pragma unroll
                for (int j = 0; j < 4; ++j) { const int c = 256 * j + 4 * lane; const f32x4 A = *(const LAS f32x4*)(tb[q] + 1024 + 256 * j), B = *(const LAS f32x4*)(tb[q] + 2048 + 256 * j);
                    const f32x4 h = v[q][j] * rs * A + B;
                    u32x2 w; w.x = pk2(h[0], h[1]); w.y = pk2(h[2], h[3]); *(GAS u32x2*)(H + (size_t)row * DM + c) = w; }
            }
        }
    }
}

constexpr int RW_STRIDE = 1028;
__device__ __forceinline__ void phase_norm_ffn_router(int l, lptr lds, int vcu, int G, int wv, bool dry = false) {
    const int tid = opaque_tid(wv), lane = tid & 63, wave = __builtin_amdgcn_readfirstlane(tid >> 6);
    unsigned char* ws = parg(lds, 31); float* outp = (float*)parg(lds, 30);
    const float* gain = pin(lds, 5) + l * DM;
    const float* bgp = pin(lds, 23) + l * 4; const float* bep = pin(lds, 25) + l * 32;
    LAS float* wl = (LAS float*)lds;
    { const float* wg = pin(lds, 22) + (size_t)l * 1024 * 4; const float* we = pin(lds, 24) + (size_t)l * 1024 * 32;
      for (int i = tid; i < 1024 * 4; i += NTHREADS) wl[(i & 3) * RW_STRIDE + (i >> 2)] = wg[i];
      for (int i = tid; i < 1024 * 32; i += NTHREADS) wl[(4 + (i & 31)) * RW_STRIDE + (i >> 5)] = we[i]; }
    LAS unsigned* hist = (LAS unsigned*)(lds + LDS_MISC + 4608);
    if (tid < 32) hist[tid] = 0u;
    __syncthreads();
    const int gw = vcu * NWAVES + wave, NGW = G * NWAVES;
    const float* mod = (const float*)(ws + WS_MOD);
    bf16_t* H = dry ? (bf16_t*)(ws + WS_END) : (bf16_t*)(ws + WS_H);
    int* toke = (int*)(ws + WS_TOKE); float* tokg = (float*)(ws + WS_TOKG); int* tokp = (int*)(ws + WS_TOKP);
    unsigned* cnt = (unsigned*)(ws + WS_CTL) + CW_CNT + l * 32 * 16;
    const int nrows = (l == DEPTH - 1) ? NLAT : MTOT;
    for (int row = gw; row < nrows; row += NGW) {
        const int r = mod_r(row);
        const float* xp = xrow_ptr(outp, ws, row);
        f32x4 v[4];
#pragma unroll
        for (int j = 0; j < 4; ++j) v[j] = *(const GAS f32x4*)(xp + 256 * j + 4 * lane);
        float ss = 0.f;
#pragma unroll
        for (int j = 0; j < 4; ++j) ss += (v[j][0] * v[j][0] + v[j][1] * v[j][1]) + (v[j][2] * v[j][2] + v[j][3] * v[j][3]);
        const float rs = __builtin_amdgcn_rsqf(wave_sum(ss) * (1.0f / DM) + NORM_EPS);
        const float* sh = mod + ((size_t)l * 17 + r) * 6144 + 3 * 1024; const float* sc = sh + 1024;
#pragma unroll
        for (int j = 0; j < 4; ++j) { const int c = 256 * j + 4 * lane; const f32x4 g = *(const GAS f32x4*)(gain + c), s0 = *(const GAS f32x4*)(sh + c), s1 = *(const GAS f32x4*)(sc + c);
            v[j] = v[j] * rs * g * (s1 + 1.0f) + s0;
            u32x2 w; w.x = pk2(v[j][0], v[j][1]); w.y = pk2(v[j][2], v[j][3]); *(GAS u32x2*)(H + (size_t)row * DM + c) = w; }
        float a[36];
        int wo = 4 * lane; asm volatile("" : "+v"(wo));
        const LAS float* wlr = wl + wo;
#pragma unroll
        for (int c = 0; c < 36; ++c) {
            float s = 0.f;
#pragma unroll
            for (int j = 0; j < 4; ++j) { const f32x4 w = *(const LAS f32x4*)(wlr + c * RW_STRIDE + 256 * j); s += (v[j][0] * w[0] + v[j][1] * w[1]) + (v[j][2] * w[2] + v[j][3] * w[3]); }
            a[c] = s;
        }
#pragma unroll
        for (int c = 0; c < 4; ++c) a[c] = wave_sum(a[c]) + bgp[c];
#define HALVE(N, MASK) _Pragma("unroll") for (int i = 0; i < (N) / 2; ++i) { const bool up = (lane & (MASK)) != 0; const float send = up ? a[4 + i] : a[4 + i + (N) / 2]; \
            const float keep = up ? a[4 + i + (N) / 2] : a[4 + i]; a[4 + i] = keep + xshfl<(MASK)>(send); }
        HALVE(32, 32) HALVE(16, 16) HALVE(8, 8) HALVE(4, 4) HALVE(2, 2)
#undef HALVE
        float ev = a[4] + xshfl<1>(a[4]);
        ev += bep[lane >> 1];
        int grp = 0; float gm = a[0];
#pragma unroll
        for (int c = 1; c < 4; ++c) if (a[c] > gm) { gm = a[c]; grp = c; }
        float gs = 0.f;
#pragma unroll
        for (int c = 0; c < 4; ++c) gs += __expf(a[c] - gm);
        const float pgrp = 1.0f / gs;
        float el[8];
        const int grpu = __builtin_amdgcn_readfirstlane(grp);
#pragma unroll
        for (int i = 0; i < 8; ++i) el[i] = __builtin_bit_cast(float, __builtin_amdgcn_readlane(__builtin_bit_cast(int, ev), (grpu * 8 + i) * 2));
        int i1 = 0; float m1 = el[0];
#pragma unroll
        for (int i = 1; i < 8; ++i) if (el[i] > m1) { m1 = el[i]; i1 = i; }
        int i2 = -1; float m2 = -INFINITY;
#pragma unroll
        for (int i = 0; i < 8; ++i) if (i != i1 && el[i] > m2) { m2 = el[i]; i2 = i; }
        const float e2 = __expf(m2 - m1);
        const float g1 = pgrp / (1.0f + e2), g2 = pgrp * e2 / (1.0f + e2);
        if (lane == 0 && (!dry || g1 < -1.0f)) {
            const int ea = grp * 8 + i1, eb = grp * 8 + i2;
            const unsigned pa = __hip_atomic_fetch_add(hist + ea, 1u, __ATOMIC_RELAXED, __HIP_MEMORY_SCOPE_WORKGROUP), pb = __hip_atomic_fetch_add(hist + eb, 1u, __ATOMIC_RELAXED, __HIP_MEMORY_SCOPE_WORKGROUP);
            toke[row * 2] = ea; toke[row * 2 + 1] = eb; tokg[row * 2] = g1; tokg[row * 2 + 1] = g2; tokp[row * 2] = (int)pa; tokp[row * 2 + 1] = (int)pb;
        }
    }
    __syncthreads();
    if (tid < 32 && !dry) ((int*)(ws + WS_WGB))[vcu * 32 + tid] = (int)atomicAdd(cnt + tid * 16, hist[tid]);
}

constexpr int RW2_STRIDE = 2080, RW2_TAB = 48 * RW2_STRIDE, RW2_SCR = RW2_TAB + 16384;
__device__ __forceinline__ void phase_router_mfma(int l, lptr lds, int vcu, int G, int wv) {
    const int tid = opaque_tid(wv), lane = tid & 63, wave = __builtin_amdgcn_readfirstlane(tid >> 6);
    unsigned char* ws = parg(lds, 31); float* outp = (float*)parg(lds, 30);
    const float* gain = pin(lds, 5) + l * DM;
    const float* bgp = pin(lds, 23) + l * 4; const float* bep = pin(lds, 25) + l * 32;
    const float* mod = (const float*)(ws + WS_MOD);
    const int nrows = (l == DEPTH - 1) ? NLAT : MTOT;
    const int RPW = nrows / G;
    const int row_lo = vcu * RPW; const int r_lo = mod_r(row_lo), r_hi = mod_r(row_lo + RPW - 1);
    {
        const float* wg = pin(lds, 22) + (size_t)l * 1024 * 4; const float* we = pin(lds, 24) + (size_t)l * 1024 * 32;
        for (int i = tid; i < 1024 * 32; i += NTHREADS) *(LAS bf16_t*)(lds + (i & 31) * RW2_STRIDE + (i >> 5) * 2) = (bf16_t)f2bf(we[i]);
        for (int i = tid; i < 1024 * 4; i += NTHREADS) *(LAS bf16_t*)(lds + (32 + (i & 3)) * RW2_STRIDE + (i >> 2) * 2) = (bf16_t)f2bf(wg[i]);
        for (int i = tid; i < 12 * 512; i += NTHREADS) *(LAS unsigned*)(lds + (36 + i / 512) * RW2_STRIDE + (i % 512) * 4) = 0u;
        LAS float* tab = (LAS float*)(lds + RW2_TAB);
        for (int i = tid; i < 2048; i += NTHREADS) { const int t = i >> 10, c = i & 1023; const int r = t ? r_hi : r_lo;
            const float* sh = mod + ((size_t)l * 17 + r) * 6144 + 3 * 1024;
            tab[t * 2048 + c] = gain[c] * (1.0f + sh[1024 + c]); tab[t * 2048 + 1024 + c] = sh[c]; }
        if (tid < 32) ((LAS unsigned*)(lds + LDS_MISC + 4608))[tid] = 0u;
    }
    __syncthreads();
    LAS unsigned* hist = (LAS unsigned*)(lds + LDS_MISC + 4608);
    bf16_t* H = (bf16_t*)(ws + WS_H);
    const float* rs16 = (const float*)(ws + WS_RS16);
    int* toke = (int*)(ws + WS_TOKE); float* tokg = (float*)(ws + WS_TOKG); int* tokp = (int*)(ws + WS_TOKP);
    const int rl = lane & 15, kq = lane >> 4;
    LAS float* scr = (LAS float*)(lds + RW2_SCR + wave * 3136);
    for (int b = wave; b < RPW / 16; b += NWAVES) {
        const int row0 = row_lo + 16 * b, row = row0 + rl;
        const int t = (mod_r(row0) == r_lo) ? 0 : 1;
        const LAS float* tA = (const LAS float*)(lds + RW2_TAB) + t * 2048 + 8 * kq; const LAS float* tB = tA + 1024;
        float rs;
        { const f32x4 p0 = *(const GAS f32x4*)(rs16 + (size_t)row * 16), p1 = *(const GAS f32x4*)(rs16 + (size_t)row * 16 + 4), p2 = *(const GAS f32x4*)(rs16 + (size_t)row * 16 + 8), p3 = *(const GAS f32x4*)(rs16 + (size_t)row * 16 + 12);
          const f32x4 q = (p0 + p1) + (p2 + p3); rs = __builtin_amdgcn_rsqf(((q[0] + q[1]) + (q[2] + q[3])) * (1.0f / DM) + NORM_EPS); }
        const bf16_t* xp = (const bf16_t*)(ws + WS_XB) + (size_t)row * DM + 8 * kq;
        bf16_t* hp = H + (size_t)row * DM + 8 * kq;
        const LAS unsigned char* wp = lds + rl * RW2_STRIDE + 16 * kq;
        f32x4 acc0 = {0.f, 0.f, 0.f, 0.f}, acc1 = acc0, acc2 = acc0;
#pragma unroll 8
        for (int s = 0; s < 32; ++s) {
            const u32x4 xw = *(const GAS u32x4*)(xp + 32 * s);
            const f32x4 x0 = {bflo(xw.x), bfhi(xw.x), bflo(xw.y), bfhi(xw.y)}, x1 = {bflo(xw.z), bfhi(xw.z), bflo(xw.w), bfhi(xw.w)};
            const f32x4 a0 = *(const LAS f32x4*)(tA + 32 * s), a1 = *(const LAS f32x4*)(tA + 32 * s + 4), b0 = *(const LAS f32x4*)(tB + 32 * s), b1 = *(const LAS f32x4*)(tB + 32 * s + 4);
            const f32x4 h0 = x0 * rs * a0 + b0, h1 = x1 * rs * a1 + b1;
            const u32x4 hw = pack8(h0, h1);
            *(GAS u32x4*)(hp + 32 * s) = hw;
            const bf16x8 af = __builtin_bit_cast(bf16x8, hw);
            const bf16x8 w0 = *(const LAS bf16x8*)(wp + 64 * s), w1 = *(const LAS bf16x8*)(wp + 16 * RW2_STRIDE + 64 * s), w2 = *(const LAS bf16x8*)(wp + 32 * RW2_STRIDE + 64 * s);
            acc0 = __builtin_amdgcn_mfma_f32_16x16x32_bf16(af, w0, acc0, 0, 0, 0);
            acc1 = __builtin_amdgcn_mfma_f32_16x16x32_bf16(af, w1, acc1, 0, 0, 0);
            acc2 = __builtin_amdgcn_mfma_f32_16x16x32_bf16(af, w2, acc2, 0, 0, 0);
        }
#pragma unroll
        for (int j = 0; j < 4; ++j) { scr[(4 * kq + j) * 49 + rl] = acc0[j]; scr[(4 * kq + j) * 49 + 16 + rl] = acc1[j]; scr[(4 * kq + j) * 49 + 32 + rl] = acc2[j]; }
        LDS_WAIT();
        if (lane < 16) {
            const LAS float* lg = scr + lane * 49;
            float g[4];
#pragma unroll
            for (int c = 0; c < 4; ++c) g[c] = lg[32 + c] + bgp[c];
            int grp = 0; float gm = g[0];
#pragma unroll
            for (int c = 1; c < 4; ++c) if (g[c] > gm) { gm = g[c]; grp = c; }
            float gs = 0.f;
#pragma unroll
            for (int c = 0; c < 4; ++c) gs += __expf(g[c] - gm);
            const float pgrp = 1.0f / gs;
            float el[8];
#pragma unroll
            for (int i = 0; i < 8; ++i) el[i] = lg[grp * 8 + i] + bep[grp * 8 + i];
            int i1 = 0; float m1 = el[0];
#pragma unroll
            for (int i = 1; i < 8; ++i) if (el[i] > m1) { m1 = el[i]; i1 = i; }
            int i2 = -1; float m2 = -INFINITY;
#pragma unroll
            for (int i = 0; i < 8; ++i) if (i != i1 && el[i] > m2) { m2 = el[i]; i2 = i; }
            const float e2 = __expf(m2 - m1);
            const float g1 = pgrp / (1.0f + e2), g2 = pgrp * e2 / (1.0f + e2);
            const int ea = grp * 8 + i1, eb = grp * 8 + i2;
            const unsigned pa = __hip_atomic_fetch_add(hist + ea, 1u, __ATOMIC_RELAXED, __HIP_MEMORY_SCOPE_WORKGROUP), pb = __hip_atomic_fetch_add(hist + eb, 1u, __ATOMIC_RELAXED, __HIP_MEMORY_SCOPE_WORKGROUP);
            const int rr = row0 + lane;
            toke[rr * 2] = ea; toke[rr * 2 + 1] = eb; tokg[rr * 2] = g1; tokg[rr * 2 + 1] = g2; tokp[rr * 2] = (int)pa; tokp[rr * 2 + 1] = (int)pb;
        }
        LDS_WAIT();
    }
    __syncthreads();
    unsigned* cnt = (unsigned*)(ws + WS_CTL) + CW_CNT + l * 32 * 16;
    if (tid < 32) ((int*)(ws + WS_WGB))[vcu * 32 + tid] = (int)atomicAdd(cnt + tid * 16, hist[tid]);
}

__device__ __forceinline__ void phase_moe_scan(int l, lptr lds, int vcu, int G, int wv) {
    const int tid = opaque_tid(wv);
    unsigned char* ws = parg(lds, 31);
    LAS int* tile_exp = (LAS int*)(lds + LDS_MISC); LAS int* ntl = (LAS int*)(lds + LDS_MISC + 4096); LAS int* pad_start = (LAS int*)(lds + LDS_MISC + 4224); LAS int* cntl = (LAS int*)(lds + LDS_MISC + 4352);
    const unsigned* cnt = (const unsigned*)(ws + WS_CTL) + CW_CNT + l * 32 * 16;
    if (tid < 32) cntl[tid] = (int)__hip_atomic_load(cnt + tid * 16, __ATOMIC_RELAXED, __HIP_MEMORY_SCOPE_AGENT);
    __syncthreads();
    if (tid == 0) { int t = 0; for (int e = 0; e < 32; ++e) { pad_start[e] = t * 256; const int nt = (cntl[e] + 255) >> 8; for (int i = 0; i < nt; ++i) tile_exp[t + i] = e; t += nt; } ntl[0] = t; }
    __syncthreads();
    const int gt = vcu * NTHREADS + tid, NGT = G * NTHREADS;
    const int ntok = (l == DEPTH - 1) ? NLAT : MTOT;
    const int* toke = (const int*)(ws + WS_TOKE); const float* tokg = (const float*)(ws + WS_TOKG); const int* tokp = (const int*)(ws + WS_TOKP);
    int* tokd = (int*)(ws + WS_TOKD); int* slott = (int*)(ws + WS_SLOTT); float* slotg = (float*)(ws + WS_SLOTG);
    const int* wgb = (const int*)(ws + WS_WGB);
    for (int a = gt; a < 2 * ntok; a += NGT) { const int e = toke[a]; const int wgv = (a >> 1) / (ntok / G);
        const int dest = pad_start[e] + wgb[wgv * 32 + e] + tokp[a]; slott[dest] = a >> 1; slotg[dest] = tokg[a]; tokd[a] = dest; }
    for (int i = gt; i < 32 * 256; i += NGT) { const int e = i >> 8, off = i & 255; const int s = pad_start[e] + cntl[e] + off; const int end = pad_start[e] + (((cntl[e] + 255) >> 8) << 8);
        if (s < end) { slott[s] = ZROW; slotg[s] = 0.f; } }
}

struct Params { const float* in[30]; float* out; unsigned char* ws; };

__device__ __forceinline__ void moe_gemms(lptr lds, int l, int tid, int G, int bx) {
}

template <int L> __device__ __forceinline__ void layer_body(lptr lds, int wv) {
    constexpr int jj = L / 2, par = L % 2, l = L; constexpr bool last = (L == DEPTH - 1);
#define GRID_BAR() do { XcdBarrier b_; b_.bar = (unsigned*)(parg(lds, 31) + WS_CTL) + CW_BAR; b_.x = xb_xcc_id(); b_.st = (volatile LAS unsigned*)(lds + LDS_BYTES - 64); xcd_barrier(b_, wv); } while (0)
#define G   (opaque_s((int)gridDim.x))
#define bx  (opaque_s((int)blockIdx.x))
#define vcu (opaque_s((int)((blockIdx.x % 8) * (gridDim.x / 8) + blockIdx.x / 8)))
    const int tid = opaque_tid(wv);
            if (REP_ROW > 1 && l > 0) { phase_norm_mix(lds, l, vcu, G, wv, true); GRID_BAR(); }
            phase_norm_mix(lds, l, vcu, G, wv);
            GRID_BAR();
            if constexpr (par == 0) {
                for (int rep_ = 0; rep_ < REP_WIN; ++rep_)
                {
                    unsigned char* ws = parg(lds, 31);
                    pg8::GemmPlain g{(const char*)(ws + WS_H), (const char*)(ws + WS_WINE) + (size_t)jj * 1280 * 1024 * 2, 1024, 1024};
                    pg8::StaticOrder S; S.init(MTOT / 256, 5, G, bx);
                    EpiWinEven E{ws + WS_BIG, (float*)(ws + WS_RSQ), (const float*)(ws + WS_ROPE64), (const float*)(ws + WS_ROPE32), (REP_NOST && rep_ > 0)};
                    pg8::gemm_phase(lds, g, S, E, wv);
                }
                GRID_BAR();
                {
                    unsigned char* ws = parg(lds, 31);
                    pg8::GemmPlain g{(const char*)(ws + WS_BIG + BG_CQ), (const char*)(ws + WS_WUQ) + (size_t)jj * 768 * 256 * 2, 256, 256};
                    pg8::StaticOrder S; S.init(MTOT / 256, 3, G, bx);
                    EpiUq E{(bf16_t*)(ws + WS_BIG + BG_QM), (const float*)(ws + WS_RSQ), (const float*)(ws + WS_ROPE32)};
                    pg8::gemm_phase(lds, g, S, E, wv);
                }
                {
                    unsigned char* ws = parg(lds, 31);
                    pg8::GemmPlain g2{(const char*)(ws + WS_BIG + BG_CKVR), (const char*)(ws + WS_WUKV) + (size_t)jj * 1024 * 256 * 2, 256, 256};
                    pg8::StaticOrder S2; S2.init(MTOT / 256, 4, G, G - 1 - bx);
                    EpiUkv E2{(bf16_t*)(ws + WS_BIG + BG_KVM), (const float*)(ws + WS_RSQ)};
                    pg8::gemm_phase(lds, g2, S2, E2, wv);
                }
                GRID_BAR();
                for (int rep_ = 0; rep_ < REP_ATT; ++rep_) {
                {
                    unsigned char* big = parg(lds, 31) + WS_BIG; bf16_t* Hb = (bf16_t*)(parg(lds, 31) + WS_H);
                    att::Tensors Tm{(const bf16_t*)(big + BG_QM), (const bf16_t*)(big + BG_KVM), (const bf16_t*)(big + BG_CKVR), (const bf16_t*)(big + BG_KVM), Hb, nullptr, 0.f, nullptr, 0.f, 0.10206207261596575f * LOG2E};
                    LAS unsigned* redo = (LAS unsigned*)(lds + LDS_MISC + 4608 + 64);
#pragma unroll 1
                    for (int pass = 0; pass < 2; ++pass) {
#pragma unroll 1
                    for (int i = 0; i < 9; ++i) {
                        att::Unit U;
                        if (i < 8) { const int u = vcu + 256 * i, bh = u >> 4, qb = u & 15, b = bh >> 3, h = bh & 7; U = att::Unit{b * SEQ + qb * 256, b * SEQ, 64, NLAT + b * CTXL, h, 0, 0}; }
                        else { if (vcu >= 128) break; const int b = vcu >> 3, h = vcu & 7; U = att::Unit{NLAT + b * CTXL, 0, 0, NLAT + b * CTXL, h, 0, 0}; }
                        if (pass == 0) { const bool bad = att::attn_unit_q<att::MLA, false>(lds, U, Tm, wv); if (opaque_tid(wv) == 0) redo[i] = bad ? 1u : 0u; }
                        else { __syncthreads(); if (__builtin_amdgcn_readfirstlane(redo[i]) != 0u) (void)att::attn_unit_q<att::MLA, true>(lds, U, Tm, wv); }
                    }
                    }
                }
                {
                    unsigned char* big = parg(lds, 31) + WS_BIG; bf16_t* Hb = (bf16_t*)(parg(lds, 31) + WS_H);
                    att::Tensors Ts{(const bf16_t*)(big + BG_AQ), (const bf16_t*)(big + BG_AKV), nullptr, (const bf16_t*)(big + BG_AKV), Hb, pin(lds, 13) + jj * 8, 0.f, nullptr, 0.f, 1.0f};
                    LAS unsigned* redo = (LAS unsigned*)(lds + LDS_MISC + 4608 + 64);
#pragma unroll 1
                    for (int pass = 0; pass < 2; ++pass) {
#pragma unroll 1
                    for (int i = 0; i < 9; ++i) {
                        att::Unit U;
                        if (i < 8) { const int u = vcu + 256 * i, bh = u >> 4, qb = u & 15, b = bh >> 3, h = bh & 7;
                            const int q0 = qb * 256, t0 = (q0 == 0) ? 0 : (q0 / 64 - 2), t1 = (q0 / 64 + 5 > 63) ? 63 : (q0 / 64 + 5);
                            U = att::Unit{b * SEQ + q0, b * SEQ + 64 * t0, t1 - t0 + 1, NLAT + b * CTXL, h, q0, 64 * t0}; }
                        else { if (vcu < 128) break; const int u = vcu - 128, b = u >> 3, h = u & 7; U = att::Unit{NLAT + b * CTXL, 0, 0, NLAT + b * CTXL, h, 0, 0}; }
                        if (pass == 0) { const bool bad = att::attn_unit<att::SWA, false>(lds, U, Ts, wv); if (opaque_tid(wv) == 0) redo[i] = bad ? 1u : 0u; }
                        else { __syncthreads(); if (__builtin_amdgcn_readfirstlane(redo[i]) != 0u) (void)att::attn_unit<att::SWA, true>(lds, U, Ts, wv); }
                    }
                    }
                }
                }
                GRID_BAR();
                {
                    unsigned char* ws = parg(lds, 31); float* outp = (float*)parg(lds, 30); float* xctx = (float*)(ws + WS_XCTX);
                    pg8::GemmPlain g{(const char*)(ws + WS_H), (const char*)(ws + WS_WOUTE) + (size_t)jj * 1024 * 1024 * 2, 1024, 1024};
                    pg8::StaticOrder S; S.init(MTOT / 256, 4, G, bx);
                    EpiResid<(L == 0)> E{pin(lds, 0), pin(lds, 2), (bf16_t*)(ws + WS_XB), (const float*)(ws + WS_MOD) + (size_t)l * 17 * 6144, 2 * 1024, (float*)(ws + WS_RS16)};
                    pg8::gemm_phase(lds, g, S, E, wv);
                }
            } else {
                for (int rep_ = 0; rep_ < REP_WIN; ++rep_)
                {
                    unsigned char* ws = parg(lds, 31);
                    pg8::GemmPlain g{(const char*)(ws + WS_H), (const char*)(ws + WS_WINO) + (size_t)jj * 3072 * 1024 * 2, 1024, 1024};
                    pg8::StaticOrder S; S.init(MTOT / 256, 12, G, bx);
                    EpiWinOdd E{(bf16_t*)(ws + WS_BIG), (const float*)(ws + WS_ROPE64), (REP_NOST && rep_ > 0)};
                    pg8::gemm_phase(lds, g, S, E, wv);
                }
                GRID_BAR();
                for (int rep_ = 0; rep_ < REP_ATT; ++rep_)
                {
                    unsigned char* big = parg(lds, 31) + WS_BIG; bf16_t* Hb = (bf16_t*)(parg(lds, 31) + WS_H);
                    float d1 = 0.f, d2 = 0.f;
                    { const float* lq1 = pin(lds, 16) + jj * 64; const float* lk1 = pin(lds, 17) + jj * 64; const float* lq2 = pin(lds, 18) + jj * 64; const float* lk2 = pin(lds, 19) + jj * 64;
                      for (int i = 0; i < 64; ++i) { d1 += lq1[i] * lk1[i]; d2 += lq2[i] * lk2[i]; } }
                    const float lam_init = 0.8f - 0.6f * expf(-0.3f * (float)l);
                    const float lam = expf(d1) - expf(d2) + lam_init;
                    att::Tensors Td{(const bf16_t*)big, (const bf16_t*)big, nullptr, (const bf16_t*)big, Hb, nullptr, lam, pin(lds, 20) + jj * 128, 1.0f - lam_init, 0.125f * LOG2E};
                    LAS unsigned* redo = (LAS unsigned*)(lds + LDS_MISC + 4608 + 64);
#pragma unroll 1
                    for (int pass = 0; pass < 2; ++pass) {
#pragma unroll 1
                    for (int i = 0; i < 17; ++i) {
                        att::Unit U;
                        if (i < 16) { const int u = vcu + 256 * i, bh = u >> 5, qb = u & 31, b = bh >> 3, h = bh & 7; U = att::Unit{b * SEQ + qb * 128, b * SEQ, 64, NLAT + b * CTXL, h, 0, 0}; }
                        else { if (last) break; const int bh = vcu >> 1, half = vcu & 1, b = bh >> 3, h = bh & 7; U = att::Unit{NLAT + b * CTXL + half * 128, 0, 0, NLAT + b * CTXL, h, 0, 0}; }
                        if (pass == 0) { const bool bad = att::attn_unit_q<att::DIFF, false>(lds, U, Td, wv); if (opaque_tid(wv) == 0) redo[i] = bad ? 1u : 0u; }
                        else { __syncthreads(); if (__builtin_amdgcn_readfirstlane(redo[i]) != 0u) (void)att::attn_unit_q<att::DIFF, true>(lds, U, Td, wv); }
                    }
                    }
                }
                GRID_BAR();
                {
                    unsigned char* ws = parg(lds, 31); float* outp = (float*)parg(lds, 30); float* xctx = (float*)(ws + WS_XCTX);
                    pg8::GemmPlain g{(const char*)(ws + WS_H), (const char*)(ws + WS_WOUTO) + (size_t)jj * 1024 * 1024 * 2, 1024, 1024};
                    pg8::StaticOrder S; S.init((last ? NLAT : MTOT) / 256, 4, G, bx);
                    EpiResid<false> E{pin(lds, 0), pin(lds, 2), (bf16_t*)(ws + WS_XB), (const float*)(ws + WS_MOD) + (size_t)l * 17 * 6144, 2 * 1024, (float*)(ws + WS_RS16)};
                    pg8::gemm_phase(lds, g, S, E, wv);
                }
            }
            GRID_BAR();
            phase_router_mfma(l, lds, vcu, G, wv);
            GRID_BAR();
            phase_moe_scan(l, lds, vcu, G, wv);
            GRID_BAR();
            for (int rep_ = 0; rep_ < REP_MOE; ++rep_)
            {
                unsigned char* ws = parg(lds, 31);
                LAS int* tile_exp = (LAS int*)(lds + LDS_MISC); LAS int* idx = (LAS int*)(lds + 131072); const int nt = *(LAS int*)(lds + LDS_MISC + 4096); const int* slott = (const int*)(ws + WS_SLOTT);
                const int cu_ = vcu;
                { const int t_ = opaque_tid(wv); for (int i = 0; i * G + cu_ < nt * 4; ++i) { const int pm = (i * G + cu_) >> 2; if (t_ < 256) idx[i * 256 + t_] = slott[pm * 256 + t_]; } }
                __syncthreads();
                GemmMoe1 g{(const char*)(ws + WS_H), (const char*)(ws + WS_W13) + (size_t)l * NEXP * 1024 * 1024 * 2, idx, tile_exp, 1024};
                MoeSched S{tile_exp, nt, G, cu_};
                EpiSwiglu E{(bf16_t*)(ws + WS_BIG + BG_ACT)};
                pg8::gemm_phase(lds, g, S, E, wv);
            }
            GRID_BAR();
            for (int rep_ = 0; rep_ < REP_MOE; ++rep_)
            {
                unsigned char* ws = parg(lds, 31);
                LAS int* tile_exp = (LAS int*)(lds + LDS_MISC); const int nt = *(LAS int*)(lds + LDS_MISC + 4096);
                LAS float* gl = (LAS float*)(lds + 131072); const float* slotg = (const float*)(ws + WS_SLOTG); const int cu_ = vcu;
                { const int t_ = opaque_tid(wv); for (int i = 0; i * G + cu_ < nt * 4; ++i) { const int pm = (i * G + cu_) >> 2; if (t_ < 256) gl[i * 256 + t_] = slotg[pm * 256 + t_]; } }
                __syncthreads();
                GemmMoe2 g{(const char*)(ws + WS_BIG + BG_ACT), (const char*)(ws + WS_W2T) + (size_t)l * NEXP * 1024 * 512 * 2, tile_exp, 512};
                MoeSched S{tile_exp, nt, G, cu_};
                EpiMoe2 E{(bf16_t*)(ws + WS_BIG + BG_YB), gl};
                pg8::gemm_phase(lds, g, S, E, wv);
            }
            GRID_BAR();
}
#undef GRID_BAR
#undef G
#undef bx
#undef vcu
__global__ void __launch_bounds__(NTHREADS, 2) fwd_kernel(Params P) {
    extern __shared__ __attribute__((aligned(16))) unsigned char lds_raw[];
    const lptr lds = (lptr)lds_raw;
    const int tid = threadIdx.x;
    const int wv = __builtin_amdgcn_readfirstlane(tid >> 6);
#define PAD_STR2(n) #n
#define PAD_STR(n) PAD_STR2(n)
    if (CODE_PAD > 0) asm volatile(".rept " PAD_STR(CODE_PAD) "\n\ts_nop 0\n\t.endr" ::: "memory");
#define G   (opaque_s((int)gridDim.x))
#define bx  (opaque_s((int)blockIdx.x))
#define vcu (opaque_s((int)((blockIdx.x % 8) * (gridDim.x / 8) + blockIdx.x / 8)))
    volatile LAS unsigned* bst = (volatile LAS unsigned*)(lds + LDS_BYTES - 64);
    if (tid < 16) bst[tid] = 0u;
    if (tid < 32) {
        const unsigned long long* ka = (const unsigned long long*)__builtin_amdgcn_kernarg_segment_ptr();
        ((LAS unsigned long long*)(lds + LDS_PB))[tid] = ka[tid];
    }
    __syncthreads();
    (void)xcd_barrier_post((unsigned*)(parg(lds, 31) + WS_CTL) + CW_BAR, bst, wv);
#define GRID_BAR() do { XcdBarrier b_; b_.bar = (unsigned*)(parg(lds, 31) + WS_CTL) + CW_BAR; b_.x = xb_xcc_id(); b_.st = (volatile LAS unsigned*)(lds + LDS_BYTES - 64); xcd_barrier(b_, wv); } while (0)

    for (int rep_ = 0; rep_ < REP_PRO; ++rep_) prologue_a(lds, vcu, G, wv);
    GRID_BAR();
    prologue_b(lds, vcu, G, wv);
    GRID_BAR();

    layer_body<0>(lds, wv);
    layer_body<1>(lds, wv);
    layer_body<2>(lds, wv);
    layer_body<3>(lds, wv);
    phase_norm_mix(lds, DEPTH, vcu, G, wv);
#undef G
#undef bx
#undef vcu
}

extern "C" void kernel_launch(void* const* d_in, const int* in_sizes, int n_in, void* d_out, int out_size, void* d_ws, size_t ws_size, hipStream_t stream) {
    static int grid = 0;
    if (grid == 0) {
        if (n_in != 30 || out_size != NLAT * DM || ws_size < WS_END) { fprintf(stderr, "kernel_launch: unexpected shapes (n_in %d out %d ws %zu need %zu)\n", n_in, out_size, ws_size, (size_t)WS_END); grid = -1; return; }
        int dev = 0, cus = 0, per_cu = 0;
        if (hipGetDevice(&dev) != hipSuccess || hipDeviceGetAttribute(&cus, hipDeviceAttributeMultiprocessorCount, dev) != hipSuccess) { grid = -1; return; }
        if (hipFuncSetAttribute((const void*)fwd_kernel, hipFuncAttributeMaxDynamicSharedMemorySize, LDS_BYTES) != hipSuccess) { fprintf(stderr, "kernel_launch: hipFuncSetAttribute failed\n"); grid = -1; return; }
        if (hipOccupancyMaxActiveBlocksPerMultiprocessor(&per_cu, (const void*)fwd_kernel, NTHREADS, LDS_BYTES) != hipSuccess || per_cu < 1) { fprintf(stderr, "kernel_launch: occupancy query says %d\n", per_cu); }
        (void)hipGetLastError();
        grid = cus;
        if (grid % 8 != 0 || grid < 8) { fprintf(stderr, "kernel_launch: unexpected CU count %d\n", cus); grid = -1; return; }
    }
    if (grid < 0) return;
    (void)hipMemsetAsync((char*)d_ws + WS_CTL, 0, CTL_ZERO, stream);
    Params p{};
    for (int i = 0; i < 30; ++i) p.in[i] = (const float*)d_in[i];
    p.out = (float*)d_out; p.ws = (unsigned char*)d_ws;
    hipLaunchKernelGGL(fwd_kernel, dim3(grid), dim3(NTHREADS), LDS_BYTES, stream, p);
}
```
